# Optimizing an MI355X kernel written in HIP

```python
import math
import jax, jax.numpy as jnp
from jax import lax
import numpy as np

D_MODEL = 1024
BATCH = 32
SEQ = 256
DEPTH = 1
DEC_BATCH = 4
DEC_SEQ = 2048
PAST_LEN = 512

GRID_W = 64
N_HEADS = 8
HEAD_DIM = 64
D_ATT = N_HEADS * HEAD_DIM
N_POOL_GROUPS = 4
POOL_WINDOWS = (2, 4, 8, 16)
D_POOL = 512
POOL_GROUP_DIM = D_POOL // N_POOL_GROUPS
N_BRANCHES = 2
D_IN = D_POOL + 3 * D_ATT + N_BRANCHES * D_MODEL
D_FF = 2816
NA_KH = 8
NA_KW = 16
Q_BLOCK = 128
N_MOD = 9
EPS = 1e-6
NEG = -1e30

kernel_name = "hybrid_pool_natten_macaron_step"


def rms_norm(x, g):
    xf = x.astype(jnp.float32)
    y = xf * lax.rsqrt(jnp.mean(xf * xf, axis=-1, keepdims=True) + EPS)
    return (y * g.astype(jnp.float32)).astype(x.dtype)


def adaln_params(cond, w_ada, b_ada):
    m = jax.nn.silu(cond) @ w_ada + b_ada
    m = m.reshape(-1, 1, N_MOD, D_MODEL)
    return [m[:, :, i] for i in range(N_MOD)]


def modulate(h, shift, scale):
    return h * (1.0 + scale) + shift


def swiglu(h, w_gu, w_dn):
    a, u = jnp.split(h @ w_gu, 2, axis=-1)
    return (jax.nn.silu(a) * u) @ w_dn


def pool_mixer(p, w_pool, pool_scale):
    B, L, _ = p.shape
    pg = p.reshape(B, L, N_POOL_GROUPS, POOL_GROUP_DIM)
    cs = jnp.cumsum(pg.astype(jnp.float32), axis=1)
    cs = jnp.concatenate([jnp.zeros_like(cs[:, :1]), cs], axis=1)
    t = jnp.arange(L)
    means = []
    for g, w in enumerate(POOL_WINDOWS):
        lo = jnp.clip(t - w // 2, 0, L)
        hi = jnp.clip(t + w // 2, 0, L)
        s = cs[:, hi, g] - cs[:, lo, g]
        means.append(s / (hi - lo).astype(jnp.float32)[None, :, None])
    mean = jnp.stack(means, axis=2)
    d = (mean - pg.astype(jnp.float32)).astype(p.dtype)
    y = jnp.einsum('blgc,gcd->blgd', d, w_pool)
    return y.reshape(B, L, D_POOL) * pool_scale


def context_attention(q, k, v):
    B, P, H, d = q.shape
    scale = 1.0 / math.sqrt(HEAD_DIM)
    qb = q.reshape(B, P // Q_BLOCK, Q_BLOCK, H, d).transpose(1, 0, 2, 3, 4)

    def one_block(q_blk):
        s = jnp.einsum('bqhd,bkhd->bhqk', q_blk, k).astype(jnp.float32) * scale
        pr = jax.nn.softmax(s, axis=-1).astype(v.dtype)
        return jnp.einsum('bhqk,bkhd->bqhd', pr, v)

    o = lax.map(one_block, qb)
    return o.transpose(1, 0, 2, 3, 4).reshape(B, P, H * d)


def latent_attention(q, k, v, k_ctx, v_ctx, rpb):
    B, L, H, d = q.shape
    rows = L // GRID_W
    kh = min(NA_KH, rows)
    scale = 1.0 / math.sqrt(HEAD_DIM)
    qg = q.reshape(B, rows, GRID_W, H, d)
    kg = k.reshape(B, rows, GRID_W, H, d)
    vg = v.reshape(B, rows, GRID_W, H, d)
    r = jnp.arange(rows)
    r0 = jnp.clip(r - kh // 2, 0, rows - kh)
    col = jnp.arange(GRID_W)
    c0 = jnp.clip(col - NA_KW // 2, 0, GRID_W - NA_KW)
    col_ok = (col[None, :] >= c0[:, None]) & (col[None, :] < c0[:, None] + NA_KW)
    dc_idx = jnp.clip(col[None, :] - col[:, None] + NA_KW - 1, 0, 2 * NA_KW - 2)
    col_bias = rpb.astype(jnp.float32)[:, :, dc_idx]
    col_bias = jnp.where(col_ok[None, None], col_bias, NEG)

    def one_row(args):
        q_row, r_q, r_start = args
        k_win = lax.dynamic_slice_in_dim(kg, r_start, kh, axis=1)
        v_win = lax.dynamic_slice_in_dim(vg, r_start, kh, axis=1)
        dr_idx = r_start + jnp.arange(kh) - r_q + NA_KH - 1
        bias = col_bias[:, dr_idx].transpose(0, 2, 1, 3)
        s_loc = jnp.einsum('bqhd,bikhd->bhqik', q_row, k_win).astype(jnp.float32) * scale
        s_loc = (s_loc + bias[None]).reshape(B, H, GRID_W, kh * GRID_W)
        s_ctx = jnp.einsum('bqhd,bphd->bhqp', q_row, k_ctx).astype(jnp.float32) * scale
        pr = jax.nn.softmax(jnp.concatenate([s_loc, s_ctx], axis=-1), axis=-1).astype(v.dtype)
        p_loc = pr[..., :kh * GRID_W].reshape(B, H, GRID_W, kh, GRID_W)
        p_ctx = pr[..., kh * GRID_W:]
        return (jnp.einsum('bhqik,bikhd->bqhd', p_loc, v_win)
                + jnp.einsum('bhqp,bphd->bqhd', p_ctx, v_ctx))

    o = lax.map(one_row, (qg.transpose(1, 0, 2, 3, 4), r, r0))
    return o.transpose(1, 0, 2, 3, 4).reshape(B, L, H * d)


def trunk_layer(x, mod, lp, k_ctx=None, v_ctx=None):
    sh1, sc1, g1, sh2, sc2, g2, sh3, sc3, g3 = mod
    B, L, _ = x.shape
    h = modulate(rms_norm(x, lp['g_ff1']), sh1, sc1)
    x = x + 0.5 * g1 * swiglu(h, lp['w_ff1_in'], lp['w_ff1_out'])

    h = modulate(rms_norm(x, lp['g_mix']), sh2, sc2)
    proj = h @ lp['w_in']
    o1 = D_POOL
    o2 = o1 + D_ATT
    o3 = o2 + D_ATT
    o4 = o3 + D_ATT
    p = proj[..., :o1]
    q = rms_norm(proj[..., o1:o2].reshape(B, L, N_HEADS, HEAD_DIM), lp['q_gain'])
    k = rms_norm(proj[..., o2:o3].reshape(B, L, N_HEADS, HEAD_DIM), lp['k_gain'])
    v = proj[..., o3:o4].reshape(B, L, N_HEADS, HEAD_DIM)
    gates = jax.nn.sigmoid(proj[..., o4:].astype(jnp.float32)).astype(x.dtype)
    gates = gates.reshape(B, L, N_BRANCHES, D_MODEL)

    a = pool_mixer(p, lp['w_pool'], lp['pool_scale']) @ lp['w_br_pool']
    if k_ctx is None:
        att = context_attention(q, k, v)
    else:
        att = latent_attention(q, k, v, k_ctx, v_ctx, lp['rpb'])
    b = att @ lp['w_br_att']
    merged = gates[:, :, 0] * a + gates[:, :, 1] * b
    x = x + g2 * (merged @ lp['w_out'])

    h = modulate(rms_norm(x, lp['g_ff2']), sh3, sc3)
    x = x + 0.5 * g3 * swiglu(h, lp['w_ff2_in'], lp['w_ff2_out'])
    return x, k, v


def setup_inputs(seed: int = 0) -> dict:
    key = jax.random.key(seed)
    ks = jax.random.split(key, 32)
    f32 = jnp.float32

    def nrm(k, shape, scale=1.0):
        return jax.random.normal(k, shape, f32) * scale

    def gain(k, shape):
        return 1.0 + 0.1 * jax.random.normal(k, shape, f32)

    D = D_MODEL
    return {
        "x_prompt": nrm(ks[0], (BATCH, SEQ, D)),
        "x_sample": nrm(ks[1], (DEC_BATCH, DEC_SEQ, D)),
        "cache_k": nrm(ks[2], (DEC_BATCH, DEPTH, PAST_LEN, N_HEADS, HEAD_DIM)),
        "cache_v": nrm(ks[3], (DEC_BATCH, DEPTH, PAST_LEN, N_HEADS, HEAD_DIM)),
        "c": nrm(ks[4], (DEC_BATCH, D)),
        "c_ctx": nrm(ks[5], (D,)),
        "w_ada": nrm(ks[6], (DEPTH, D, N_MOD * D), D ** -0.5),
        "b_ada": nrm(ks[7], (DEPTH, N_MOD * D), 0.02),
        "g_ff1": gain(ks[8], (DEPTH, D)),
        "w_ff1_in": nrm(ks[9], (DEPTH, D, 2 * D_FF), D ** -0.5),
        "w_ff1_out": nrm(ks[10], (DEPTH, D_FF, D), D_FF ** -0.5),
        "g_mix": gain(ks[11], (DEPTH, D)),
        "w_in": nrm(ks[12], (DEPTH, D, D_IN), D ** -0.5),
        "q_gain": gain(ks[13], (DEPTH, HEAD_DIM)),
        "k_gain": gain(ks[14], (DEPTH, HEAD_DIM)),
        "w_pool": nrm(ks[15], (DEPTH, N_POOL_GROUPS, POOL_GROUP_DIM, POOL_GROUP_DIM), POOL_GROUP_DIM ** -0.5),
        "pool_scale": gain(ks[16], (DEPTH, D_POOL)),
        "rpb": nrm(ks[17], (DEPTH, N_HEADS, 2 * NA_KH - 1, 2 * NA_KW - 1), 0.1),
        "w_br_pool": nrm(ks[18], (DEPTH, D_POOL, D), D_POOL ** -0.5),
        "w_br_att": nrm(ks[19], (DEPTH, D_ATT, D), D_ATT ** -0.5),
        "w_out": nrm(ks[20], (DEPTH, D, D), D ** -0.5),
        "g_ff2": gain(ks[21], (DEPTH, D)),
        "w_ff2_in": nrm(ks[22], (DEPTH, D, 2 * D_FF), D ** -0.5),
        "w_ff2_out": nrm(ks[23], (DEPTH, D_FF, D), D_FF ** -0.5),
    }


def reference(x_prompt, x_sample, cache_k, cache_v, c, c_ctx, w_ada, b_ada, g_ff1, w_ff1_in,
              w_ff1_out, g_mix, w_in, q_gain, k_gain, w_pool, pool_scale, rpb, w_br_pool,
              w_br_att, w_out, g_ff2, w_ff2_in, w_ff2_out):
    xp = x_prompt
    xs = x_sample
    new_ks = []
    new_vs = []
    for l in range(DEPTH):
        lp = {
            'g_ff1': g_ff1[l], 'w_ff1_in': w_ff1_in[l], 'w_ff1_out': w_ff1_out[l],
            'g_mix': g_mix[l], 'w_in': w_in[l], 'q_gain': q_gain[l], 'k_gain': k_gain[l],
            'w_pool': w_pool[l], 'pool_scale': pool_scale[l], 'rpb': rpb[l],
            'w_br_pool': w_br_pool[l], 'w_br_att': w_br_att[l], 'w_out': w_out[l],
            'g_ff2': g_ff2[l], 'w_ff2_in': w_ff2_in[l], 'w_ff2_out': w_ff2_out[l],
        }
        mod_ctx = adaln_params(c_ctx, w_ada[l], b_ada[l])
        xp, k_p, v_p = trunk_layer(xp, mod_ctx, lp)
        new_ks.append(k_p)
        new_vs.append(v_p)
        mod_lat = adaln_params(c, w_ada[l], b_ada[l])
        xs, _, _ = trunk_layer(xs, mod_lat, lp, cache_k[:, l], cache_v[:, l])
    new_k = jnp.stack(new_ks, axis=1)
    new_v = jnp.stack(new_vs, axis=1)
    return (xp, xs, new_k, new_v)
```

```cpp
#include <hip/hip_runtime.h>
#include <hip/hip_cooperative_groups.h>
#include <cstdio>
#include <cstdint>
namespace cg = cooperative_groups;
namespace pg8 {
#define PG8_LAS __attribute__((address_space(3)))
typedef unsigned short bf16_t;
typedef short bf16x8 __attribute__((ext_vector_type(8)));
typedef float f32x4 __attribute__((ext_vector_type(4)));
typedef unsigned u32x4 __attribute__((ext_vector_type(4)));
constexpr int BM = 256, BK = 64, HALF = 128, HTB = HALF * BK * 2  , STAGE_BYTES = 8 * HTB, NXCD = 8, WGM = 8;

__host__ __device__ __forceinline__ int lds_byte(int r, int c) { const int st = (r >> 4) * 2 + (c >> 5), rr = r & 15, cc = c & 31, ob = rr * 64 + cc * 2; return st * 1024 + (ob ^ (((ob >> 9) & 1) << 5)); }
__host__ __device__ __forceinline__ void stage_rc(int b, int& R, int& C) { const int st = b / 1024, sb = b % 1024, swz = sb ^ (((sb >> 9) & 1) << 5); R = (st >> 1) * 16 + swz / 64; C = (st & 1) * 32 + (swz % 64) / 2; }
__host__ __device__ __forceinline__ int perm32(int rho) { const int n = rho >> 4, i = rho & 15; return 8 * (i >> 2) + 4 * n + (i & 3); }

struct Unit { int pm, pn; };
struct Gemm { const bf16_t* A; const bf16_t* Bt; int M, N, K; };

struct StaticOrder {
    int nM, nN, nwg, G, c;
    __host__ __device__ void init(int M, int N, int G_, int c_) { nM = M / BM; nN = N / BM; nwg = nM * nN; G = G_; c = c_; }
    __host__ __device__ bool next(int i, Unit& u) const {
        const long L = (long)i * G + c; if (L >= nwg) return false;
        int wgid = (int)L; { const int q = nwg / NXCD, r = nwg % NXCD, xcd = wgid % NXCD, off = wgid / NXCD; wgid = (xcd < r ? xcd * (q + 1) : r * (q + 1) + (xcd - r) * q) + off; }
        const int nig = WGM * nN, gid = wgid / nig, fm = gid * WGM, gsz = (nM - fm) < WGM ? (nM - fm) : WGM;
        u.pm = fm + ((wgid % nig) % gsz); u.pn = (wgid % nig) / gsz; return true;
    }
    __device__ __forceinline__ void a_ready(const Unit&) const {}
    __device__ __forceinline__ void done(const Unit&) const {}
};

__device__ __forceinline__ unsigned cvt_pk_bf16(float lo, float hi) { unsigned r; asm volatile("v_cvt_pk_bf16_f32 %0, %1, %2" : "=v"(r) : "v"(lo), "v"(hi)); return r; }
template <class Epi, class Sched, bool ALIGN_EPI = false, bool SP2 = false>
__device__ __forceinline__ void gemm_phase(PG8_LAS unsigned char* lds, const Gemm g, const Sched& S, const Epi& E) {
    const int tid = threadIdx.x, wid = __builtin_amdgcn_readfirstlane(tid >> 6), lane = tid & 63, wr = wid >> 2, wc = wid & 3, fr = lane & 15, fq = lane >> 4;
    const int K = g.K, nt = K / BK;
    unsigned voffA[2], voffB[2];
#pragma unroll
    for (int i = 0; i < 2; ++i) { int R, C; stage_rc(tid * 16 + i * 8192, R, C); const int Rb = Epi::PERM ? ((R & ~31) + perm32(R & 31)) : R;
        voffA[i] = (unsigned)(R * K + C) * 2u; voffB[i] = (unsigned)(Rb * K + C) * 2u; }
    const size_t kstep = (size_t)(BK * 2);
    const size_t hstep = (size_t)HALF * K * 2;
    const size_t tstep = 2 * hstep;
    const unsigned ldsw = (unsigned)wid * 1024u;
    const int aoff = lds_byte(wr * 64 + fr, fq * 8), boff = lds_byte(wc * 32 + fr, fq * 8);
#define PG8_SA(b, h) (((b) * 2 + (h)) * HTB)
#define PG8_SB(b, h) ((4 + (b) * 2 + (h)) * HTB)
#define PG8_STAGE(bufoff, gbase, voff) do { _Pragma("unroll") for (int _i = 0; _i < 2; ++_i) \
        __builtin_amdgcn_global_load_lds((const unsigned*)((const char*)(gbase) + (voff)[_i]), (PG8_LAS unsigned*)(lds + (bufoff) + ldsw + _i * 8192), 16, 0, 0); } while (0)
#define PG8_LDA(dst, b, h) do { _Pragma("unroll") for (int m = 0; m < 4; ++m) _Pragma("unroll") for (int k = 0; k < 2; ++k) dst[m][k] = *(const PG8_LAS bf16x8*)(lds + PG8_SA(b, h) + aoff + m * 2048 + k * 1024); } while (0)
#define PG8_LDB(dst, b, h) do { _Pragma("unroll") for (int n = 0; n < 2; ++n) _Pragma("unroll") for (int k = 0; k < 2; ++k) dst[n][k] = *(const PG8_LAS bf16x8*)(lds + PG8_SB(b, h) + boff + n * 2048 + k * 1024); } while (0)
#define PG8_MMA(ai, bj, At, Bt) do { __builtin_amdgcn_s_setprio(1); _Pragma("unroll") for (int m = 0; m < 4; ++m) _Pragma("unroll") for (int n = 0; n < 2; ++n) _Pragma("unroll") for (int k = 0; k < 2; ++k) \
        acc[ai][bj][m][n] = __builtin_amdgcn_mfma_f32_16x16x32_bf16(Bt[n][k], At[m][k], acc[ai][bj][m][n], 0, 0, 0); __builtin_amdgcn_s_setprio(0); } while (0)
#define PG8_WAIT_V(n) asm volatile("s_waitcnt vmcnt(" #n ")" ::: "memory")
#define PG8_WAIT_L(n) asm volatile("s_waitcnt lgkmcnt(" #n ")" ::: "memory")
#define PG8_BAR __builtin_amdgcn_s_barrier()
#define PG8_SCHED __builtin_amdgcn_sched_barrier(0)
    Unit cur, nxt; int ui = 0;
    if (!S.next(0, cur)) return;
    f32x4 acc[2][2][4][2];
#pragma unroll
    for (int a = 0; a < 2; ++a)
#pragma unroll
        for (int b = 0; b < 2; ++b)
#pragma unroll
            for (int m = 0; m < 4; ++m)
#pragma unroll
                for (int n = 0; n < 2; ++n) acc[a][b][m][n] = (f32x4){0.f, 0.f, 0.f, 0.f};
    bf16x8 At[4][2], B0[2][2], B1[2][2];
    const char* cA = (const char*)g.A + (size_t)cur.pm * tstep; const char* cB = (const char*)g.Bt + (size_t)cur.pn * tstep;
    S.a_ready(cur);
    if constexpr (SP2) {
        PG8_STAGE(PG8_SB(0, 0), cB, voffB); PG8_STAGE(PG8_SB(0, 1), cB + hstep, voffB); PG8_STAGE(PG8_SA(0, 0), cA, voffA); PG8_STAGE(PG8_SA(0, 1), cA + hstep, voffA);
        if (wr == 1) PG8_BAR;
        PG8_WAIT_V(2); PG8_BAR;
        PG8_STAGE(PG8_SB(1, 0), cB + kstep, voffB); PG8_STAGE(PG8_SA(1, 0), cA + kstep, voffA); PG8_STAGE(PG8_SB(1, 1), cB + hstep + kstep, voffB);
        PG8_WAIT_V(6); PG8_BAR;
    } else {
        PG8_STAGE(PG8_SB(0, 0), cB, voffB); PG8_STAGE(PG8_SA(0, 0), cA, voffA); PG8_STAGE(PG8_SB(0, 1), cB + hstep, voffB); PG8_STAGE(PG8_SA(0, 1), cA + hstep, voffA);
        if (wr == 1) PG8_BAR;
        PG8_WAIT_V(4); PG8_BAR;
        PG8_STAGE(PG8_SB(1, 0), cB + kstep, voffB); PG8_STAGE(PG8_SA(1, 0), cA + kstep, voffA); PG8_STAGE(PG8_SB(1, 1), cB + hstep + kstep, voffB);
        PG8_WAIT_V(6); PG8_BAR;
    }
    for (;;) {
        const bool has_next = S.next(ui + 1, nxt);
        const char* nA = has_next ? (const char*)g.A + (size_t)nxt.pm * tstep : cA; const char* nB = has_next ? (const char*)g.Bt + (size_t)nxt.pn * tstep : cB;
        for (int t = 0; t < nt; t += 2) {
            const bool last = (t == nt - 2);
            const char* a1 = cA + (size_t)(t + 1) * kstep;
            const char* a2 = last ? nA : cA + (size_t)(t + 2) * kstep; const char* b2 = last ? nB : cB + (size_t)(t + 2) * kstep;
            const char* a3 = a2 + kstep; const char* b3 = b2 + kstep;
            if (last && has_next) S.a_ready(nxt);
            if constexpr (SP2) {
            PG8_LDB(B0, 0, 0); PG8_LDB(B1, 0, 1); PG8_SCHED; PG8_LDA(At, 0, 0); PG8_STAGE(PG8_SA(1, 1), a1 + hstep, voffA);
            PG8_WAIT_V(8); PG8_WAIT_L(0); PG8_BAR; PG8_MMA(0, 0, At, B0); PG8_MMA(0, 1, At, B1); PG8_BAR; PG8_SCHED;
            PG8_LDA(At, 0, 1); PG8_STAGE(PG8_SB(0, 0), b2, voffB); PG8_STAGE(PG8_SB(0, 1), b2 + hstep, voffB); PG8_STAGE(PG8_SA(0, 0), a2, voffA);
            PG8_WAIT_V(8); PG8_WAIT_L(0); PG8_BAR; PG8_MMA(1, 0, At, B0); PG8_MMA(1, 1, At, B1); PG8_BAR; PG8_SCHED;
            PG8_LDB(B0, 1, 0); PG8_LDB(B1, 1, 1); PG8_SCHED; PG8_LDA(At, 1, 0); PG8_STAGE(PG8_SA(0, 1), a2 + hstep, voffA);
            PG8_WAIT_V(8); PG8_WAIT_L(0); PG8_BAR; PG8_MMA(0, 0, At, B0); PG8_MMA(0, 1, At, B1); PG8_BAR; PG8_SCHED;
            PG8_LDA(At, 1, 1); PG8_STAGE(PG8_SB(1, 0), b3, voffB); PG8_STAGE(PG8_SB(1, 1), b3 + hstep, voffB); PG8_STAGE(PG8_SA(1, 0), a3, voffA);
            PG8_WAIT_V(8); PG8_WAIT_L(0); PG8_BAR; PG8_MMA(1, 0, At, B0); PG8_MMA(1, 1, At, B1); PG8_BAR; PG8_SCHED;
            } else {
            PG8_LDB(B0, 0, 0); PG8_SCHED; PG8_LDA(At, 0, 0); PG8_STAGE(PG8_SA(1, 1), a1 + hstep, voffA);
            PG8_WAIT_L(8); PG8_BAR; PG8_WAIT_L(0); PG8_MMA(0, 0, At, B0); PG8_BAR; PG8_SCHED;
            PG8_LDB(B1, 0, 1); PG8_STAGE(PG8_SB(0, 0), b2, voffB);
            PG8_BAR; PG8_WAIT_L(0); PG8_MMA(0, 1, At, B1); PG8_BAR;
            PG8_LDA(At, 0, 1); PG8_STAGE(PG8_SA(0, 0), a2, voffA);
            PG8_BAR; PG8_WAIT_L(0); PG8_MMA(1, 0, At, B0); PG8_BAR; PG8_SCHED;
            PG8_STAGE(PG8_SB(0, 1), b2 + hstep, voffB);
            PG8_WAIT_V(6); PG8_BAR; PG8_MMA(1, 1, At, B1); PG8_BAR;
            PG8_LDB(B0, 1, 0); PG8_SCHED; PG8_LDA(At, 1, 0); PG8_STAGE(PG8_SA(0, 1), a2 + hstep, voffA);
            PG8_WAIT_L(8); PG8_BAR; PG8_WAIT_L(0); PG8_MMA(0, 0, At, B0); PG8_BAR; PG8_SCHED;
            PG8_LDB(B1, 1, 1); PG8_STAGE(PG8_SB(1, 0), b3, voffB);
            PG8_BAR; PG8_WAIT_L(0); PG8_MMA(0, 1, At, B1); PG8_BAR;
            PG8_LDA(At, 1, 1); PG8_STAGE(PG8_SA(1, 0), a3, voffA);
            PG8_BAR; PG8_WAIT_L(0); PG8_MMA(1, 0, At, B0); PG8_BAR; PG8_SCHED;
            PG8_STAGE(PG8_SB(1, 1), b3 + hstep, voffB);
            PG8_WAIT_V(6); PG8_BAR; PG8_MMA(1, 1, At, B1); PG8_BAR;
            }
        }
        if constexpr (ALIGN_EPI) { if (wr == 0) PG8_BAR; }
        if constexpr (!Epi::AFTER_DRAIN) { E(acc, cur, wr, wc, fr, fq); S.done(cur); }
        if (!has_next) break;
#pragma unroll
        for (int a = 0; a < 2; ++a)
#pragma unroll
            for (int b = 0; b < 2; ++b)
#pragma unroll
                for (int m = 0; m < 4; ++m)
#pragma unroll
                    for (int n = 0; n < 2; ++n) acc[a][b][m][n] = (f32x4){0.f, 0.f, 0.f, 0.f};
        cur = nxt; cA = nA; cB = nB; ++ui;
        if constexpr (ALIGN_EPI) { if (wr == 1) PG8_BAR; }
    }
    PG8_WAIT_V(0);
    if constexpr (!ALIGN_EPI) { if (wr == 0) PG8_BAR; }
    PG8_BAR;
    if constexpr (Epi::AFTER_DRAIN) { E.fused(acc, cur, wr, wc, fr, fq, lds, wid, lane); S.done(cur); }
#undef PG8_SA
#undef PG8_SB
#undef PG8_STAGE
#undef PG8_LDA
#undef PG8_LDB
#undef PG8_MMA
#undef PG8_WAIT_V
#undef PG8_WAIT_L
#undef PG8_BAR
#undef PG8_SCHED
}
}

#define LAS __attribute__((address_space(3)))
using pg8::bf16_t; using pg8::bf16x8; using pg8::f32x4; using pg8::u32x4;
typedef float f32x16 __attribute__((ext_vector_type(16)));
typedef float f32x2_t __attribute__((ext_vector_type(2)));
typedef __bf16 bf16x2_t __attribute__((ext_vector_type(2)));
typedef unsigned u32x2 __attribute__((ext_vector_type(2)));

constexpr int DM = 1024, NTOK = 16384, NCTX = 8192, DFF = 2816, DATT = 512, DIN = 4096, NMOD = 9;
constexpr float EPS = 1e-6f, LOG2E = 1.4426950408889634f;
constexpr size_t MiB = 1u << 20;
constexpr size_t WS_FF1IN = 0, WS_FF1OUT = 11 * MiB, WS_FF2IN = 17 * MiB, WS_FF2OUT = 28 * MiB, WS_WIN = 34 * MiB, WS_WBP = 42 * MiB, WS_WBA = 43 * MiB, WS_WOUT = 44 * MiB,
                 WS_WPOOL = 46 * MiB, WS_MOD = 47 * MiB, WS_KC = 48 * MiB, WS_VTC = 50 * MiB;
constexpr size_t WS_H = 52 * MiB;
constexpr size_t WS_ACT = 84 * MiB;
constexpr size_t WS_P = 172 * MiB;
constexpr size_t WS_Q = 204 * MiB;
constexpr size_t WS_K = 220 * MiB;
constexpr size_t WS_VT = 236 * MiB;
constexpr size_t WS_END = 252 * MiB;
static_assert(WS_END <= 256 * MiB, "d_ws map");
constexpr size_t OUT_Y = 0, OUT_K = (size_t)NTOK * DM, OUT_V = OUT_K + (size_t)NCTX * DATT;

__device__ __forceinline__ unsigned pkbf(float lo, float hi) { f32x2_t v = {lo, hi}; bf16x2_t b = __builtin_convertvector(v, bf16x2_t); return __builtin_bit_cast(unsigned, b); }
__device__ __forceinline__ float bflo(unsigned w) { return __uint_as_float(w << 16); }
__device__ __forceinline__ float bfhi(unsigned w) { return __uint_as_float(w & 0xffff0000u); }
__device__ __forceinline__ float fast_sigmoid(float x) { return __builtin_amdgcn_rcpf(1.0f + __builtin_amdgcn_exp2f(-x * LOG2E)); }
__device__ __forceinline__ float wave_sum(float v) {
#pragma unroll
    for (int o = 1; o < 64; o <<= 1) v += __shfl_xor(v, o);
    return v;
}
__device__ __forceinline__ int cond_of_pm(int pm) { return pm < 32 ? 0 : 1 + ((pm - 32) >> 3); }

#define EPI_ROWS(ai, m) (u.pm * 256 + (ai) * 128 + wr * 64 + (m) * 16 + fr)

struct EpiSwiGLU {
    static constexpr bool PERM = true, AFTER_DRAIN = false;
    bf16_t* O;
    __device__ __forceinline__ void operator()(const f32x4 (&acc)[2][2][4][2], const pg8::Unit& u, int wr, int wc, int fr, int fq) const {
        const int col = u.pn * 128 + wc * 32 + 8 * fq;
#pragma unroll
        for (int ai = 0; ai < 2; ++ai)
#pragma unroll
            for (int m = 0; m < 4; ++m) {
                float v[8];
#pragma unroll
                for (int n = 0; n < 2; ++n)
#pragma unroll
                    for (int j = 0; j < 4; ++j) { const float g = acc[ai][0][m][n][j], up = acc[ai][1][m][n][j]; v[4 * n + j] = g * fast_sigmoid(g) * up; }
                u32x4 w; w.x = pkbf(v[0], v[1]); w.y = pkbf(v[2], v[3]); w.z = pkbf(v[4], v[5]); w.w = pkbf(v[6], v[7]);
                *(u32x4*)(O + (size_t)EPI_ROWS(ai, m) * DFF + col) = w;
            }
    }
};
struct EpiResid {
    static constexpr bool PERM = true, AFTER_DRAIN = false;
    const float* base0; const float* base1;
    float* out; const float* mod; int gi; float coef;
    __device__ __forceinline__ void operator()(const f32x4 (&acc)[2][2][4][2], const pg8::Unit& u, int wr, int wc, int fr, int fq) const {
        const float* gv = mod + (size_t)cond_of_pm(u.pm) * (NMOD * DM) + gi * DM;
        const float* base = u.pm < 32 ? base0 : base1 - (size_t)NCTX * DM;
        const int col = u.pn * 256 + wc * 32 + 8 * fq;
        f32x4 g[2][2];
#pragma unroll
        for (int bj = 0; bj < 2; ++bj)
#pragma unroll
            for (int n = 0; n < 2; ++n) g[bj][n] = *(const f32x4*)(gv + col + bj * 128 + 4 * n) * coef;
#pragma unroll
        for (int ai = 0; ai < 2; ++ai)
#pragma unroll
            for (int m = 0; m < 4; ++m) { const size_t off = (size_t)EPI_ROWS(ai, m) * DM + col;
#pragma unroll
                for (int bj = 0; bj < 2; ++bj)
#pragma unroll
                    for (int n = 0; n < 2; ++n) { const f32x4 b = *(const f32x4*)(base + off + bj * 128 + 4 * n); *(f32x4*)(out + off + bj * 128 + 4 * n) = b + g[bj][n] * acc[ai][bj][m][n]; }
            }
    }
};
struct EpiWin {
    static constexpr bool PERM = true, AFTER_DRAIN = false;
    float* P; bf16_t* Q; bf16_t* Kb; bf16_t* VT; bf16_t* Gt; float* outk; float* outv; const float* qgain; const float* kgain;
    __device__ __forceinline__ void operator()(const f32x4 (&acc)[2][2][4][2], const pg8::Unit& u, int wr, int wc, int fr, int fq) const {
        const int pn = u.pn;
        if (pn < 2) {
            const int col = pn * 256 + wc * 32 + 8 * fq;
#pragma unroll
            for (int ai = 0; ai < 2; ++ai)
#pragma unroll
                for (int m = 0; m < 4; ++m) { float* rp = P + (size_t)EPI_ROWS(ai, m) * DATT + col;
#pragma unroll
                    for (int bj = 0; bj < 2; ++bj)
#pragma unroll
                        for (int n = 0; n < 2; ++n) *(f32x4*)(rp + bj * 128 + 4 * n) = acc[ai][bj][m][n]; }
        } else if (pn < 6) {
            const bool isk = pn >= 4;
            const float* gain = isk ? kgain : qgain;
            const int head = 4 * (pn & 1) + wc;
            f32x4 gn[2][2];
#pragma unroll
            for (int bj = 0; bj < 2; ++bj)
#pragma unroll
                for (int n = 0; n < 2; ++n) gn[bj][n] = *(const f32x4*)(gain + 32 * bj + 8 * fq + 4 * n);
            bf16_t* dst = isk ? Kb : Q;
#pragma unroll
            for (int ai = 0; ai < 2; ++ai)
#pragma unroll
                for (int m = 0; m < 4; ++m) {
                    float ss = 0.f;
#pragma unroll
                    for (int bj = 0; bj < 2; ++bj)
#pragma unroll
                        for (int n = 0; n < 2; ++n) { const f32x4 x = acc[ai][bj][m][n]; ss += (x[0] * x[0] + x[1] * x[1]) + (x[2] * x[2] + x[3] * x[3]); }
                    ss += __shfl_xor(ss, 16); ss += __shfl_xor(ss, 32);
                    const float rstd = 1.0f / sqrtf(ss * (1.0f / 64.0f) + EPS);
                    const int row = EPI_ROWS(ai, m);
#pragma unroll
                    for (int bj = 0; bj < 2; ++bj) {
                        const f32x4 a = acc[ai][bj][m][0] * rstd * gn[bj][0], b = acc[ai][bj][m][1] * rstd * gn[bj][1];
                        const int c = head * 64 + 32 * bj + 8 * fq;
                        u32x4 w; w.x = pkbf(a[0], a[1]); w.y = pkbf(a[2], a[3]); w.z = pkbf(b[0], b[1]); w.w = pkbf(b[2], b[3]);
                        *(u32x4*)(dst + (size_t)row * DATT + c) = w;
                        if (isk && u.pm < 32) { *(f32x4*)(outk + (size_t)row * DATT + c) = a; *(f32x4*)(outk + (size_t)row * DATT + c + 4) = b; }
                    }
                }
        } else if (pn < 8) {
            const bool ctx = u.pm < 32;
            const int L = ctx ? 256 : 2048;
            const int bidx = ctx ? u.pm : ((u.pm - 32) >> 3);
            const int t0 = ctx ? 0 : ((u.pm - 32) & 7) * 256;
            bf16_t* vb = VT + (ctx ? (size_t)0 : (size_t)32 * 8 * 64 * 256) + (size_t)bidx * 8 * 64 * L;
#pragma unroll
            for (int ai = 0; ai < 2; ++ai)
#pragma unroll
                for (int m = 0; m < 4; ++m) {
                    const int rl = ai * 128 + wr * 64 + m * 16 + fr, row = u.pm * 256 + rl, t = t0 + rl;
#pragma unroll
                    for (int bj = 0; bj < 2; ++bj) {
                        const int c = (pn - 6) * 256 + bj * 128 + wc * 32 + 8 * fq;
                        const f32x4 a = acc[ai][bj][m][0], b = acc[ai][bj][m][1];
                        bf16_t* vp = vb + (size_t)c * L + t;
                        const unsigned w0 = pkbf(a[0], a[1]), w1 = pkbf(a[2], a[3]), w2 = pkbf(b[0], b[1]), w3 = pkbf(b[2], b[3]);
                        vp[0] = (bf16_t)w0; vp[(size_t)L] = (bf16_t)(w0 >> 16); vp[(size_t)2 * L] = (bf16_t)w1; vp[(size_t)3 * L] = (bf16_t)(w1 >> 16);
                        vp[(size_t)4 * L] = (bf16_t)w2; vp[(size_t)5 * L] = (bf16_t)(w2 >> 16); vp[(size_t)6 * L] = (bf16_t)w3; vp[(size_t)7 * L] = (bf16_t)(w3 >> 16);
                        if (ctx) { *(f32x4*)(outv + (size_t)row * DATT + c) = a; *(f32x4*)(outv + (size_t)row * DATT + c + 4) = b; }
                    }
                }
        } else {
            const int col = (pn - 8) * 256 + wc * 32 + 8 * fq;
#pragma unroll
            for (int ai = 0; ai < 2; ++ai)
#pragma unroll
                for (int m = 0; m < 4; ++m) { bf16_t* rp = Gt + (size_t)EPI_ROWS(ai, m) * 2048 + col;
#pragma unroll
                    for (int bj = 0; bj < 2; ++bj) { const f32x4 a = acc[ai][bj][m][0], b = acc[ai][bj][m][1];
                        u32x4 w; w.x = pkbf(fast_sigmoid(a[0]), fast_sigmoid(a[1])); w.y = pkbf(fast_sigmoid(a[2]), fast_sigmoid(a[3]));
                        w.z = pkbf(fast_sigmoid(b[0]), fast_sigmoid(b[1])); w.w = pkbf(fast_sigmoid(b[2]), fast_sigmoid(b[3]));
                        *(u32x4*)(rp + bj * 128) = w; }
                }
        }
    }
};
template <int MODE> struct EpiMix {
    static constexpr bool PERM = true, AFTER_DRAIN = false;
    bf16_t* O; int ldo; const float* vec; const bf16_t* Gt; const bf16_t* T1;
    __device__ __forceinline__ void operator()(const f32x4 (&acc)[2][2][4][2], const pg8::Unit& u, int wr, int wc, int fr, int fq) const {
        const int col = u.pn * 256 + wc * 32 + 8 * fq;
        f32x4 sv[2][2];
        if (MODE == 0) {
#pragma unroll
            for (int bj = 0; bj < 2; ++bj)
#pragma unroll
                for (int n = 0; n < 2; ++n) sv[bj][n] = *(const f32x4*)(vec + col + bj * 128 + 4 * n);
        }
#pragma unroll
        for (int ai = 0; ai < 2; ++ai)
#pragma unroll
            for (int m = 0; m < 4; ++m) { const int row = EPI_ROWS(ai, m);
#pragma unroll
                for (int bj = 0; bj < 2; ++bj) {
                    f32x4 a = acc[ai][bj][m][0], b = acc[ai][bj][m][1];
                    const int c = col + bj * 128;
                    if (MODE == 0) { a = a * sv[bj][0]; b = b * sv[bj][1]; }
                    else {
                        const u32x4 gw = *(const u32x4*)(Gt + (size_t)row * 2048 + (MODE == 2 ? 1024 : 0) + c);
                        const f32x4 ga = {bflo(gw.x), bfhi(gw.x), bflo(gw.y), bfhi(gw.y)}, gb = {bflo(gw.z), bfhi(gw.z), bflo(gw.w), bfhi(gw.w)};
                        a = a * ga; b = b * gb;
                        if (MODE == 2) { const u32x4 tw = *(const u32x4*)(T1 + (size_t)row * DM + c);
                            a = a + (f32x4){bflo(tw.x), bfhi(tw.x), bflo(tw.y), bfhi(tw.y)}; b = b + (f32x4){bflo(tw.z), bfhi(tw.z), bflo(tw.w), bfhi(tw.w)}; }
                    }
                    u32x4 w; w.x = pkbf(a[0], a[1]); w.y = pkbf(a[2], a[3]); w.z = pkbf(b[0], b[1]); w.w = pkbf(b[2], b[3]);
                    *(u32x4*)(O + (size_t)row * ldo + c) = w;
                }
            }
    }
};

__device__ __forceinline__ unsigned f2bf(float f) { unsigned u = __builtin_bit_cast(unsigned, f); return (u + 0x7fffu + ((u >> 16) & 1u)) >> 16; }
__device__ __forceinline__ unsigned pk2(float lo, float hi) { return f2bf(lo) | (f2bf(hi) << 16); }
__device__ __forceinline__ int dest_row(int mode, int n) {
    if (mode == 1) { const int up = n >= DFF, j = up ? n - DFF : n; return 256 * (j >> 7) + (up ? 128 : 0) + (j & 127); }
    if (mode == 2) { if (n >= 512 && n < 1536) { const int tb = n & ~255, cc = n & 255, hh = cc >> 6, d = cc & 63; return tb + 128 * (d >> 5) + 32 * hh + (d & 31); } return n; }
    return n;
}
__device__ __forceinline__ void tr_item(const float* W, int N, bf16_t* WT, int ldt, int mode, LAS float* scr, int item, int lane) {
    const int nblk = N / 32, kb = item / nblk, nb = item % nblk, k0 = 64 * kb, n0 = 32 * nb;
#pragma unroll 8
    for (int i = 0; i < 32; ++i) { const int kk = 2 * i + (lane >> 5); scr[kk * 33 + (lane & 31)] = W[(size_t)(k0 + kk) * N + n0 + (lane & 31)]; }
    asm volatile("s_waitcnt lgkmcnt(0)" ::: "memory");
    const int c = lane & 7;
#pragma unroll
    for (int j = 0; j < 4; ++j) { const int n = (lane >> 3) + 8 * j; const LAS float* s = scr + (8 * c) * 33 + n;
        u32x4 o; o.x = pk2(s[0 * 33], s[1 * 33]); o.y = pk2(s[2 * 33], s[3 * 33]); o.z = pk2(s[4 * 33], s[5 * 33]); o.w = pk2(s[6 * 33], s[7 * 33]);
        *(u32x4*)(WT + (size_t)dest_row(mode, n0 + n) * ldt + k0 + 8 * c) = o; }
    asm volatile("s_waitcnt lgkmcnt(0)" ::: "memory");
}

struct Args { const float* in[24]; float* out; unsigned char* ws; int ph_lo, ph_hi; };
enum { I_XP = 0, I_XS, I_CK, I_CV, I_C, I_CCTX, I_WADA, I_BADA, I_GFF1, I_WFF1IN, I_WFF1OUT, I_GMIX, I_WIN, I_QG, I_KG, I_WPOOL, I_PSCALE, I_RPB, I_WBP, I_WBA, I_WOUT, I_GFF2, I_WFF2IN, I_WFF2OUT };

__device__ __forceinline__ void phase0(const Args& a, LAS unsigned char* lds, int tid, int lane, int wave, int G) {
    unsigned char* ws = a.ws;
    if ((int)blockIdx.x < 144) {
        LAS float* sc = (LAS float*)lds; LAS float* red = sc + 5 * 1024;
        for (int i = tid; i < 5 * 1024; i += 512) { const float v = i < 1024 ? a.in[I_CCTX][i] : a.in[I_C][i - 1024]; sc[i] = v * fast_sigmoid(v); }
        __syncthreads();
        float* mod = (float*)(ws + WS_MOD);
        for (int u = blockIdx.x; u < 144; u += G) {
            float acc[5] = {0.f, 0.f, 0.f, 0.f, 0.f};
            const float* wp = a.in[I_WADA] + (size_t)(wave * 128) * (NMOD * DM) + u * 64 + lane;
#pragma unroll 2
            for (int k = 0; k < 128; k += 4) {
                const float w0 = wp[(size_t)(k + 0) * (NMOD * DM)], w1 = wp[(size_t)(k + 1) * (NMOD * DM)], w2 = wp[(size_t)(k + 2) * (NMOD * DM)], w3 = wp[(size_t)(k + 3) * (NMOD * DM)];
#pragma unroll
                for (int c = 0; c < 5; ++c) { const f32x4 s = *(const LAS f32x4*)(sc + c * 1024 + wave * 128 + k); acc[c] += (s[0] * w0 + s[1] * w1) + (s[2] * w2 + s[3] * w3); }
            }
#pragma unroll
            for (int c = 0; c < 5; ++c) red[(wave * 5 + c) * 64 + lane] = acc[c];
            __syncthreads();
            if (tid < 320) { const int c = tid >> 6, l = tid & 63; float s = 0.f;
#pragma unroll
                for (int w = 0; w < 8; ++w) s += red[(w * 5 + c) * 64 + l];
                mod[c * (NMOD * DM) + u * 64 + l] = s + a.in[I_BADA][u * 64 + l]; }
            __syncthreads();
        }
    }
    LAS float* scr = (LAS float*)(lds + wave * 16384);
    const int gw = blockIdx.x * 8 + wave, NGW = G * 8;
    constexpr int I_FIN = 16 * 176, I_FOUT = 44 * 32, I_IN = 16 * 128, I_BR = 8 * 32, I_OUT = 16 * 32, I_PL = 8, I_CVI = 8 * 16;
    constexpr int NITEMS = 2 * I_FIN + 2 * I_FOUT + I_IN + 2 * I_BR + I_OUT + 4 * I_PL + 4 * I_CVI;
    for (int it = gw; it < NITEMS; it += NGW) {
        int r = it;
        if (r < I_FIN) { tr_item(a.in[I_WFF1IN], 2 * DFF, (bf16_t*)(ws + WS_FF1IN), DM, 1, scr, r, lane); continue; } r -= I_FIN;
        if (r < I_FIN) { tr_item(a.in[I_WFF2IN], 2 * DFF, (bf16_t*)(ws + WS_FF2IN), DM, 1, scr, r, lane); continue; } r -= I_FIN;
        if (r < I_FOUT) { tr_item(a.in[I_WFF1OUT], DM, (bf16_t*)(ws + WS_FF1OUT), DFF, 0, scr, r, lane); continue; } r -= I_FOUT;
        if (r < I_FOUT) { tr_item(a.in[I_WFF2OUT], DM, (bf16_t*)(ws + WS_FF2OUT), DFF, 0, scr, r, lane); continue; } r -= I_FOUT;
        if (r < I_IN) { tr_item(a.in[I_WIN], DIN, (bf16_t*)(ws + WS_WIN), DM, 2, scr, r, lane); continue; } r -= I_IN;
        if (r < I_BR) { tr_item(a.in[I_WBP], DM, (bf16_t*)(ws + WS_WBP), DATT, 0, scr, r, lane); continue; } r -= I_BR;
        if (r < I_BR) { tr_item(a.in[I_WBA], DM, (bf16_t*)(ws + WS_WBA), DATT, 0, scr, r, lane); continue; } r -= I_BR;
        if (r < I_OUT) { tr_item(a.in[I_WOUT], DM, (bf16_t*)(ws + WS_WOUT), DM, 0, scr, r, lane); continue; } r -= I_OUT;
        if (r < 4 * I_PL) { const int g = r / I_PL; tr_item(a.in[I_WPOOL] + (size_t)g * 128 * 128, 128, (bf16_t*)(ws + WS_WPOOL) + (size_t)(g * 128) * 512 + g * 128, 512, 0, scr, r % I_PL, lane); continue; } r -= 4 * I_PL;
        { const int b = r / I_CVI; tr_item(a.in[I_CV] + (size_t)b * 512 * 512, 512, (bf16_t*)(ws + WS_VTC) + (size_t)b * 512 * 512, 512, 0, scr, r % I_CVI, lane); }
    }
    const int gt = blockIdx.x * 512 + tid, NGT = G * 512;
    for (int i = gt; i < 4 * 512 * 512 / 4; i += NGT) { const f32x4 v = *(const f32x4*)(a.in[I_CK] + (size_t)i * 4); u32x2 o; o.x = pk2(v[0], v[1]); o.y = pk2(v[2], v[3]); *(u32x2*)((bf16_t*)(ws + WS_KC) + (size_t)i * 4) = o; }
    for (int i = gt; i < 512 * 64; i += NGT) { const int row = i >> 6, col = (i & 63) * 8; if ((row >> 7) != (col >> 7)) *(u32x4*)((bf16_t*)(ws + WS_WPOOL) + (size_t)row * 512 + col) = (u32x4){0u, 0u, 0u, 0u}; }
}

__device__ __forceinline__ void norm_phase(const float* src0, const float* src1, const float* gvec, const float* mod, int mi, bf16_t* H, int G, int wave, int lane) {
    for (int rb = blockIdx.x; rb < NTOK / 64; rb += G) {
        const int rbase = rb * 64, cond = rbase < NCTX ? 0 : 1 + ((rbase - NCTX) >> 11);
        const float* sh = mod + (size_t)cond * (NMOD * DM) + mi * DM; const float* scl = sh + DM;
        f32x4 av[4], sv[4];
#pragma unroll
        for (int j = 0; j < 4; ++j) { const int c = 4 * lane + 256 * j; av[j] = *(const f32x4*)(gvec + c) * (*(const f32x4*)(scl + c) + 1.0f); sv[j] = *(const f32x4*)(sh + c); }
        for (int i = 0; i < 8; ++i) {
            const int row = rbase + wave * 8 + i;
            const float* xr = row < NCTX ? src0 + (size_t)row * DM : src1 + (size_t)(row - NCTX) * DM;
            f32x4 v[4]; float s = 0.f;
#pragma unroll
            for (int j = 0; j < 4; ++j) { v[j] = *(const f32x4*)(xr + 4 * lane + 256 * j); s += (v[j][0] * v[j][0] + v[j][1] * v[j][1]) + (v[j][2] * v[j][2] + v[j][3] * v[j][3]); }
            const float rstd = 1.0f / sqrtf(wave_sum(s) * (1.0f / DM) + EPS);
#pragma unroll
            for (int j = 0; j < 4; ++j) { const f32x4 o = v[j] * rstd * av[j] + sv[j]; u32x2 w; w.x = pkbf(o[0], o[1]); w.y = pkbf(o[2], o[3]); *(u32x2*)(H + (size_t)row * DM + 4 * lane + 256 * j) = w; }
        }
    }
}

__device__ __forceinline__ int crow(int r, int hh) { return (r & 3) + 8 * (r >> 2) + 4 * hh; }
#define MFMA32(a, b, c) __builtin_amdgcn_mfma_f32_32x32x16_bf16((a), (b), (c), 0, 0, 0)
struct KVFrag { bf16x8 k[4]; u32x2 v[2][2][2]; };
__device__ __forceinline__ void kv_load(KVFrag& f, const bf16_t* kp, const bf16_t* vp, int L, int r32, int hh) {
#pragma unroll
    for (int d0 = 0; d0 < 4; ++d0) f.k[d0] = *(const bf16x8*)(kp + (size_t)r32 * DATT + d0 * 16 + 8 * hh);
#pragma unroll
    for (int t = 0; t < 2; ++t)
#pragma unroll
        for (int s = 0; s < 2; ++s) { const bf16_t* p = vp + (size_t)(32 * t + r32) * L + 16 * s + 4 * hh;
            f.v[t][s][0] = *(const u32x2*)p; f.v[t][s][1] = *(const u32x2*)(p + 8); }
}
__device__ __forceinline__ void attn_wave(const bf16_t* Qp, bf16_t* Op, int nd, const bf16_t* Kd, const bf16_t* Vtd, int Ld,
                                          int nl, const bf16_t* Kl, const bf16_t* Vtl, int rq, int r0, int g, const LAS float* rpbh, int lane) {
    const int r32 = lane & 31, hh = lane >> 5;
    constexpr float C2 = 0.125f * LOG2E;
    bf16x8 qf[4];
#pragma unroll
    for (int d0 = 0; d0 < 4; ++d0) qf[d0] = *(const bf16x8*)(Qp + (size_t)r32 * DATT + d0 * 16 + 8 * hh);
    f32x16 o0, o1;
#pragma unroll
    for (int r = 0; r < 16; ++r) { o0[r] = 0.f; o1[r] = 0.f; }
    float mrun = -1e30f, lrun = 0.f;
    const int nt = nd + nl;
    const int qc = 32 * g + r32; int c0 = qc - 8; c0 = c0 < 0 ? 0 : (c0 > 48 ? 48 : c0);
    KVFrag cur, nxt;
    kv_load(cur, Kd, Vtd, Ld, r32, hh);
    for (int ti = 0; ti < nt; ++ti) {
        const int tn = ti + 1;
        if (tn < nt) {
            if (tn < nd) kv_load(nxt, Kd + (size_t)tn * 32 * DATT, Vtd + tn * 32, Ld, r32, hh);
            else { const int tl = tn - nd, tok = (r0 + (tl >> 1)) * 64 + 32 * (tl & 1); kv_load(nxt, Kl + (size_t)tok * DATT, Vtl + tok, 2048, r32, hh); }
        }
        f32x16 s;
#pragma unroll
        for (int r = 0; r < 16; ++r) s[r] = 0.f;
#pragma unroll
        for (int d0 = 0; d0 < 4; ++d0) s = MFMA32(cur.k[d0], qf[d0], s);
        if (ti >= nd) {
            const int tl = ti - nd, kr = r0 + (tl >> 1), kc0 = 32 * (tl & 1);
            const LAS float* bp = rpbh + (kr - rq + 7) * 31;
#pragma unroll
            for (int r = 0; r < 16; ++r) { const int kc = kc0 + crow(r, hh); int rel = kc - qc + 15; rel = rel < 0 ? 0 : (rel > 30 ? 30 : rel);
                const bool ok = kc >= c0 && kc < c0 + 16; const float b = bp[rel]; s[r] = ok ? s[r] * C2 + b : -1e30f; }
        } else {
#pragma unroll
            for (int r = 0; r < 16; ++r) s[r] *= C2;
        }
        float mx = s[0];
#pragma unroll
        for (int r = 1; r < 16; ++r) mx = fmaxf(mx, s[r]);
        mx = fmaxf(mx, __shfl_xor(mx, 32));
        const float mnew = fmaxf(mrun, mx), alpha = __builtin_amdgcn_exp2f(mrun - mnew);
        mrun = mnew;
        float ps = 0.f;
#pragma unroll
        for (int r = 0; r < 16; ++r) { s[r] = __builtin_amdgcn_exp2f(s[r] - mnew); ps += s[r]; }
        lrun = lrun * alpha + ps;
#pragma unroll
        for (int r = 0; r < 16; ++r) { o0[r] *= alpha; o1[r] *= alpha; }
        u32x4 p0, p1;
        p0.x = pkbf(s[0], s[1]); p0.y = pkbf(s[2], s[3]); p0.z = pkbf(s[4], s[5]); p0.w = pkbf(s[6], s[7]);
        p1.x = pkbf(s[8], s[9]); p1.y = pkbf(s[10], s[11]); p1.z = pkbf(s[12], s[13]); p1.w = pkbf(s[14], s[15]);
        const bf16x8 pb0 = __builtin_bit_cast(bf16x8, p0), pb1 = __builtin_bit_cast(bf16x8, p1);
#define VFRAG(t, s_) __builtin_bit_cast(bf16x8, (u32x4){cur.v[t][s_][0].x, cur.v[t][s_][0].y, cur.v[t][s_][1].x, cur.v[t][s_][1].y})
        o0 = MFMA32(VFRAG(0, 0), pb0, o0); o0 = MFMA32(VFRAG(0, 1), pb1, o0);
        o1 = MFMA32(VFRAG(1, 0), pb0, o1); o1 = MFMA32(VFRAG(1, 1), pb1, o1);
#undef VFRAG
        cur = nxt;
    }
    lrun += __shfl_xor(lrun, 32);
    const float inv = 1.0f / lrun;
    bf16_t* op = Op + (size_t)r32 * DATT + 4 * hh;
#pragma unroll
    for (int rg = 0; rg < 4; ++rg) {
        u32x2 w; w.x = pkbf(o0[4 * rg] * inv, o0[4 * rg + 1] * inv); w.y = pkbf(o0[4 * rg + 2] * inv, o0[4 * rg + 3] * inv); *(u32x2*)(op + 8 * rg) = w;
        u32x2 x; x.x = pkbf(o1[4 * rg] * inv, o1[4 * rg + 1] * inv); x.y = pkbf(o1[4 * rg + 2] * inv, o1[4 * rg + 3] * inv); *(u32x2*)(op + 32 + 8 * rg) = x;
    }
}

__device__ __forceinline__ void mixer_phase(const Args& a, LAS unsigned char* lds, int tid, int lane, int wave, int G) {
    unsigned char* ws = a.ws;
    const bf16_t* Q = (const bf16_t*)(ws + WS_Q); const bf16_t* Kb = (const bf16_t*)(ws + WS_K); const bf16_t* VT = (const bf16_t*)(ws + WS_VT);
    const bf16_t* KC = (const bf16_t*)(ws + WS_KC); const bf16_t* VTC = (const bf16_t*)(ws + WS_VTC);
    bf16_t* ATT = (bf16_t*)(ws + WS_H);
    LAS float* rpbl = (LAS float*)lds;
    for (int i = tid; i < 8 * 15 * 31; i += 512) rpbl[i] = a.in[I_RPB][i] * LOG2E;
    __syncthreads();
    for (int u = blockIdx.x; u < 256; u += G) {
        {
            const int b = u >> 6, h = (u >> 3) & 7, rq = 4 * (u & 7) + (wave >> 1), g = wave & 1;
            int r0 = rq - 4; r0 = r0 < 0 ? 0 : (r0 > 24 ? 24 : r0);
            const size_t row0 = (size_t)NCTX + (size_t)b * 2048 + rq * 64 + 32 * g;
            attn_wave(Q + row0 * DATT + h * 64, ATT + row0 * DATT + h * 64, 16, KC + (size_t)b * 512 * DATT + h * 64, VTC + (size_t)(b * 8 + h) * 64 * 512, 512,
                      16, Kb + ((size_t)NCTX + (size_t)b * 2048) * DATT + h * 64, VT + (size_t)32 * 8 * 64 * 256 + (size_t)(b * 8 + h) * 64 * 2048, rq, r0, g, rpbl + h * 15 * 31, lane);
        }
        {
            const int b = u >> 3, h = u & 7;
            const size_t row0 = (size_t)b * 256 + 32 * wave;
            attn_wave(Q + row0 * DATT + h * 64, ATT + row0 * DATT + h * 64, 8, Kb + (size_t)b * 256 * DATT + h * 64, VT + (size_t)(b * 8 + h) * 64 * 256, 256,
                      0, Kb, VT, 0, 0, 0, rpbl, lane);
        }
    }
    const float* P = (const float*)(ws + WS_P); bf16_t* D = (bf16_t*)(ws + WS_ACT + 64 * MiB);
    const int gw = blockIdx.x * 8 + wave, NGW = G * 8;
    for (int row = gw; row < NTOK; row += NGW) {
        int t, L; if (row < NCTX) { t = row & 255; L = 256; } else { t = (row - NCTX) & 2047; L = 2048; }
        const int hw = 1 << (lane >> 4);
        int lo = t - hw; lo = lo < 0 ? 0 : lo; int hi = t + hw; hi = hi > L ? L : hi;
        const float* pr = P + (size_t)(row - t) * DATT + 8 * lane;
        f32x4 s0 = {0.f, 0.f, 0.f, 0.f}, s1 = {0.f, 0.f, 0.f, 0.f};
        for (int i = lo; i < hi; ++i) { s0 += *(const f32x4*)(pr + (size_t)i * DATT); s1 += *(const f32x4*)(pr + (size_t)i * DATT + 4); }
        const float rc = 1.0f / (float)(hi - lo);
        const f32x4 c0 = *(const f32x4*)(pr + (size_t)t * DATT), c1 = *(const f32x4*)(pr + (size_t)t * DATT + 4);
        const f32x4 d0 = s0 * rc - c0, d1 = s1 * rc - c1;
        u32x4 w; w.x = pkbf(d0[0], d0[1]); w.y = pkbf(d0[2], d0[3]); w.z = pkbf(d1[0], d1[1]); w.w = pkbf(d1[2], d1[3]);
        *(u32x4*)(D + (size_t)row * DATT + 8 * lane) = w;
    }
}

constexpr int LDS_BYTES = 147456;
__global__ void __launch_bounds__(512, 2) mk_fwd(Args args) {
    extern __shared__ __attribute__((aligned(16))) unsigned char lds_raw[];
    LAS unsigned char* lds = (LAS unsigned char*)lds_raw;
    cg::grid_group grid = cg::this_grid();
    const int tid = threadIdx.x, lane = tid & 63, wave = __builtin_amdgcn_readfirstlane(tid >> 6), G = gridDim.x;
    unsigned char* ws = args.ws;
    const int lo = args.ph_lo, hi = args.ph_hi;
    const float* mod = (const float*)(ws + WS_MOD);
    float* Y = args.out + OUT_Y;
    bf16_t* H = (bf16_t*)(ws + WS_H); bf16_t* ACT = (bf16_t*)(ws + WS_ACT);
#define IN(k) (lo <= (k) && (k) < hi)
#define SEAM(k) do { if (IN(k) && IN((k) + 1)) grid.sync(); } while (0)
#define GEMM_PHASE(EPI, e, Aptr, Bptr, N_, K_) do { pg8::Gemm g_{(const bf16_t*)(Aptr), (const bf16_t*)(Bptr), NTOK, (N_), (K_)}; pg8::StaticOrder S_; S_.init(NTOK, (N_), G, (int)blockIdx.x); \
        pg8::gemm_phase<EPI, pg8::StaticOrder, true, true>(lds, g_, S_, e); } while (0)

    if (IN(0)) { phase0(args, lds, tid, lane, wave, G); } SEAM(0);
    if (IN(1)) { norm_phase(args.in[I_XP], args.in[I_XS], args.in[I_GFF1], mod, 0, H, G, wave, lane); } SEAM(1);
    if (IN(2)) { EpiSwiGLU e{ACT}; GEMM_PHASE(EpiSwiGLU, e, H, ws + WS_FF1IN, 2 * DFF, DM); } SEAM(2);
    if (IN(3)) { EpiResid e{args.in[I_XP], args.in[I_XS], Y, mod, 2, 0.5f}; GEMM_PHASE(EpiResid, e, ACT, ws + WS_FF1OUT, DM, DFF); } SEAM(3);
    if (IN(4)) { norm_phase(Y, Y + (size_t)NCTX * DM, args.in[I_GMIX], mod, 3, H, G, wave, lane); } SEAM(4);
    if (IN(5)) { EpiWin e{(float*)(ws + WS_P), (bf16_t*)(ws + WS_Q), (bf16_t*)(ws + WS_K), (bf16_t*)(ws + WS_VT), ACT, args.out + OUT_K, args.out + OUT_V, args.in[I_QG], args.in[I_KG]};
                 GEMM_PHASE(EpiWin, e, H, ws + WS_WIN, DIN, DM); } SEAM(5);
    if (IN(6)) { mixer_phase(args, lds, tid, lane, wave, G); } SEAM(6);
    if (IN(7)) { EpiMix<0> e{H + (size_t)NTOK * DATT, DATT, args.in[I_PSCALE], nullptr, nullptr}; GEMM_PHASE(EpiMix<0>, e, ws + WS_ACT + 64 * MiB, ws + WS_WPOOL, DATT, DATT); } SEAM(7);
    if (IN(8)) { { EpiMix<1> e{(bf16_t*)(ws + WS_K), DM, nullptr, ACT, nullptr}; GEMM_PHASE(EpiMix<1>, e, H + (size_t)NTOK * DATT, ws + WS_WBP, DM, DATT); }
                 { EpiMix<2> e{(bf16_t*)(ws + WS_P), DM, nullptr, ACT, (const bf16_t*)(ws + WS_K)}; GEMM_PHASE(EpiMix<2>, e, H, ws + WS_WBA, DM, DATT); } } SEAM(8);
    if (IN(9)) { EpiResid e{Y, Y + (size_t)NCTX * DM, Y, mod, 5, 1.0f}; GEMM_PHASE(EpiResid, e, ws + WS_P, ws + WS_WOUT, DM, DM); } SEAM(9);
    if (IN(10)) { norm_phase(Y, Y + (size_t)NCTX * DM, args.in[I_GFF2], mod, 6, H, G, wave, lane); } SEAM(10);
    if (IN(11)) { EpiSwiGLU e{ACT}; GEMM_PHASE(EpiSwiGLU, e, H, ws + WS_FF2IN, 2 * DFF, DM); } SEAM(11);
    if (IN(12)) { EpiResid e{Y, Y + (size_t)NCTX * DM, Y, mod, 8, 0.5f}; GEMM_PHASE(EpiResid, e, ACT, ws + WS_FF2OUT, DM, DFF); }
}

#ifndef MK_PER_PHASE
#define MK_PER_PHASE 1
#endif
extern "C" void kernel_launch(void* const* d_in, const int* in_sizes, int n_in, void* d_out, int out_size, void* d_ws, size_t ws_size, hipStream_t stream) {
    static int grid = 0;
    if (grid == 0) {
        if (n_in != 24 || ws_size < WS_END) { fprintf(stderr, "kernel_launch: unexpected n_in %d / ws_size %zu (need %zu)\n", n_in, ws_size, (size_t)WS_END); grid = -1; return; }
        int dev = 0, cus = 0, per_cu = 0;
        hipGetDevice(&dev); hipDeviceGetAttribute(&cus, hipDeviceAttributeMultiprocessorCount, dev);
        if (hipFuncSetAttribute((const void*)mk_fwd, hipFuncAttributeMaxDynamicSharedMemorySize, LDS_BYTES) != hipSuccess) { fprintf(stderr, "kernel_launch: hipFuncSetAttribute failed\n"); grid = -1; return; }
        if (hipOccupancyMaxActiveBlocksPerMultiprocessor(&per_cu, (const void*)mk_fwd, 512, LDS_BYTES) != hipSuccess || per_cu < 1) { fprintf(stderr, "kernel_launch: occupancy query says %d\n", per_cu); per_cu = 1; }
        (void)hipGetLastError();
        grid = cus * per_cu;
        fprintf(stderr, "kernel_launch: grid %d (cus %d x %d), ws %zu\n", grid, cus, per_cu, ws_size);
    }
    if (grid < 0) return;
    Args a{};
    for (int i = 0; i < 24; ++i) a.in[i] = (const float*)d_in[i];
    a.out = (float*)d_out; a.ws = (unsigned char*)d_ws;
#if MK_PER_PHASE
    for (int p = 0; p < 13; ++p) { a.ph_lo = p; a.ph_hi = p + 1; hipLaunchKernelGGL(mk_fwd, dim3(grid), dim3(512), LDS_BYTES, stream, a); }
#else
    a.ph_lo = 0; a.ph_hi = 13;
    void* kargs[] = {&a};
    hipError_t e = hipLaunchCooperativeKernel((const void*)mk_fwd, dim3(grid), dim3(512), kargs, LDS_BYTES, stream);
    if (e != hipSuccess) fprintf(stderr, "kernel_launch: cooperative launch failed: %s (grid %d)\n", hipGetErrorString(e), grid);
#endif
}
```

```cpp
#include <hip/hip_runtime.h>
#include <hip/hip_cooperative_groups.h>
#include <cstdio>
#include <cstdint>
namespace cg = cooperative_groups;
namespace pg8 {
#define PG8_LAS __attribute__((address_space(3)))
typedef unsigned short bf16_t;
typedef short bf16x8 __attribute__((ext_vector_type(8)));
typedef float f32x4 __attribute__((ext_vector_type(4)));
typedef unsigned u32x4 __attribute__((ext_vector_type(4)));
constexpr int BM = 256, BK = 64, HALF = 128, HTB = HALF * BK * 2  , STAGE_BYTES = 8 * HTB, NXCD = 8, WGM = 8;

__host__ __device__ __forceinline__ int lds_byte(int r, int c) { const int st = (r >> 4) * 2 + (c >> 5), rr = r & 15, cc = c & 31, ob = rr * 64 + cc * 2; return st * 1024 + (ob ^ (((ob >> 9) & 1) << 5)); }
__host__ __device__ __forceinline__ void stage_rc(int b, int& R, int& C) { const int st = b / 1024, sb = b % 1024, swz = sb ^ (((sb >> 9) & 1) << 5); R = (st >> 1) * 16 + swz / 64; C = (st & 1) * 32 + (swz % 64) / 2; }
__host__ __device__ __forceinline__ int perm32(int rho) { const int n = rho >> 4, i = rho & 15; return 8 * (i >> 2) + 4 * n + (i & 3); }

struct Unit { int pm, pn, ord; };
struct Gemm { const bf16_t* A; const bf16_t* Bt; int M, N, K; };

struct StaticOrder {
    int nM, nN, nwg, G, c;
    __host__ __device__ void init(int M, int N, int G_, int c_) { nM = M / BM; nN = N / BM; nwg = nM * nN; G = G_; c = c_; }
    __host__ __device__ bool next(int i, Unit& u) const {
        const long L = (long)i * G + c; if (L >= nwg) return false;
        int wgid = (int)L; { const int q = nwg / NXCD, r = nwg % NXCD, xcd = wgid % NXCD, off = wgid / NXCD; wgid = (xcd < r ? xcd * (q + 1) : r * (q + 1) + (xcd - r) * q) + off; }
        const int nig = WGM * nN, gid = wgid / nig, fm = gid * WGM, gsz = (nM - fm) < WGM ? (nM - fm) : WGM;
        u.pm = fm + ((wgid % nig) % gsz); u.pn = (wgid % nig) / gsz; u.ord = i; return true;
    }
    __device__ __forceinline__ void a_ready(const Unit&) const {}
    __device__ __forceinline__ void done(const Unit&) const {}
};

__device__ __forceinline__ unsigned cvt_pk_bf16(float lo, float hi) { unsigned r; asm volatile("v_cvt_pk_bf16_f32 %0, %1, %2" : "=v"(r) : "v"(lo), "v"(hi)); return r; }
template <class Epi, class Sched, bool ALIGN_EPI = false, bool SP2 = false>
__device__ __forceinline__ void gemm_phase(PG8_LAS unsigned char* lds, const Gemm g, const Sched S, const Epi E) {
    const int tid = threadIdx.x, wid = __builtin_amdgcn_readfirstlane(tid >> 6), lane = tid & 63, wr = wid >> 2, wc = wid & 3, fr = lane & 15, fq = lane >> 4;
    const int K = g.K, nt = K / BK;
    unsigned voffA[2], voffB[2];
#pragma unroll
    for (int i = 0; i < 2; ++i) { int R, C; stage_rc(tid * 16 + i * 8192, R, C); const int Rb = Epi::PERM ? ((R & ~31) + perm32(R & 31)) : R;
        voffA[i] = (unsigned)(R * K + C) * 2u; voffB[i] = (unsigned)(Rb * K + C) * 2u; }
    const size_t kstep = (size_t)(BK * 2);
    const size_t hstep = (size_t)HALF * K * 2;
    const size_t tstep = 2 * hstep;
    const unsigned ldsw = (unsigned)wid * 1024u;
    const int aoff = lds_byte(wr * 64 + fr, fq * 8), boff = lds_byte(wc * 32 + fr, fq * 8);
#define PG8_SA(b, h) (((b) * 2 + (h)) * HTB)
#define PG8_SB(b, h) ((4 + (b) * 2 + (h)) * HTB)
#define PG8_STAGE(bufoff, gbase, voff) do { _Pragma("unroll") for (int _i = 0; _i < 2; ++_i) \
        __builtin_amdgcn_global_load_lds((const unsigned*)((const char*)(gbase) + (voff)[_i]), (PG8_LAS unsigned*)(lds + (bufoff) + ldsw + _i * 8192), 16, 0, 0); } while (0)
#define PG8_LDA(dst, b, h) do { _Pragma("unroll") for (int m = 0; m < 4; ++m) _Pragma("unroll") for (int k = 0; k < 2; ++k) dst[m][k] = *(const PG8_LAS bf16x8*)(lds + PG8_SA(b, h) + aoff + m * 2048 + k * 1024); } while (0)
#define PG8_LDB(dst, b, h) do { _Pragma("unroll") for (int n = 0; n < 2; ++n) _Pragma("unroll") for (int k = 0; k < 2; ++k) dst[n][k] = *(const PG8_LAS bf16x8*)(lds + PG8_SB(b, h) + boff + n * 2048 + k * 1024); } while (0)
#define PG8_MMA(ai, bj, At, Bt) do { __builtin_amdgcn_s_setprio(1); _Pragma("unroll") for (int m = 0; m < 4; ++m) _Pragma("unroll") for (int n = 0; n < 2; ++n) _Pragma("unroll") for (int k = 0; k < 2; ++k) \
        acc[ai][bj][m][n] = __builtin_amdgcn_mfma_f32_16x16x32_bf16(Bt[n][k], At[m][k], acc[ai][bj][m][n], 0, 0, 0); __builtin_amdgcn_s_setprio(0); } while (0)
#define PG8_WAIT_V(n) asm volatile("s_waitcnt vmcnt(" #n ")" ::: "memory")
#define PG8_WAIT_L(n) asm volatile("s_waitcnt lgkmcnt(" #n ")" ::: "memory")
#define PG8_BAR __builtin_amdgcn_s_barrier()
#define PG8_SCHED __builtin_amdgcn_sched_barrier(0)
    Unit cur, nxt; int ui = 0;
    if (!S.next(0, cur)) return;
    f32x4 acc[2][2][4][2];
#pragma unroll
    for (int a = 0; a < 2; ++a)
#pragma unroll
        for (int b = 0; b < 2; ++b)
#pragma unroll
            for (int m = 0; m < 4; ++m)
#pragma unroll
                for (int n = 0; n < 2; ++n) acc[a][b][m][n] = (f32x4){0.f, 0.f, 0.f, 0.f};
    bf16x8 At[4][2], B0[2][2], B1[2][2];
    const char* cA = (const char*)g.A + (size_t)cur.pm * tstep; const char* cB = (const char*)g.Bt + (size_t)cur.pn * tstep;
    S.a_ready(cur);
    if constexpr (SP2) {
        PG8_STAGE(PG8_SB(0, 0), cB, voffB); PG8_STAGE(PG8_SB(0, 1), cB + hstep, voffB); PG8_STAGE(PG8_SA(0, 0), cA, voffA); PG8_STAGE(PG8_SA(0, 1), cA + hstep, voffA);
        if (wr == 1) PG8_BAR;
        PG8_WAIT_V(2); PG8_BAR;
        PG8_STAGE(PG8_SB(1, 0), cB + kstep, voffB); PG8_STAGE(PG8_SA(1, 0), cA + kstep, voffA); PG8_STAGE(PG8_SB(1, 1), cB + hstep + kstep, voffB);
        PG8_WAIT_V(6); PG8_BAR;
    } else {
        PG8_STAGE(PG8_SB(0, 0), cB, voffB); PG8_STAGE(PG8_SA(0, 0), cA, voffA); PG8_STAGE(PG8_SB(0, 1), cB + hstep, voffB); PG8_STAGE(PG8_SA(0, 1), cA + hstep, voffA);
        if (wr == 1) PG8_BAR;
        PG8_WAIT_V(4); PG8_BAR;
        PG8_STAGE(PG8_SB(1, 0), cB + kstep, voffB); PG8_STAGE(PG8_SA(1, 0), cA + kstep, voffA); PG8_STAGE(PG8_SB(1, 1), cB + hstep + kstep, voffB);
        PG8_WAIT_V(6); PG8_BAR;
    }
    for (;;) {
        const bool has_next = S.next(ui + 1, nxt);
        const char* nA = has_next ? (const char*)g.A + (size_t)nxt.pm * tstep : cA; const char* nB = has_next ? (const char*)g.Bt + (size_t)nxt.pn * tstep : cB;
        for (int t = 0; t < nt; t += 2) {
            const bool last = (t == nt - 2);
            const char* a1 = cA + (size_t)(t + 1) * kstep;
            const char* a2 = last ? nA : cA + (size_t)(t + 2) * kstep; const char* b2 = last ? nB : cB + (size_t)(t + 2) * kstep;
            const char* a3 = a2 + kstep; const char* b3 = b2 + kstep;
            if (last && has_next) S.a_ready(nxt);
            if constexpr (SP2) {
            PG8_LDB(B0, 0, 0); PG8_LDB(B1, 0, 1); PG8_SCHED; PG8_LDA(At, 0, 0); PG8_STAGE(PG8_SA(1, 1), a1 + hstep, voffA);
            PG8_WAIT_V(8); PG8_WAIT_L(0); PG8_BAR; PG8_MMA(0, 0, At, B0); PG8_MMA(0, 1, At, B1); PG8_BAR; PG8_SCHED;
            PG8_LDA(At, 0, 1); PG8_STAGE(PG8_SB(0, 0), b2, voffB); PG8_STAGE(PG8_SB(0, 1), b2 + hstep, voffB); PG8_STAGE(PG8_SA(0, 0), a2, voffA);
            PG8_WAIT_V(8); PG8_WAIT_L(0); PG8_BAR; PG8_MMA(1, 0, At, B0); PG8_MMA(1, 1, At, B1); PG8_BAR; PG8_SCHED;
            PG8_LDB(B0, 1, 0); PG8_LDB(B1, 1, 1); PG8_SCHED; PG8_LDA(At, 1, 0); PG8_STAGE(PG8_SA(0, 1), a2 + hstep, voffA);
            PG8_WAIT_V(8); PG8_WAIT_L(0); PG8_BAR; PG8_MMA(0, 0, At, B0); PG8_MMA(0, 1, At, B1); PG8_BAR; PG8_SCHED;
            PG8_LDA(At, 1, 1); PG8_STAGE(PG8_SB(1, 0), b3, voffB); PG8_STAGE(PG8_SB(1, 1), b3 + hstep, voffB); PG8_STAGE(PG8_SA(1, 0), a3, voffA);
            PG8_WAIT_V(8); PG8_WAIT_L(0); PG8_BAR; PG8_MMA(1, 0, At, B0); PG8_MMA(1, 1, At, B1); PG8_BAR; PG8_SCHED;
            } else {
            PG8_LDB(B0, 0, 0); PG8_SCHED; PG8_LDA(At, 0, 0); PG8_STAGE(PG8_SA(1, 1), a1 + hstep, voffA);
            PG8_WAIT_L(8); PG8_BAR; PG8_WAIT_L(0); PG8_MMA(0, 0, At, B0); PG8_BAR; PG8_SCHED;
            PG8_LDB(B1, 0, 1); PG8_STAGE(PG8_SB(0, 0), b2, voffB);
            PG8_BAR; PG8_WAIT_L(0); PG8_MMA(0, 1, At, B1); PG8_BAR;
            PG8_LDA(At, 0, 1); PG8_STAGE(PG8_SA(0, 0), a2, voffA);
            PG8_BAR; PG8_WAIT_L(0); PG8_MMA(1, 0, At, B0); PG8_BAR; PG8_SCHED;
            PG8_STAGE(PG8_SB(0, 1), b2 + hstep, voffB);
            PG8_WAIT_V(6); PG8_BAR; PG8_MMA(1, 1, At, B1); PG8_BAR;
            PG8_LDB(B0, 1, 0); PG8_SCHED; PG8_LDA(At, 1, 0); PG8_STAGE(PG8_SA(0, 1), a2 + hstep, voffA);
            PG8_WAIT_L(8); PG8_BAR; PG8_WAIT_L(0); PG8_MMA(0, 0, At, B0); PG8_BAR; PG8_SCHED;
            PG8_LDB(B1, 1, 1); PG8_STAGE(PG8_SB(1, 0), b3, voffB);
            PG8_BAR; PG8_WAIT_L(0); PG8_MMA(0, 1, At, B1); PG8_BAR;
            PG8_LDA(At, 1, 1); PG8_STAGE(PG8_SA(1, 0), a3, voffA);
            PG8_BAR; PG8_WAIT_L(0); PG8_MMA(1, 0, At, B0); PG8_BAR; PG8_SCHED;
            PG8_STAGE(PG8_SB(1, 1), b3 + hstep, voffB);
            PG8_WAIT_V(6); PG8_BAR; PG8_MMA(1, 1, At, B1); PG8_BAR;
            }
        }
        if constexpr (ALIGN_EPI) { if (wr == 0) PG8_BAR; }
        if constexpr (!Epi::AFTER_DRAIN) { E(acc, cur, wr, wc, fr, fq); S.done(cur); }
        if (!has_next) break;
#pragma unroll
        for (int a = 0; a < 2; ++a)
#pragma unroll
            for (int b = 0; b < 2; ++b)
#pragma unroll
                for (int m = 0; m < 4; ++m)
#pragma unroll
                    for (int n = 0; n < 2; ++n) acc[a][b][m][n] = (f32x4){0.f, 0.f, 0.f, 0.f};
        cur = nxt; cA = nA; cB = nB; ++ui;
        if constexpr (ALIGN_EPI) { if (wr == 1) PG8_BAR; }
    }
    PG8_WAIT_V(0);
    if constexpr (!ALIGN_EPI) { if (wr == 0) PG8_BAR; }
    PG8_BAR;
    if constexpr (Epi::AFTER_DRAIN) { E.fused(acc, cur, wr, wc, fr, fq, lds, wid, lane); S.done(cur); }
#undef PG8_SA
#undef PG8_SB
#undef PG8_STAGE
#undef PG8_LDA
#undef PG8_LDB
#undef PG8_MMA
#undef PG8_WAIT_V
#undef PG8_WAIT_L
#undef PG8_BAR
#undef PG8_SCHED
}
}

#define LAS __attribute__((address_space(3)))
using pg8::bf16_t; using pg8::bf16x8; using pg8::f32x4; using pg8::u32x4;
typedef float f32x16 __attribute__((ext_vector_type(16)));
typedef float f32x2_t __attribute__((ext_vector_type(2)));
typedef __bf16 bf16x2_t __attribute__((ext_vector_type(2)));
typedef unsigned u32x2 __attribute__((ext_vector_type(2)));

constexpr int DM = 1024, NTOK = 16384, NCTX = 8192, DFF = 2816, DATT = 512, DIN = 4096, NMOD = 9;
constexpr float EPS = 1e-6f, LOG2E = 1.4426950408889634f;
constexpr size_t MiB = 1u << 20;
constexpr size_t WS_FF1IN = 0, WS_FF1OUT = 11 * MiB, WS_FF2IN = 17 * MiB, WS_FF2OUT = 28 * MiB, WS_WIN = 34 * MiB, WS_WBP = 42 * MiB, WS_WBA = 43 * MiB, WS_WOUT = 44 * MiB,
                 WS_WPOOL = 46 * MiB, WS_MOD = 47 * MiB, WS_KC = 48 * MiB, WS_VTC = 50 * MiB;
constexpr size_t WS_H = 52 * MiB;
constexpr size_t WS_ACT = 84 * MiB;
constexpr size_t WS_P = 172 * MiB;
constexpr size_t WS_Q = 204 * MiB;
constexpr size_t WS_K = 220 * MiB;
constexpr size_t WS_VT = 236 * MiB;
constexpr size_t WS_CTL = 252 * MiB, CTL_BYTES = 16384;
constexpr size_t WS_SS = 253 * MiB;
constexpr size_t WS_BVIN = 47 * MiB + 512 * 1024, WS_BVFF2 = WS_BVIN + 128 * 1024;
constexpr size_t WS_END = 254 * MiB;
static_assert(WS_END <= 256 * MiB, "d_ws map");
constexpr size_t KV_LAT = (size_t)32 * 8 * 8 * 2048;
constexpr size_t OUT_Y = 0, OUT_K = (size_t)NTOK * DM, OUT_V = OUT_K + (size_t)NCTX * DATT;

__device__ __forceinline__ unsigned pkbf(float lo, float hi) { f32x2_t v = {lo, hi}; bf16x2_t b = __builtin_convertvector(v, bf16x2_t); return __builtin_bit_cast(unsigned, b); }
__device__ __forceinline__ float bflo(unsigned w) { return __uint_as_float(w << 16); }
__device__ __forceinline__ float bfhi(unsigned w) { return __uint_as_float(w & 0xffff0000u); }
__device__ __forceinline__ float fast_sigmoid(float x) { return __builtin_amdgcn_rcpf(1.0f + __builtin_amdgcn_exp2f(-x * LOG2E)); }
__device__ __forceinline__ float wave_sum(float v) {
#pragma unroll
    for (int o = 1; o < 64; o <<= 1) v += __shfl_xor(v, o);
    return v;
}
__device__ __forceinline__ int cond_of_pm(int pm) { return pm < 32 ? 0 : 1 + ((pm - 32) >> 3); }

__device__ __forceinline__ float row_sumsq(const float* SS, int row, int fq) {
    const f32x4 a = *(const f32x4*)(SS + (size_t)row * 16 + 4 * fq); float s = (a[0] + a[1]) + (a[2] + a[3]);
    s += __shfl_xor(s, 16); s += __shfl_xor(s, 32); return s;
}
__device__ __forceinline__ float rstd_of(float sumsq) { return 1.0f / sqrtf(sumsq * (1.0f / DM) + EPS); }

__device__ __forceinline__ void rstd_table(const float* SS, const pg8::StaticOrder& S, LAS float* tbl, int nmax, int tid) {
    pg8::Unit u;
    for (int i = 0; i < nmax && S.next(i, u); ++i)
        if (tid < 256) { const f32x4* p = (const f32x4*)(SS + (size_t)(u.pm * 256 + tid) * 16); const f32x4 a = (p[0] + p[1]) + (p[2] + p[3]); tbl[i * 256 + tid] = rstd_of(((a[0] + a[1]) + (a[2] + a[3]))); }
    __syncthreads();
}

#define EPI_ROWS(ai, m) (u.pm * 256 + (ai) * 128 + wr * 64 + (m) * 16 + fr)

template <bool NORMED> struct EpiSwiGLU {
    static constexpr bool PERM = true, AFTER_DRAIN = false;
    unsigned char* ws; const LAS float* tbl; int nmax;
    __device__ __forceinline__ void operator()(const f32x4 (&acc)[2][2][4][2], const pg8::Unit& u, int wr, int wc, int fr, int fq) const {
        bf16_t* O = (bf16_t*)(ws + WS_ACT); const float* bvec = (const float*)(ws + WS_BVFF2); const float* SS = (const float*)(ws + WS_SS);
        const int col = u.pn * 128 + wc * 32 + 8 * fq;
        f32x4 bv[2][2];
        if (NORMED) { const float* bp = bvec + (size_t)cond_of_pm(u.pm) * (2 * DFF) + u.pn * 256 + wc * 32 + 8 * fq;
#pragma unroll
            for (int bj = 0; bj < 2; ++bj)
#pragma unroll
                for (int n = 0; n < 2; ++n) bv[bj][n] = *(const f32x4*)(bp + bj * 128 + 4 * n); }
#pragma unroll
        for (int ai = 0; ai < 2; ++ai)
#pragma unroll
            for (int m = 0; m < 4; ++m) {
                const int row = EPI_ROWS(ai, m);
                const float rs = NORMED ? (u.ord < nmax ? tbl[u.ord * 256 + ai * 128 + wr * 64 + m * 16 + fr] : rstd_of(row_sumsq(SS, row, fq))) : 1.f;
                float v[8];
#pragma unroll
                for (int n = 0; n < 2; ++n)
#pragma unroll
                    for (int j = 0; j < 4; ++j) { float g = acc[ai][0][m][n][j], up = acc[ai][1][m][n][j]; if (NORMED) { g = g * rs + bv[0][n][j]; up = up * rs + bv[1][n][j]; } v[4 * n + j] = g * fast_sigmoid(g) * up; }
                u32x4 w; w.x = pkbf(v[0], v[1]); w.y = pkbf(v[2], v[3]); w.z = pkbf(v[4], v[5]); w.w = pkbf(v[6], v[7]);
                *(u32x4*)(O + (size_t)row * DFF + col) = w;
            }
    }
};
template <bool NEXT, int GI, int COEF2, int MNEXT> struct EpiResid {
    static constexpr bool PERM = true, AFTER_DRAIN = false;
    const float* base0; long d1;
    float* out; unsigned char* ws; const float* gnext;
    __device__ __forceinline__ void operator()(const f32x4 (&acc)[2][2][4][2], const pg8::Unit& u, int wr, int wc, int fr, int fq) const {
        constexpr int gi = GI, mnext = MNEXT; constexpr float coef = 0.5f * COEF2;
        bf16_t* XA = (bf16_t*)(ws + WS_H); float* SS = (float*)(ws + WS_SS);
        const float* mc = (const float*)(ws + WS_MOD) + (size_t)cond_of_pm(u.pm) * (NMOD * DM);
        const float* gv = mc + gi * DM;
        const float* base = base0 + (u.pm < 32 ? 0L : d1);
        const int col = u.pn * 256 + wc * 32 + 8 * fq;
        f32x4 g[2][2], an[2][2];
#pragma unroll
        for (int bj = 0; bj < 2; ++bj)
#pragma unroll
            for (int n = 0; n < 2; ++n) { g[bj][n] = *(const f32x4*)(gv + col + bj * 128 + 4 * n) * coef;
                if (NEXT) an[bj][n] = *(const f32x4*)(gnext + col + bj * 128 + 4 * n) * (*(const f32x4*)(mc + (mnext + 1) * DM + col + bj * 128 + 4 * n) + 1.0f); }
#pragma unroll
        for (int ai = 0; ai < 2; ++ai)
#pragma unroll
            for (int m = 0; m < 4; ++m) { const int row = EPI_ROWS(ai, m); const size_t off = (size_t)row * DM + col; float ss = 0.f;
#pragma unroll
                for (int bj = 0; bj < 2; ++bj) { f32x4 o[2];
#pragma unroll
                    for (int n = 0; n < 2; ++n) { const f32x4 b = *(const f32x4*)(base + off + bj * 128 + 4 * n); o[n] = b + g[bj][n] * acc[ai][bj][m][n]; *(f32x4*)(out + off + bj * 128 + 4 * n) = o[n];
                        if (NEXT) ss += (o[n][0] * o[n][0] + o[n][1] * o[n][1]) + (o[n][2] * o[n][2] + o[n][3] * o[n][3]); }
                    if (NEXT) { const f32x4 xa = o[0] * an[bj][0], xb = o[1] * an[bj][1]; u32x4 w; w.x = pkbf(xa[0], xa[1]); w.y = pkbf(xa[2], xa[3]); w.z = pkbf(xb[0], xb[1]); w.w = pkbf(xb[2], xb[3]);
                        *(u32x4*)(XA + off + bj * 128) = w; }
                }
                if (NEXT) { ss += __shfl_xor(ss, 16); ss += __shfl_xor(ss, 32); if (fq == 0) SS[(size_t)row * 16 + u.pn * 4 + wc] = ss; }
            }
    }
};
struct EpiWin {
    static constexpr bool PERM = true, AFTER_DRAIN = false;
    unsigned char* ws; float* outk; const float* qgain; const float* kgain; LAS unsigned char* scr; const LAS float* tbl; int nmax;
    __device__ __forceinline__ void operator()(const f32x4 (&accr)[2][2][4][2], const pg8::Unit& u, int wr, int wc, int fr, int fq) const {
        const int pn = u.pn;
        float* P = (float*)(ws + WS_P); bf16_t* Q = (bf16_t*)(ws + WS_Q); bf16_t* Kb = (bf16_t*)(ws + WS_K); bf16_t* VT = (bf16_t*)(ws + WS_VT); bf16_t* Gt = (bf16_t*)(ws + WS_ACT);
        float* outv = outk + (size_t)NCTX * DATT; const float* bvec = (const float*)(ws + WS_BVIN);
        f32x4 (&acc)[2][2][4][2] = const_cast<f32x4 (&)[2][2][4][2]>(accr);
        { const float* bp = bvec + (size_t)cond_of_pm(u.pm) * DIN + pn * 256 + wc * 32 + 8 * fq; f32x4 bv[2][2];
#pragma unroll
            for (int bj = 0; bj < 2; ++bj)
#pragma unroll
                for (int n = 0; n < 2; ++n) bv[bj][n] = *(const f32x4*)(bp + bj * 128 + 4 * n);
#pragma unroll
            for (int ai = 0; ai < 2; ++ai)
#pragma unroll
                for (int m = 0; m < 4; ++m) { const float rs = u.ord < nmax ? tbl[u.ord * 256 + ai * 128 + wr * 64 + m * 16 + fr] : rstd_of(row_sumsq((const float*)(ws + WS_SS), EPI_ROWS(ai, m), fq));
#pragma unroll
                    for (int bj = 0; bj < 2; ++bj)
#pragma unroll
                        for (int n = 0; n < 2; ++n) acc[ai][bj][m][n] = accr[ai][bj][m][n] * rs + bv[bj][n]; } }

        if (pn < 2) {
            const int col = pn * 256 + wc * 32 + 8 * fq;
#pragma unroll
            for (int ai = 0; ai < 2; ++ai)
#pragma unroll
                for (int m = 0; m < 4; ++m) { float* rp = P + (size_t)EPI_ROWS(ai, m) * DATT + col;
#pragma unroll
                    for (int bj = 0; bj < 2; ++bj)
#pragma unroll
                        for (int n = 0; n < 2; ++n) *(f32x4*)(rp + bj * 128 + 4 * n) = acc[ai][bj][m][n]; }
        } else if (pn < 6) {
            const bool isk = pn >= 4;
            const float* gain = isk ? kgain : qgain;
            const int head = 4 * (pn & 1) + wc;
            f32x4 gn[2][2];
#pragma unroll
            for (int bj = 0; bj < 2; ++bj)
#pragma unroll
                for (int n = 0; n < 2; ++n) gn[bj][n] = *(const f32x4*)(gain + 32 * bj + 8 * fq + 4 * n);
#pragma unroll
            for (int ai = 0; ai < 2; ++ai)
#pragma unroll
                for (int m = 0; m < 4; ++m) {
                    float ss = 0.f;
#pragma unroll
                    for (int bj = 0; bj < 2; ++bj)
#pragma unroll
                        for (int n = 0; n < 2; ++n) { const f32x4 x = acc[ai][bj][m][n]; ss += (x[0] * x[0] + x[1] * x[1]) + (x[2] * x[2] + x[3] * x[3]); }
                    ss += __shfl_xor(ss, 16); ss += __shfl_xor(ss, 32);
                    const float rstd = 1.0f / sqrtf(ss * (1.0f / 64.0f) + EPS);
                    const int row = EPI_ROWS(ai, m);
#pragma unroll
                    for (int bj = 0; bj < 2; ++bj) {
                        const f32x4 a = acc[ai][bj][m][0] * rstd * gn[bj][0], b = acc[ai][bj][m][1] * rstd * gn[bj][1];
                        const int c = head * 64 + 32 * bj + 8 * fq;
                        u32x4 w; w.x = pkbf(a[0], a[1]); w.y = pkbf(a[2], a[3]); w.z = pkbf(b[0], b[1]); w.w = pkbf(b[2], b[3]);
                        if (!isk) *(u32x4*)(Q + (size_t)row * DATT + c) = w;
                        else {
                            const bool ctx = u.pm < 32; const int rl = row - u.pm * 256, tok = ctx ? rl : ((u.pm - 32) & 7) * 256 + rl;
                            const size_t tile = ctx ? (size_t)(u.pm * 8 + head) * 8 + (tok >> 5) : KV_LAT / 2048 + (size_t)(((u.pm - 32) >> 3) * 8 + head) * 64 + (tok >> 5);
                            *(u32x4*)(Kb + tile * 2048 + (2 * bj + (fq >> 1)) * 512 + (32 * (fq & 1) + (tok & 31)) * 8) = w; }
                        if (isk && u.pm < 32) { *(f32x4*)(outk + (size_t)row * DATT + c) = a; *(f32x4*)(outk + (size_t)row * DATT + c + 4) = b; }
                    }
                }
        } else if (pn < 8) {
            const bool ctx = u.pm < 32;
            LAS unsigned char* pad = scr + (wr * 4 + wc) * 1280;
            const int lane_ = fq * 16 + fr, d_ = lane_ & 31, hh_ = lane_ >> 5;
#pragma unroll
            for (int ai = 0; ai < 2; ++ai)
#pragma unroll
                for (int m = 0; m < 4; ++m) {
                    const int rl0 = ai * 128 + wr * 64 + m * 16, row = u.pm * 256 + rl0 + fr, tok0 = ctx ? rl0 : ((u.pm - 32) & 7) * 256 + rl0;
#pragma unroll
                    for (int bj = 0; bj < 2; ++bj) {
                        const int c = (pn - 6) * 256 + bj * 128 + wc * 32 + 8 * fq, head = c >> 6;
                        const f32x4 a = acc[ai][bj][m][0], b = acc[ai][bj][m][1];
                        u32x4 w; w.x = pkbf(a[0], a[1]); w.y = pkbf(a[2], a[3]); w.z = pkbf(b[0], b[1]); w.w = pkbf(b[2], b[3]);
                        *(LAS u32x4*)(pad + fr * 80 + fq * 16) = w;
                        if (ctx) { *(f32x4*)(outv + (size_t)row * DATT + c) = a; *(f32x4*)(outv + (size_t)row * DATT + c + 4) = b; }
                        unsigned short e[8];
#pragma unroll
                        for (int j = 0; j < 8; ++j) e[j] = *(const LAS unsigned short*)(pad + (8 * (j >> 2) + 4 * hh_ + (j & 3)) * 80 + d_ * 2);
                        u32x4 o; o.x = e[0] | ((unsigned)e[1] << 16); o.y = e[2] | ((unsigned)e[3] << 16); o.z = e[4] | ((unsigned)e[5] << 16); o.w = e[6] | ((unsigned)e[7] << 16);
                        const size_t tile = ctx ? (size_t)(u.pm * 8 + head) * 8 + (tok0 >> 5) : KV_LAT / 2048 + (size_t)(((u.pm - 32) >> 3) * 8 + head) * 64 + (tok0 >> 5);
                        *(u32x4*)(VT + tile * 2048 + ((wc & 1) * 2 + ((tok0 >> 4) & 1)) * 512 + lane_ * 8) = o;
                    }
                }
        } else {
            const int col = (pn - 8) * 256 + wc * 32 + 8 * fq;
#pragma unroll
            for (int ai = 0; ai < 2; ++ai)
#pragma unroll
                for (int m = 0; m < 4; ++m) { bf16_t* rp = Gt + (size_t)EPI_ROWS(ai, m) * 2048 + col;
#pragma unroll
                    for (int bj = 0; bj < 2; ++bj) { const f32x4 a = acc[ai][bj][m][0], b = acc[ai][bj][m][1];
                        u32x4 w; w.x = pkbf(fast_sigmoid(a[0]), fast_sigmoid(a[1])); w.y = pkbf(fast_sigmoid(a[2]), fast_sigmoid(a[3]));
                        w.z = pkbf(fast_sigmoid(b[0]), fast_sigmoid(b[1])); w.w = pkbf(fast_sigmoid(b[2]), fast_sigmoid(b[3]));
                        *(u32x4*)(rp + bj * 128) = w; }
                }
        }
    }
};
template <int MODE> struct EpiMix {
    static constexpr bool PERM = true, AFTER_DRAIN = false;
    unsigned char* ws; const float* vec;
    __device__ __forceinline__ void operator()(const f32x4 (&acc)[2][2][4][2], const pg8::Unit& u, int wr, int wc, int fr, int fq) const {
        bf16_t* O = (bf16_t*)(ws + (MODE == 0 ? WS_H + 16 * MiB : MODE == 1 ? WS_K : WS_P)); constexpr int ldo = MODE == 0 ? DATT : DM;
        const bf16_t* Gt = (const bf16_t*)(ws + WS_ACT); const bf16_t* T1 = (const bf16_t*)(ws + WS_K);
        const int col = u.pn * 256 + wc * 32 + 8 * fq;
        f32x4 sv[2][2];
        if (MODE == 0) {
#pragma unroll
            for (int bj = 0; bj < 2; ++bj)
#pragma unroll
                for (int n = 0; n < 2; ++n) sv[bj][n] = *(const f32x4*)(vec + col + bj * 128 + 4 * n);
        }
#pragma unroll
        for (int ai = 0; ai < 2; ++ai)
#pragma unroll
            for (int m = 0; m < 4; ++m) { const int row = EPI_ROWS(ai, m);
#pragma unroll
                for (int bj = 0; bj < 2; ++bj) {
                    f32x4 a = acc[ai][bj][m][0], b = acc[ai][bj][m][1];
                    const int c = col + bj * 128;
                    if (MODE == 0) { a = a * sv[bj][0]; b = b * sv[bj][1]; }
                    else {
                        const u32x4 gw = *(const u32x4*)(Gt + (size_t)row * 2048 + (MODE == 2 ? 1024 : 0) + c);
                        const f32x4 ga = {bflo(gw.x), bfhi(gw.x), bflo(gw.y), bfhi(gw.y)}, gb = {bflo(gw.z), bfhi(gw.z), bflo(gw.w), bfhi(gw.w)};
                        a = a * ga; b = b * gb;
                        if (MODE == 2) { const u32x4 tw = *(const u32x4*)(T1 + (size_t)row * DM + c);
                            a = a + (f32x4){bflo(tw.x), bfhi(tw.x), bflo(tw.y), bfhi(tw.y)}; b = b + (f32x4){bflo(tw.z), bfhi(tw.z), bflo(tw.w), bfhi(tw.w)}; }
                    }
                    u32x4 w; w.x = pkbf(a[0], a[1]); w.y = pkbf(a[2], a[3]); w.z = pkbf(b[0], b[1]); w.w = pkbf(b[2], b[3]);
                    *(u32x4*)(O + (size_t)row * ldo + c) = w;
                }
            }
    }
};

__device__ __forceinline__ unsigned f2bf(float f) { unsigned u = __builtin_bit_cast(unsigned, f); return (u + 0x7fffu + ((u >> 16) & 1u)) >> 16; }
__device__ __forceinline__ unsigned pk2(float lo, float hi) { return f2bf(lo) | (f2bf(hi) << 16); }
__device__ __forceinline__ int dest_row(int mode, int n) {
    if (mode == 1) { const int up = n >= DFF, j = up ? n - DFF : n; return 256 * (j >> 7) + (up ? 128 : 0) + (j & 127); }
    if (mode == 2) { if (n >= 512 && n < 1536) { const int tb = n & ~255, cc = n & 255, hh = cc >> 6, d = cc & 63; return tb + 128 * (d >> 5) + 32 * hh + (d & 31); } return n; }
    return n;
}
__device__ __forceinline__ void tr_item(const float* W, int N, bf16_t* WT, int ldt, int mode, LAS float* scr, int item, int lane) {
    const int nblk = N / 32, kb = item / nblk, nb = item % nblk, k0 = 64 * kb, n0 = 32 * nb;
#pragma unroll
    for (int i = 0; i < 32; ++i) { const int kk = 2 * i + (lane >> 5); scr[kk * 33 + (lane & 31)] = W[(size_t)(k0 + kk) * N + n0 + (lane & 31)]; }
    asm volatile("s_waitcnt lgkmcnt(0)" ::: "memory");
    const int c = lane & 7;
#pragma unroll
    for (int j = 0; j < 4; ++j) { const int n = (lane >> 3) + 8 * j; const LAS float* s = scr + (8 * c) * 33 + n;
        u32x4 o; o.x = pk2(s[0 * 33], s[1 * 33]); o.y = pk2(s[2 * 33], s[3 * 33]); o.z = pk2(s[4 * 33], s[5 * 33]); o.w = pk2(s[6 * 33], s[7 * 33]);
        *(u32x4*)(WT + (size_t)dest_row(mode, n0 + n) * ldt + k0 + 8 * c) = o; }
    asm volatile("s_waitcnt lgkmcnt(0)" ::: "memory");
}

struct Args { const float* in[24]; float* out; unsigned char* ws; int ph_lo, ph_hi; };
enum { I_XP = 0, I_XS, I_CK, I_CV, I_C, I_CCTX, I_WADA, I_BADA, I_GFF1, I_WFF1IN, I_WFF1OUT, I_GMIX, I_WIN, I_QG, I_KG, I_WPOOL, I_PSCALE, I_RPB, I_WBP, I_WBA, I_WOUT, I_GFF2, I_WFF2IN, I_WFF2OUT };

__device__ __forceinline__ void phase0(const Args& a, LAS unsigned char* lds, int tid, int lane, int wave, int G) {
    unsigned char* ws = a.ws;
    if ((int)blockIdx.x < 144) {
        LAS float* sc = (LAS float*)lds; LAS float* red = sc + 5 * 1024;
        for (int i = tid; i < 5 * 1024; i += 512) { const float v = i < 1024 ? a.in[I_CCTX][i] : a.in[I_C][i - 1024]; sc[i] = v * fast_sigmoid(v); }
        __syncthreads();
        float* mod = (float*)(ws + WS_MOD);
        for (int u = blockIdx.x; u < 144; u += G) {
            const int rsub = lane >> 4, c4 = (lane & 15) * 4;
            f32x4 acc[5];
#pragma unroll
            for (int c = 0; c < 5; ++c) acc[c] = (f32x4){0.f, 0.f, 0.f, 0.f};
            const float* wp = a.in[I_WADA] + (size_t)(wave * 128 + rsub) * (NMOD * DM) + u * 64 + c4;
            const LAS float* scw = sc + wave * 128 + rsub;
#pragma unroll 8
            for (int i = 0; i < 32; ++i) {
                const f32x4 wv = *(const f32x4*)(wp + (size_t)(4 * i) * (NMOD * DM));
#pragma unroll
                for (int c = 0; c < 5; ++c) acc[c] += wv * scw[c * 1024 + 4 * i];
            }
#pragma unroll
            for (int c = 0; c < 5; ++c)
#pragma unroll
                for (int j = 0; j < 4; ++j) { float v = acc[c][j]; v += __shfl_xor(v, 16); v += __shfl_xor(v, 32); acc[c][j] = v; }
            if (lane < 16) {
#pragma unroll
                for (int c = 0; c < 5; ++c) *(LAS f32x4*)(red + (wave * 5 + c) * 64 + c4) = acc[c]; }
            __syncthreads();
            if (tid < 320) { const int c = tid >> 6, l = tid & 63; float s = 0.f;
#pragma unroll
                for (int w = 0; w < 8; ++w) s += red[(w * 5 + c) * 64 + l];
                mod[c * (NMOD * DM) + u * 64 + l] = s + a.in[I_BADA][u * 64 + l]; }
            __syncthreads();
        }
    }
    LAS float* scr = (LAS float*)(lds + wave * 16384);
    constexpr int I_FIN = 16 * 176, I_IN = 16 * 128, I_FOUT = 44 * 32;
    constexpr int NITEMS = I_FIN + I_IN + I_FOUT;
    const bool bal = (G == 256); const int bx = blockIdx.x;
    if (bal && bx < 144) return;
    const int slot0 = bal ? (bx - 144) * 8 + wave : bx * 8 + wave, nslots = bal ? 112 * 8 : G * 8;
    for (int it = slot0; it < NITEMS; it += nslots) {
        int r = it;
        if (r < I_FIN) { tr_item(a.in[I_WFF1IN], 2 * DFF, (bf16_t*)(ws + WS_FF1IN), DM, 1, scr, r, lane); continue; } r -= I_FIN;
        if (r < I_IN) { tr_item(a.in[I_WIN], DIN, (bf16_t*)(ws + WS_WIN), DM, 2, scr, r, lane); continue; } r -= I_IN;
        tr_item(a.in[I_WFF1OUT], DM, (bf16_t*)(ws + WS_FF1OUT), DFF, 0, scr, r, lane);
    }
}

__device__ __forceinline__ void late_copies(const Args& a, LAS unsigned char* lds, int lane, int wave, int wi, int nw) {
    unsigned char* ws = a.ws;
    LAS float* scr = (LAS float*)(lds + wave * 16384);
    constexpr int I_FIN = 16 * 176, I_FOUT = 44 * 32, I_BR = 8 * 32, I_OUT = 16 * 32, I_FOLD = 4 * 8 * 16;
    constexpr int NITEMS = I_FIN + I_FOUT + I_BR + I_OUT + I_FOLD;
    for (int it = wi; it < NITEMS; it += nw) {
        int r = it;
        if (r < I_FIN) { tr_item(a.in[I_WFF2IN], 2 * DFF, (bf16_t*)(ws + WS_FF2IN), DM, 1, scr, r, lane); continue; } r -= I_FIN;
        if (r < I_FOUT) { tr_item(a.in[I_WFF2OUT], DM, (bf16_t*)(ws + WS_FF2OUT), DFF, 0, scr, r, lane); continue; } r -= I_FOUT;
        if (r < I_BR) { tr_item(a.in[I_WBA], DM, (bf16_t*)(ws + WS_WBA), DATT, 0, scr, r, lane); continue; } r -= I_BR;
        if (r < I_OUT) { tr_item(a.in[I_WOUT], DM, (bf16_t*)(ws + WS_WOUT), DM, 0, scr, r, lane); continue; } r -= I_OUT;
        {
            const int g = r >> 7, ib = (r >> 4) & 7, n = (r & 15) * 64 + lane;
            const float* wp = a.in[I_WPOOL] + (size_t)g * 128 * 128 + (size_t)(ib * 16) * 128; const float* ps = a.in[I_PSCALE] + g * 128; const float* wb = a.in[I_WBP] + (size_t)(g * 128) * DM + n;
#pragma unroll
            for (int q = 0; q < 8; ++q) { const int e4 = q * 64 + lane, i = e4 >> 5, j4 = (e4 & 31) * 4; const f32x4 w4 = *(const f32x4*)(wp + i * 128 + j4) * *(const f32x4*)(ps + j4); *(LAS f32x4*)(scr + i * 128 + j4) = w4; }
            asm volatile("s_waitcnt lgkmcnt(0)" ::: "memory");
            float acc[16];
#pragma unroll
            for (int i = 0; i < 16; ++i) acc[i] = 0.f;
#pragma unroll 2
            for (int j = 0; j < 128; j += 4) { const float w0 = wb[(size_t)j * DM], w1 = wb[(size_t)(j + 1) * DM], w2 = wb[(size_t)(j + 2) * DM], w3 = wb[(size_t)(j + 3) * DM];
#pragma unroll
                for (int i = 0; i < 16; ++i) { const f32x4 p4 = *(const LAS f32x4*)(scr + i * 128 + j); acc[i] += (p4[0] * w0 + p4[1] * w1) + (p4[2] * w2 + p4[3] * w3); } }
            asm volatile("s_waitcnt lgkmcnt(0)" ::: "memory");
            u32x4 o0, o1; o0.x = pk2(acc[0], acc[1]); o0.y = pk2(acc[2], acc[3]); o0.z = pk2(acc[4], acc[5]); o0.w = pk2(acc[6], acc[7]);
            o1.x = pk2(acc[8], acc[9]); o1.y = pk2(acc[10], acc[11]); o1.z = pk2(acc[12], acc[13]); o1.w = pk2(acc[14], acc[15]);
            bf16_t* dst = (bf16_t*)(ws + WS_WBP) + (size_t)n * DATT + g * 128 + ib * 16; *(u32x4*)dst = o0; *(u32x4*)(dst + 8) = o1;
        }
    }
    const int gt = wi * 64 + lane, NGT = nw * 64;
    for (int i = gt; i < 2 * 32 * 16 * 256; i += NGT) {
        const int isv = i >= 32 * 16 * 256, ch = isv ? i - 32 * 16 * 256 : i, ln = ch & 63, q4 = (ch >> 6) & 3, tile = (ch >> 8) & 15, bh = ch >> 12, b = bh >> 3, h = bh & 7, r32 = ln & 31, hh = ln >> 5;
        u32x4 o;
        if (!isv) { const float* src = a.in[I_CK] + ((size_t)(b * 512 + tile * 32 + r32) * 8 + h) * 64 + 16 * q4 + 8 * hh; const f32x4 v0 = *(const f32x4*)src, v1 = *(const f32x4*)(src + 4);
            o.x = pk2(v0[0], v0[1]); o.y = pk2(v0[2], v0[3]); o.z = pk2(v1[0], v1[1]); o.w = pk2(v1[2], v1[3]);
            *(u32x4*)((bf16_t*)(ws + WS_KC) + (size_t)ch * 8) = o; }
        else { const int t = q4 >> 1, sK = q4 & 1; float v[8];
#pragma unroll
            for (int j = 0; j < 8; ++j) { const int key = 16 * sK + 8 * (j >> 2) + 4 * hh + (j & 3); v[j] = a.in[I_CV][((size_t)(b * 512 + tile * 32 + key) * 8 + h) * 64 + 32 * t + r32]; }
            o.x = pk2(v[0], v[1]); o.y = pk2(v[2], v[3]); o.z = pk2(v[4], v[5]); o.w = pk2(v[6], v[7]);
            *(u32x4*)((bf16_t*)(ws + WS_VTC) + (size_t)ch * 8) = o; }
    }
}

__device__ __forceinline__ void norm_phase(const float* src0, const float* src1, const float* gvec, const float* mod, int mi, bf16_t* H, int G, int wave, int lane) {
    for (int rb = blockIdx.x; rb < NTOK / 64; rb += G) {
        const int rbase = rb * 64, cond = rbase < NCTX ? 0 : 1 + ((rbase - NCTX) >> 11);
        const float* sh = mod + (size_t)cond * (NMOD * DM) + mi * DM; const float* scl = sh + DM;
        f32x4 av[4], sv[4];
#pragma unroll
        for (int j = 0; j < 4; ++j) { const int c = 4 * lane + 256 * j; av[j] = *(const f32x4*)(gvec + c) * (*(const f32x4*)(scl + c) + 1.0f); sv[j] = *(const f32x4*)(sh + c); }
        for (int i0 = 0; i0 < 8; i0 += 8) {
            f32x4 v[8][4]; float s[8];
#pragma unroll
            for (int i = 0; i < 8; ++i) {
                const int row = rbase + wave * 8 + i0 + i;
                const float* xr = row < NCTX ? src0 + (size_t)row * DM : src1 + (size_t)(row - NCTX) * DM;
#pragma unroll
                for (int j = 0; j < 4; ++j) v[i][j] = *(const f32x4*)(xr + 4 * lane + 256 * j);
            }
#pragma unroll
            for (int i = 0; i < 8; ++i) { s[i] = 0.f;
#pragma unroll
                for (int j = 0; j < 4; ++j) s[i] += (v[i][j][0] * v[i][j][0] + v[i][j][1] * v[i][j][1]) + (v[i][j][2] * v[i][j][2] + v[i][j][3] * v[i][j][3]); }
#pragma unroll
            for (int o = 1; o < 64; o <<= 1) {
#pragma unroll
                for (int i = 0; i < 8; ++i) s[i] += __shfl_xor(s[i], o); }
#pragma unroll
            for (int i = 0; i < 8; ++i) {
                const int row = rbase + wave * 8 + i0 + i;
                const float rstd = 1.0f / sqrtf(s[i] * (1.0f / DM) + EPS);
#pragma unroll
                for (int j = 0; j < 4; ++j) { const f32x4 o = v[i][j] * rstd * av[j] + sv[j]; u32x2 w; w.x = pkbf(o[0], o[1]); w.y = pkbf(o[2], o[3]); *(u32x2*)(H + (size_t)row * DM + 4 * lane + 256 * j) = w; }
            }
        }
    }
}

__device__ __forceinline__ void bvec_items(const bf16_t* Bt, int N, const float* mod, int mi, float* out, int gw, int NGW, int lane) {
    float sh[5][16];
#pragma unroll
    for (int c = 0; c < 5; ++c)
#pragma unroll
        for (int q = 0; q < 4; ++q) { const f32x4 v = *(const f32x4*)(mod + (size_t)c * (NMOD * DM) + mi * DM + 16 * lane + 4 * q); sh[c][4 * q] = v[0]; sh[c][4 * q + 1] = v[1]; sh[c][4 * q + 2] = v[2]; sh[c][4 * q + 3] = v[3]; }
    for (int n = gw; n < N; n += NGW) {
        const u32x4 w0 = *(const u32x4*)(Bt + (size_t)n * DM + 16 * lane), w1 = *(const u32x4*)(Bt + (size_t)n * DM + 16 * lane + 8);
        const float w[16] = {bflo(w0.x), bfhi(w0.x), bflo(w0.y), bfhi(w0.y), bflo(w0.z), bfhi(w0.z), bflo(w0.w), bfhi(w0.w), bflo(w1.x), bfhi(w1.x), bflo(w1.y), bfhi(w1.y), bflo(w1.z), bfhi(w1.z), bflo(w1.w), bfhi(w1.w)};
        float acc[5];
#pragma unroll
        for (int c = 0; c < 5; ++c) { float a = 0.f;
#pragma unroll
            for (int k = 0; k < 16; ++k) a += sh[c][k] * w[k];
            acc[c] = a; }
#pragma unroll
        for (int o = 1; o < 64; o <<= 1) {
#pragma unroll
            for (int c = 0; c < 5; ++c) acc[c] += __shfl_xor(acc[c], o); }
        if (lane == 0) {
#pragma unroll
            for (int c = 0; c < 5; ++c) out[(size_t)c * N + n] = acc[c]; }
    }
}

__device__ __forceinline__ int crow(int r, int hh) { return (r & 3) + 8 * (r >> 2) + 4 * hh; }
#define MFMA32(a, b, c) __builtin_amdgcn_mfma_f32_32x32x16_bf16((a), (b), (c), 0, 0, 0)
struct KVFrag { bf16x8 k[4]; bf16x8 v[4]; };
__device__ __forceinline__ void kv_load(KVFrag& f, const bf16_t* kt, const bf16_t* vt, int lane) {
#pragma unroll
    for (int i = 0; i < 4; ++i) { f.k[i] = *(const bf16x8*)(kt + i * 512 + lane * 8); f.v[i] = *(const bf16x8*)(vt + i * 512 + lane * 8); }
}
struct AttnState { f32x16 o0, o1; float mrun, lrun; };
template <bool LOCAL, int FAR = 0> __device__ __forceinline__ void attn_tile(AttnState& st, const KVFrag& f, const bf16x8 (&qf)[4], const LAS float* bq, int okb) {
    constexpr float C2 = 0.125f * LOG2E;
    constexpr int R0 = FAR == 2 ? 12 : 0, R1 = FAR == 1 ? 4 : 16;
    f32x16 s;
#pragma unroll
    for (int r = 0; r < 16; ++r) s[r] = 0.f;
#pragma unroll
    for (int d0 = 0; d0 < 4; ++d0) s = MFMA32(f.k[d0], qf[d0], s);
    if (LOCAL) {
#pragma unroll
        for (int r = R0; r < R1; ++r) { const int cr = (r & 3) + 8 * (r >> 2); const bool ok = (unsigned)(okb + cr) < 16u; s[r] = ok ? __builtin_fmaf(s[r], C2, bq[cr]) : -1e30f; }
    }
    float mx = s[R0];
#pragma unroll
    for (int r = R0 + 1; r < R1; ++r) mx = fmaxf(mx, s[r]);
    if (!LOCAL) mx *= C2;
    mx = fmaxf(mx, __shfl_xor(mx, 32));
    const float mnew = fmaxf(st.mrun, mx);
    if (__builtin_amdgcn_ballot_w64(mnew > st.mrun) != 0ull) {
        const float alpha = __builtin_amdgcn_exp2f(st.mrun - mnew);
        st.lrun *= alpha;
#pragma unroll
        for (int r = 0; r < 16; ++r) { st.o0[r] *= alpha; st.o1[r] *= alpha; }
        st.mrun = mnew;
    }
    float ps = 0.f;
#pragma unroll
    for (int r = 0; r < 16; ++r) { if (r >= R0 && r < R1) { s[r] = __builtin_amdgcn_exp2f(LOCAL ? s[r] - mnew : __builtin_fmaf(s[r], C2, -mnew)); ps += s[r]; } else s[r] = 0.f; }
    st.lrun += ps;
    u32x4 p0, p1;
    p0.x = pkbf(s[0], s[1]); p0.y = pkbf(s[2], s[3]); p0.z = pkbf(s[4], s[5]); p0.w = pkbf(s[6], s[7]);
    p1.x = pkbf(s[8], s[9]); p1.y = pkbf(s[10], s[11]); p1.z = pkbf(s[12], s[13]); p1.w = pkbf(s[14], s[15]);
    const bf16x8 pb0 = __builtin_bit_cast(bf16x8, p0), pb1 = __builtin_bit_cast(bf16x8, p1);
    if (FAR != 2) { st.o0 = MFMA32(f.v[0], pb0, st.o0); st.o1 = MFMA32(f.v[2], pb0, st.o1); }
    if (FAR != 1) { st.o0 = MFMA32(f.v[1], pb1, st.o0); st.o1 = MFMA32(f.v[3], pb1, st.o1); }
}
__device__ __forceinline__ void attn_wave(const bf16_t* Qp, bf16_t* Op, int nd, const bf16_t* KFd, const bf16_t* VFd,
                                          int nl, const bf16_t* KFl, const bf16_t* VFl, int rq, int r0, int g, const LAS float* rpbh, int lane) {
    const int r32 = lane & 31, hh = lane >> 5;
    bf16x8 qf[4];
#pragma unroll
    for (int d0 = 0; d0 < 4; ++d0) qf[d0] = *(const bf16x8*)(Qp + (size_t)r32 * DATT + d0 * 16 + 8 * hh);
    AttnState st;
#pragma unroll
    for (int r = 0; r < 16; ++r) { st.o0[r] = 0.f; st.o1[r] = 0.f; }
    st.mrun = -1e30f; st.lrun = 0.f;
    const int nt = nd + nl;
    const int qc = 32 * g + r32; int c0 = qc - 8; c0 = c0 < 0 ? 0 : (c0 > 48 ? 48 : c0);
    KVFrag f0, f1, f2;
#define ATT_LOAD(f, ti) do { const int ti_ = (ti); if (ti_ < nt) { if (ti_ < nd) kv_load(f, KFd + (size_t)ti_ * 2048, VFd + (size_t)ti_ * 2048, lane); \
        else { const int tx_ = 2 * r0 + (ti_ - nd); kv_load(f, KFl + (size_t)tx_ * 2048, VFl + (size_t)tx_ * 2048, lane); } } } while (0)
#define ATT_TILE(f, ti) do { const int ti_ = (ti); if (ti_ < nt) { if (ti_ < nd) attn_tile<false, 0>(st, f, qf, nullptr, 0); \
        else { const int tl_ = ti_ - nd, kb_ = 32 * (tl_ & 1) + 4 * hh; const LAS float* bq_ = rpbh + (r0 + (tl_ >> 1) - rq + 7) * 31 + (kb_ - qc + 15); \
            if ((tl_ & 1) == g) attn_tile<true, 0>(st, f, qf, bq_, kb_ - c0); else if (g == 0) attn_tile<true, 1>(st, f, qf, bq_, kb_ - c0); else attn_tile<true, 2>(st, f, qf, bq_, kb_ - c0); } } } while (0)
    ATT_LOAD(f0, 0); ATT_LOAD(f1, 1);
    for (int ti = 0; ti < nt; ti += 3) {
        ATT_LOAD(f2, ti + 2); ATT_TILE(f0, ti);
        ATT_LOAD(f0, ti + 3); ATT_TILE(f1, ti + 1);
        ATT_LOAD(f1, ti + 4); ATT_TILE(f2, ti + 2);
    }
#undef ATT_LOAD
#undef ATT_TILE
    float lrun = st.lrun; lrun += __shfl_xor(lrun, 32);
    const float inv = 1.0f / lrun;
    bf16_t* op = Op + (size_t)r32 * DATT + 4 * hh;
#pragma unroll
    for (int rg = 0; rg < 4; ++rg) {
        u32x2 w; w.x = pkbf(st.o0[4 * rg] * inv, st.o0[4 * rg + 1] * inv); w.y = pkbf(st.o0[4 * rg + 2] * inv, st.o0[4 * rg + 3] * inv); *(u32x2*)(op + 8 * rg) = w;
        u32x2 x; x.x = pkbf(st.o1[4 * rg] * inv, st.o1[4 * rg + 1] * inv); x.y = pkbf(st.o1[4 * rg + 2] * inv, st.o1[4 * rg + 3] * inv); *(u32x2*)(op + 32 + 8 * rg) = x;
    }
}

template <int HW> __device__ __forceinline__ void dpass_item(const float* ps, bf16_t* ds, int t0, int L) {
    f32x2_t x[32 + 2 * HW];
#pragma unroll
    for (int j = 0; j < 32 + 2 * HW; ++j) { const int t = t0 - HW + j; const bool ok = t >= 0 && t < L; const f32x2_t v = *(const f32x2_t*)(ps + (size_t)(ok ? t : t0) * DATT); x[j] = ok ? v : (f32x2_t){0.f, 0.f}; }
    f32x2_t s = {0.f, 0.f};
#pragma unroll
    for (int j = 0; j < 2 * HW; ++j) s += x[j];
#pragma unroll
    for (int i = 0; i < 32; ++i) {
        const int t = t0 + i; const int lo = t - HW < 0 ? 0 : t - HW, hi = t + HW > L ? L : t + HW;
        const f32x2_t d = s * (1.0f / (float)(hi - lo)) - x[i + HW];
        *(unsigned*)(ds + (size_t)t * DATT) = pkbf(d[0], d[1]);
        if (i < 31) s += x[i + 2 * HW] - x[i];
    }
}

__device__ __forceinline__ void mixer_phase(const Args& a, LAS unsigned char* lds, int tid, int lane, int wave, int G, int what, int vb) {
    unsigned char* ws = a.ws;
    if (what & 1) {
    const bf16_t* Q = (const bf16_t*)(ws + WS_Q); const bf16_t* Kb = (const bf16_t*)(ws + WS_K); const bf16_t* VT = (const bf16_t*)(ws + WS_VT);
    const bf16_t* KC = (const bf16_t*)(ws + WS_KC); const bf16_t* VTC = (const bf16_t*)(ws + WS_VTC);
    bf16_t* ATT = (bf16_t*)(ws + WS_H);
    LAS float* rpbl = (LAS float*)(lds + 1024);
    for (int i = tid; i < 8 * 15 * 31; i += 512) rpbl[i] = a.in[I_RPB][i] * LOG2E;
    __syncthreads();
    for (int u = vb; u < 256; u += G) {
        {
            const int ul = (u & 7) * 32 + (u >> 3), bh = ul >> 3, b = bh >> 3, h = bh & 7, rq = 4 * (ul & 7) + (wave >> 1), g = wave & 1;
            int r0 = rq - 4; r0 = r0 < 0 ? 0 : (r0 > 24 ? 24 : r0);
            const size_t row0 = (size_t)NCTX + (size_t)b * 2048 + rq * 64 + 32 * g;
            attn_wave(Q + row0 * DATT + h * 64, ATT + row0 * DATT + h * 64, 16, KC + (size_t)bh * 16 * 2048, VTC + (size_t)bh * 16 * 2048,
                      16, Kb + KV_LAT + (size_t)bh * 64 * 2048, VT + KV_LAT + (size_t)bh * 64 * 2048, rq, r0, g, rpbl + h * 15 * 31, lane);
        }
        {
            const int b = u >> 3, h = u & 7;
            const size_t row0 = (size_t)b * 256 + 32 * wave;
            attn_wave(Q + row0 * DATT + h * 64, ATT + row0 * DATT + h * 64, 8, Kb + (size_t)u * 8 * 2048, VT + (size_t)u * 8 * 2048,
                      0, Kb, VT, 0, 0, 0, rpbl, lane);
        }
    }
    }
    if (!(what & 2)) return;
    const float* P = (const float*)(ws + WS_P); bf16_t* D = (bf16_t*)(ws + WS_ACT + 64 * MiB);
    const int gw = blockIdx.x * 8 + wave, NGW = G * 8;
    for (int it = gw; it < (NTOK / 32) * 4; it += NGW) {
        const int g = it & 3, row0 = (it >> 2) * 32;
        int t0, L; if (row0 < NCTX) { t0 = row0 & 255; L = 256; } else { t0 = (row0 - NCTX) & 2047; L = 2048; }
        const float* ps = P + (size_t)(row0 - t0) * DATT + g * 128 + 2 * lane; bf16_t* ds = D + (size_t)(row0 - t0) * DATT + g * 128 + 2 * lane;
        if (g == 0) dpass_item<1>(ps, ds, t0, L); else if (g == 1) dpass_item<2>(ps, ds, t0, L); else if (g == 2) dpass_item<4>(ps, ds, t0, L); else dpass_item<8>(ps, ds, t0, L);
    }
}


typedef unsigned v4u __attribute__((ext_vector_type(4)));
#define XB_TMO      128
#define XB_XCNT(j)  (256  + 64 * (j))
#define XB_XSUB(j)  (1280 + 64 * (j))
#define XB_XGEN(j)  (2304 + 64 * (j))
#define XB_TOP      3328
#define XB_TOPGEN   3392
#define XCD_BAR_WORDS 3456
#define XB_SPIN_CAP (1u << 18)

__device__ __forceinline__ unsigned xb_ld(unsigned* p)              { return __hip_atomic_load(p, __ATOMIC_RELAXED, __HIP_MEMORY_SCOPE_AGENT); }
__device__ __forceinline__ unsigned xb_add(unsigned* p, unsigned v) { return __hip_atomic_fetch_add(p, v, __ATOMIC_RELAXED, __HIP_MEMORY_SCOPE_AGENT); }
__device__ __forceinline__ unsigned xb_xcc_id() { return (unsigned)__builtin_amdgcn_s_getreg((3 << 11) | 20) & 0xFu; }
#define XB_SPIN(cond, bar) do { unsigned _sp = 0; while (cond) { __builtin_amdgcn_s_sleep(1); \
    if ((++_sp & 255u) == 0u) { if (xb_ld(&(bar)[XB_TMO])) break; if (_sp > XB_SPIN_CAP) { atomicAdd(&(bar)[XB_TMO], 1u); break; } } } } while (0)

struct XcdBarrier {
    unsigned* bar; unsigned x;
    volatile LAS unsigned* st;
};

__device__ __forceinline__ XcdBarrier xcd_barrier_post(unsigned* bar, volatile LAS unsigned* st) {
    XcdBarrier b; b.bar = bar; b.x = xb_xcc_id(); b.st = st;
    if (threadIdx.x == 0) st[2] = xb_add(&bar[XB_XCNT(b.x)], 1u);
    return b;
}
__device__ __forceinline__ void xcd_barrier_complete(unsigned* bar, unsigned x, unsigned& nloc, unsigned& nx) {
    const unsigned G = gridDim.x * gridDim.y * gridDim.z;
    unsigned sum, cnt, mine, sp = 0u;
    for (;;) {
        sum = 0u; cnt = 0u; mine = 0u;
#pragma unroll
        for (unsigned j = 0; j < 16; ++j) { const unsigned c = xb_ld(&bar[XB_XCNT(j)]); sum += c; cnt += (c > 0u) ? 1u : 0u; mine = (j == x) ? c : mine; }
        if (sum == G) break;
        __builtin_amdgcn_s_sleep(1);
        if ((++sp & 255u) == 0u) { if (xb_ld(&bar[XB_TMO])) break; if (sp > XB_SPIN_CAP) { atomicAdd(&bar[XB_TMO], 1u); break; } }
    }
    nloc = mine > 0u ? mine : 1u; nx = cnt > 0u ? cnt : 1u;
}

__device__ __forceinline__ void xcd_barrier(const XcdBarrier& b) {
    asm volatile("s_waitcnt vmcnt(0)" ::: "memory");
    __syncthreads();
    if (threadIdx.x == 0) {
        unsigned* bar = b.bar;
        __builtin_amdgcn_s_waitcnt(0);
        unsigned nloc = b.st[0], nx = b.st[1];
        if (nloc == 0u) { xcd_barrier_complete(bar, b.x, nloc, nx); b.st[0] = nloc; b.st[1] = nx; }
        const unsigned old = xb_add(&bar[XB_XSUB(b.x)], 1u);
        const unsigned gen = old / nloc;
        if (old + 1u == (gen + 1u) * nloc) {
            __builtin_amdgcn_fence(__ATOMIC_RELEASE, "agent");
            asm volatile("s_waitcnt vmcnt(0)" ::: "memory");
            const unsigned og = xb_add(&bar[XB_TOP], 1u);
            const unsigned tg = og / nx;
            if (og + 1u == (tg + 1u) * nx) xb_add(&bar[XB_TOPGEN], 1u);
            else XB_SPIN(xb_ld(&bar[XB_TOPGEN]) == tg, bar);
            __builtin_amdgcn_fence(__ATOMIC_ACQUIRE, "agent");
            xb_add(&bar[XB_XGEN(b.x)], 1u);
            asm volatile("s_waitcnt vmcnt(0)" ::: "memory");
        } else {
            XB_SPIN(xb_ld(&bar[XB_XGEN(b.x)]) == gen, bar);
            __builtin_amdgcn_fence(__ATOMIC_ACQUIRE, "agent");
            asm volatile("s_waitcnt vmcnt(0)" ::: "memory");
        }
    }
    __syncthreads();
}

#ifndef PROBE_DUP
#define PROBE_DUP -1
#endif
constexpr int LDS_BYTES = 147456;
__global__ void __launch_bounds__(512, 2) mk_fwd(Args args) {
    extern __shared__ __attribute__((aligned(16))) unsigned char lds_raw[];
    LAS unsigned char* lds = (LAS unsigned char*)lds_raw;
    cg::grid_group grid = cg::this_grid();
    const int tid = threadIdx.x, lane = tid & 63, wave = __builtin_amdgcn_readfirstlane(tid >> 6), G = gridDim.x;
    unsigned char* ws = args.ws;
    const int lo = args.ph_lo, hi = args.ph_hi;
    if (tid < 64) ((LAS unsigned*)(lds + 131072))[tid] = 0u;
    __syncthreads();
    XcdBarrier bar = xcd_barrier_post((unsigned*)(ws + WS_CTL), (volatile LAS unsigned*)(lds + 131072 + 64));
    if (hi > 1000) grid.sync();
    const float* mod = (const float*)(ws + WS_MOD);
    float* Y = args.out + OUT_Y;
    bf16_t* H = (bf16_t*)(ws + WS_H); bf16_t* ACT = (bf16_t*)(ws + WS_ACT);
#define IN(k) (lo <= (k) && (k) < hi)
#define SEAM(k) do { if (IN(k) && IN((k) + 1)) xcd_barrier(bar); } while (0)
#define GEMM_PHASE(EPI, e, Aptr, Bptr, N_, K_) do { pg8::Gemm g_{(const bf16_t*)(Aptr), (const bf16_t*)(Bptr), NTOK, (N_), (K_)}; pg8::StaticOrder S_; S_.init(NTOK, (N_), G, vb); \
        pg8::gemm_phase<EPI, pg8::StaticOrder, true, true>(lds, g_, S_, e); } while (0)

    float* SSb = (float*)(ws + WS_SS); float* BVIN = (float*)(ws + WS_BVIN); float* BVFF2 = (float*)(ws + WS_BVFF2);
    const int gwv = blockIdx.x * 8 + wave, NGWv = G * 8;
#define PHASE(k, ...) if (IN(k)) { __VA_ARGS__ if (PROBE_DUP == (k)) { xcd_barrier(bar); __VA_ARGS__ } }
    PHASE(0, { phase0(args, lds, tid, lane, wave, G); }) SEAM(0);
    int vb = blockIdx.x;
    if (IN(0) && IN(1)) {
        volatile LAS unsigned* stw = (volatile LAS unsigned*)(lds + 131072 + 64);
        if (tid == 0) { const unsigned* bw = (const unsigned*)(ws + WS_CTL); bool ok = (G % 8 == 0) && bar.x < 8u;
            for (int j = 0; j < 8; ++j) ok = ok && (xb_ld((unsigned*)&bw[XB_XCNT(j)]) == (unsigned)(G / 8));
            stw[3] = ok ? (stw[2] * 8u + bar.x) : (unsigned)blockIdx.x; }
        __syncthreads();
        vb = (int)stw[3];
    }
    vb = __builtin_amdgcn_readfirstlane(vb);
    PHASE(1, { norm_phase(args.in[I_XP], args.in[I_XS], args.in[I_GFF1], mod, 0, H, G, wave, lane);
               bvec_items((const bf16_t*)(ws + WS_WIN), DIN, mod, 3, BVIN, gwv, NGWv, lane); }) SEAM(1);
    PHASE(2, { EpiSwiGLU<false> e{ws, nullptr, 0}; GEMM_PHASE(EpiSwiGLU<false>, e, H, ws + WS_FF1IN, 2 * DFF, DM);
               if (G == 256) { if (vb >= 128) late_copies(args, lds, lane, wave, (vb - 128) * 8 + wave, 1024); } else late_copies(args, lds, lane, wave, vb * 8 + wave, G * 8); }) SEAM(2);
    PHASE(3, { typedef EpiResid<true, 2, 1, 3> E3; E3 e{args.in[I_XP], (long)(args.in[I_XS] - args.in[I_XP]) - (long)NCTX * DM, Y, ws, args.in[I_GMIX]}; GEMM_PHASE(E3, e, ACT, ws + WS_FF1OUT, DM, DFF); }) SEAM(3);
    PHASE(4, { LAS float* tbl = (LAS float*)(lds + 141824); { pg8::StaticOrder S_; S_.init(NTOK, DIN, G, vb); rstd_table(SSb, S_, tbl, 5, tid); }
               EpiWin e{ws, args.out + OUT_K, args.in[I_QG], args.in[I_KG], lds + 131072 + 512, tbl, 5};
               GEMM_PHASE(EpiWin, e, H, ws + WS_WIN, DIN, DM); }) SEAM(4);
    PHASE(5, { mixer_phase(args, lds, tid, lane, wave, G, 3, vb); bvec_items((const bf16_t*)(ws + WS_FF2IN), 2 * DFF, mod, 6, BVFF2, gwv, NGWv, lane); }) SEAM(5);
    PHASE(6, { { EpiMix<1> e{ws, nullptr}; GEMM_PHASE(EpiMix<1>, e, ws + WS_ACT + 64 * MiB, ws + WS_WBP, DM, DATT); }
               { EpiMix<2> e{ws, nullptr}; GEMM_PHASE(EpiMix<2>, e, H, ws + WS_WBA, DM, DATT); } }) SEAM(6);
    if (IN(7)) { typedef EpiResid<true, 5, 2, 6> E8; E8 e{Y, 0L, Y, ws, args.in[I_GFF2]}; GEMM_PHASE(E8, e, ws + WS_P, ws + WS_WOUT, DM, DM); } SEAM(7);
    PHASE(8, { LAS float* tbl = (LAS float*)(lds + 131072 + 512); { pg8::StaticOrder S_; S_.init(NTOK, 2 * DFF, G, vb); rstd_table(SSb, S_, tbl, 15, tid); }
               EpiSwiGLU<true> e{ws, tbl, 15}; GEMM_PHASE(EpiSwiGLU<true>, e, H, ws + WS_FF2IN, 2 * DFF, DM); }) SEAM(8);
    if (IN(9)) { typedef EpiResid<false, 8, 1, 0> E10; E10 e{Y, 0L, Y, ws, nullptr}; GEMM_PHASE(E10, e, ACT, ws + WS_FF2OUT, DM, DFF); }
}

#ifndef MK_PER_PHASE
#define MK_PER_PHASE 0
#endif
extern "C" void kernel_launch(void* const* d_in, const int* in_sizes, int n_in, void* d_out, int out_size, void* d_ws, size_t ws_size, hipStream_t stream) {
    static int grid = 0;
    if (grid == 0) {
        if (n_in != 24 || ws_size < WS_END) { fprintf(stderr, "kernel_launch: unexpected n_in %d / ws_size %zu (need %zu)\n", n_in, ws_size, (size_t)WS_END); grid = -1; return; }
        int dev = 0, cus = 0, per_cu = 0;
        hipGetDevice(&dev); hipDeviceGetAttribute(&cus, hipDeviceAttributeMultiprocessorCount, dev);
        if (hipFuncSetAttribute((const void*)mk_fwd, hipFuncAttributeMaxDynamicSharedMemorySize, LDS_BYTES) != hipSuccess) { fprintf(stderr, "kernel_launch: hipFuncSetAttribute failed\n"); grid = -1; return; }
        if (hipOccupancyMaxActiveBlocksPerMultiprocessor(&per_cu, (const void*)mk_fwd, 512, LDS_BYTES) != hipSuccess || per_cu < 1) { fprintf(stderr, "kernel_launch: occupancy query says %d\n", per_cu); per_cu = 1; }
        (void)hipGetLastError();
        grid = cus * per_cu;
        fprintf(stderr, "kernel_launch: grid %d (cus %d x %d), ws %zu\n", grid, cus, per_cu, ws_size);
    }
    if (grid < 0) return;
    if (hipMemsetAsync((char*)d_ws + WS_CTL, 0, CTL_BYTES, stream) != hipSuccess) { fprintf(stderr, "kernel_launch: memset failed\n"); return; }
    Args a{};
    for (int i = 0; i < 24; ++i) a.in[i] = (const float*)d_in[i];
    a.out = (float*)d_out; a.ws = (unsigned char*)d_ws;
#if MK_PER_PHASE
    for (int p = 0; p < 10; ++p) { a.ph_lo = p; a.ph_hi = p + 1; hipLaunchKernelGGL(mk_fwd, dim3(grid), dim3(512), LDS_BYTES, stream, a); }
#else
    a.ph_lo = 0; a.ph_hi = 10;
    void* kargs[] = {&a};
    hipError_t e = hipLaunchCooperativeKernel((const void*)mk_fwd, dim3(grid), dim3(512), kargs, LDS_BYTES, stream);
    if (e != hipSuccess) fprintf(stderr, "kernel_launch: cooperative launch failed: %s (grid %d)\n", hipGetErrorString(e), grid);
#endif
}
```

```cpp
#include <hip/hip_runtime.h>
#include <hip/hip_cooperative_groups.h>
#include <cstdio>
#include <cstdint>
namespace cg = cooperative_groups;
namespace pg8 {
#define PG8_LAS __attribute__((address_space(3)))
typedef unsigned short bf16_t;
typedef short bf16x8 __attribute__((ext_vector_type(8)));
typedef float f32x4 __attribute__((ext_vector_type(4)));
typedef unsigned u32x4 __attribute__((ext_vector_type(4)));
constexpr int BM = 256, BK = 64, HALF = 128, HTB = HALF * BK * 2  , STAGE_BYTES = 8 * HTB, NXCD = 8, WGM = 8;

__host__ __device__ __forceinline__ int lds_byte(int r, int c) { const int st = (r >> 4) * 2 + (c >> 5), rr = r & 15, cc = c & 31, ob = rr * 64 + cc * 2; return st * 1024 + (ob ^ (((ob >> 9) & 1) << 5)); }
__host__ __device__ __forceinline__ void stage_rc(int b, int& R, int& C) { const int st = b / 1024, sb = b % 1024, swz = sb ^ (((sb >> 9) & 1) << 5); R = (st >> 1) * 16 + swz / 64; C = (st & 1) * 32 + (swz % 64) / 2; }
__host__ __device__ __forceinline__ int perm32(int rho) { const int n = rho >> 4, i = rho & 15; return 8 * (i >> 2) + 4 * n + (i & 3); }

struct Unit { int pm, pn, ord; };
struct Gemm { const bf16_t* A; const bf16_t* Bt; int M, N, K; };

struct StaticOrder {
    int nM, nN, nwg, G, c;
    __host__ __device__ void init(int M, int N, int G_, int c_) { nM = M / BM; nN = N / BM; nwg = nM * nN; G = G_; c = c_; }
    __host__ __device__ bool next(int i, Unit& u) const {
        const long L = (long)i * G + c; if (L >= nwg) return false;
        int wgid = (int)L; { const int q = nwg / NXCD, r = nwg % NXCD, xcd = wgid % NXCD, off = wgid / NXCD; wgid = (xcd < r ? xcd * (q + 1) : r * (q + 1) + (xcd - r) * q) + off; }
        const int nig = WGM * nN, gid = wgid / nig, fm = gid * WGM, gsz = (nM - fm) < WGM ? (nM - fm) : WGM;
        u.pm = fm + ((wgid % nig) % gsz); u.pn = (wgid % nig) / gsz; u.ord = i; return true;
    }
    __device__ __forceinline__ void a_ready(const Unit&) const {}
    __device__ __forceinline__ void done(const Unit&) const {}
};

__device__ __forceinline__ unsigned cvt_pk_bf16(float lo, float hi) { unsigned r; asm volatile("v_cvt_pk_bf16_f32 %0, %1, %2" : "=v"(r) : "v"(lo), "v"(hi)); return r; }
template <class Epi, class Sched, bool ALIGN_EPI = false, bool SP2 = false>
__device__ __forceinline__ void gemm_phase(PG8_LAS unsigned char* lds, const Gemm g, const Sched S, const Epi E) {
    const int tid = threadIdx.x, wid = __builtin_amdgcn_readfirstlane(tid >> 6), lane = tid & 63, wr = wid >> 2, wc = wid & 3, fr = lane & 15, fq = lane >> 4;
    const int K = g.K, nt = K / BK;
    unsigned voffA[2], voffB[2];
#pragma unroll
    for (int i = 0; i < 2; ++i) { int R, C; stage_rc(tid * 16 + i * 8192, R, C); const int Rb = Epi::PERM ? ((R & ~31) + perm32(R & 31)) : R;
        voffA[i] = (unsigned)(R * K + C) * 2u; voffB[i] = (unsigned)(Rb * K + C) * 2u; }
    const size_t kstep = (size_t)(BK * 2);
    const size_t hstep = (size_t)HALF * K * 2;
    const size_t tstep = 2 * hstep;
    const unsigned ldsw = (unsigned)wid * 1024u;
    const int aoff = lds_byte(wr * 64 + fr, fq * 8), boff = lds_byte(wc * 32 + fr, fq * 8);
#define PG8_SA(b, h) (((b) * 2 + (h)) * HTB)
#define PG8_SB(b, h) ((4 + (b) * 2 + (h)) * HTB)
#define PG8_STAGE(bufoff, gbase, voff) do { _Pragma("unroll") for (int _i = 0; _i < 2; ++_i) \
        __builtin_amdgcn_global_load_lds((const unsigned*)((const char*)(gbase) + (voff)[_i]), (PG8_LAS unsigned*)(lds + (bufoff) + ldsw + _i * 8192), 16, 0, 0); } while (0)
#define PG8_LDA(dst, b, h) do { _Pragma("unroll") for (int m = 0; m < 4; ++m) _Pragma("unroll") for (int k = 0; k < 2; ++k) dst[m][k] = *(const PG8_LAS bf16x8*)(lds + PG8_SA(b, h) + aoff + m * 2048 + k * 1024); } while (0)
#define PG8_LDB(dst, b, h) do { _Pragma("unroll") for (int n = 0; n < 2; ++n) _Pragma("unroll") for (int k = 0; k < 2; ++k) dst[n][k] = *(const PG8_LAS bf16x8*)(lds + PG8_SB(b, h) + boff + n * 2048 + k * 1024); } while (0)
#define PG8_MMA(ai, bj, At, Bt) do { __builtin_amdgcn_s_setprio(1); _Pragma("unroll") for (int m = 0; m < 4; ++m) _Pragma("unroll") for (int n = 0; n < 2; ++n) _Pragma("unroll") for (int k = 0; k < 2; ++k) \
        acc[ai][bj][m][n] = __builtin_amdgcn_mfma_f32_16x16x32_bf16(Bt[n][k], At[m][k], acc[ai][bj][m][n], 0, 0, 0); __builtin_amdgcn_s_setprio(0); } while (0)
#define PG8_WAIT_V(n) asm volatile("s_waitcnt vmcnt(" #n ")" ::: "memory")
#define PG8_WAIT_L(n) asm volatile("s_waitcnt lgkmcnt(" #n ")" ::: "memory")
#define PG8_BAR __builtin_amdgcn_s_barrier()
#define PG8_SCHED __builtin_amdgcn_sched_barrier(0)
    Unit cur, nxt; int ui = 0;
    if (!S.next(0, cur)) return;
    f32x4 acc[2][2][4][2];
#pragma unroll
    for (int a = 0; a < 2; ++a)
#pragma unroll
        for (int b = 0; b < 2; ++b)
#pragma unroll
            for (int m = 0; m < 4; ++m)
#pragma unroll
                for (int n = 0; n < 2; ++n) acc[a][b][m][n] = (f32x4){0.f, 0.f, 0.f, 0.f};
    bf16x8 At[4][2], B0[2][2], B1[2][2];
    const char* cA = (const char*)g.A + (size_t)cur.pm * tstep; const char* cB = (const char*)g.Bt + (size_t)cur.pn * tstep;
    S.a_ready(cur);
    if constexpr (SP2) {
        PG8_STAGE(PG8_SB(0, 0), cB, voffB); PG8_STAGE(PG8_SB(0, 1), cB + hstep, voffB); PG8_STAGE(PG8_SA(0, 0), cA, voffA); PG8_STAGE(PG8_SA(0, 1), cA + hstep, voffA);
        if (wr == 1) PG8_BAR;
        PG8_WAIT_V(2); PG8_BAR;
        PG8_STAGE(PG8_SB(1, 0), cB + kstep, voffB); PG8_STAGE(PG8_SA(1, 0), cA + kstep, voffA); PG8_STAGE(PG8_SB(1, 1), cB + hstep + kstep, voffB);
        PG8_WAIT_V(6); PG8_BAR;
    } else {
        PG8_STAGE(PG8_SB(0, 0), cB, voffB); PG8_STAGE(PG8_SA(0, 0), cA, voffA); PG8_STAGE(PG8_SB(0, 1), cB + hstep, voffB); PG8_STAGE(PG8_SA(0, 1), cA + hstep, voffA);
        if (wr == 1) PG8_BAR;
        PG8_WAIT_V(4); PG8_BAR;
        PG8_STAGE(PG8_SB(1, 0), cB + kstep, voffB); PG8_STAGE(PG8_SA(1, 0), cA + kstep, voffA); PG8_STAGE(PG8_SB(1, 1), cB + hstep + kstep, voffB);
        PG8_WAIT_V(6); PG8_BAR;
    }
    for (;;) {
        const bool has_next = S.next(ui + 1, nxt);
        const char* nA = has_next ? (const char*)g.A + (size_t)nxt.pm * tstep : cA; const char* nB = has_next ? (const char*)g.Bt + (size_t)nxt.pn * tstep : cB;
        for (int t = 0; t < nt; t += 2) {
            const bool last = (t == nt - 2);
            const char* a1 = cA + (size_t)(t + 1) * kstep;
            const char* a2 = last ? nA : cA + (size_t)(t + 2) * kstep; const char* b2 = last ? nB : cB + (size_t)(t + 2) * kstep;
            const char* a3 = a2 + kstep; const char* b3 = b2 + kstep;
            if (last && has_next) S.a_ready(nxt);
            if constexpr (SP2) {
            PG8_LDB(B0, 0, 0); PG8_LDB(B1, 0, 1); PG8_SCHED; PG8_LDA(At, 0, 0); PG8_STAGE(PG8_SA(1, 1), a1 + hstep, voffA);
            PG8_WAIT_V(8); PG8_WAIT_L(0); PG8_BAR; PG8_MMA(0, 0, At, B0); PG8_MMA(0, 1, At, B1); PG8_BAR; PG8_SCHED;
            PG8_LDA(At, 0, 1); PG8_STAGE(PG8_SB(0, 0), b2, voffB); PG8_STAGE(PG8_SB(0, 1), b2 + hstep, voffB); PG8_STAGE(PG8_SA(0, 0), a2, voffA);
            PG8_WAIT_V(8); PG8_WAIT_L(0); PG8_BAR; PG8_MMA(1, 0, At, B0); PG8_MMA(1, 1, At, B1); PG8_BAR; PG8_SCHED;
            PG8_LDB(B0, 1, 0); PG8_LDB(B1, 1, 1); PG8_SCHED; PG8_LDA(At, 1, 0); PG8_STAGE(PG8_SA(0, 1), a2 + hstep, voffA);
            PG8_WAIT_V(8); PG8_WAIT_L(0); PG8_BAR; PG8_MMA(0, 0, At, B0); PG8_MMA(0, 1, At, B1); PG8_BAR; PG8_SCHED;
            PG8_LDA(At, 1, 1); PG8_STAGE(PG8_SB(1, 0), b3, voffB); PG8_STAGE(PG8_SB(1, 1), b3 + hstep, voffB); PG8_STAGE(PG8_SA(1, 0), a3, voffA);
            PG8_WAIT_V(8); PG8_WAIT_L(0); PG8_BAR; PG8_MMA(1, 0, At, B0); PG8_MMA(1, 1, At, B1); PG8_BAR; PG8_SCHED;
            } else {
            PG8_LDB(B0, 0, 0); PG8_SCHED; PG8_LDA(At, 0, 0); PG8_STAGE(PG8_SA(1, 1), a1 + hstep, voffA);
            PG8_WAIT_L(8); PG8_BAR; PG8_WAIT_L(0); PG8_MMA(0, 0, At, B0); PG8_BAR; PG8_SCHED;
            PG8_LDB(B1, 0, 1); PG8_STAGE(PG8_SB(0, 0), b2, voffB);
            PG8_BAR; PG8_WAIT_L(0); PG8_MMA(0, 1, At, B1); PG8_BAR;
            PG8_LDA(At, 0, 1); PG8_STAGE(PG8_SA(0, 0), a2, voffA);
            PG8_BAR; PG8_WAIT_L(0); PG8_MMA(1, 0, At, B0); PG8_BAR; PG8_SCHED;
            PG8_STAGE(PG8_SB(0, 1), b2 + hstep, voffB);
            PG8_WAIT_V(6); PG8_BAR; PG8_MMA(1, 1, At, B1); PG8_BAR;
            PG8_LDB(B0, 1, 0); PG8_SCHED; PG8_LDA(At, 1, 0); PG8_STAGE(PG8_SA(0, 1), a2 + hstep, voffA);
            PG8_WAIT_L(8); PG8_BAR; PG8_WAIT_L(0); PG8_MMA(0, 0, At, B0); PG8_BAR; PG8_SCHED;
            PG8_LDB(B1, 1, 1); PG8_STAGE(PG8_SB(1, 0), b3, voffB);
            PG8_BAR; PG8_WAIT_L(0); PG8_MMA(0, 1, At, B1); PG8_BAR;
            PG8_LDA(At, 1, 1); PG8_STAGE(PG8_SA(1, 0), a3, voffA);
            PG8_BAR; PG8_WAIT_L(0); PG8_MMA(1, 0, At, B0); PG8_BAR; PG8_SCHED;
            PG8_STAGE(PG8_SB(1, 1), b3 + hstep, voffB);
            PG8_WAIT_V(6); PG8_BAR; PG8_MMA(1, 1, At, B1); PG8_BAR;
            }
        }
        if constexpr (ALIGN_EPI) { if (wr == 0) PG8_BAR; }
        if constexpr (!Epi::AFTER_DRAIN) { E(acc, cur, wr, wc, fr, fq); S.done(cur); }
        if (!has_next) break;
#pragma unroll
        for (int a = 0; a < 2; ++a)
#pragma unroll
            for (int b = 0; b < 2; ++b)
#pragma unroll
                for (int m = 0; m < 4; ++m)
#pragma unroll
                    for (int n = 0; n < 2; ++n) acc[a][b][m][n] = (f32x4){0.f, 0.f, 0.f, 0.f};
        cur = nxt; cA = nA; cB = nB; ++ui;
        if constexpr (ALIGN_EPI) { if (wr == 1) PG8_BAR; }
    }
    PG8_WAIT_V(0);
    if constexpr (!ALIGN_EPI) { if (wr == 0) PG8_BAR; }
    PG8_BAR;
    if constexpr (Epi::AFTER_DRAIN) { E.fused(acc, cur, wr, wc, fr, fq, lds, wid, lane); S.done(cur); }
#undef PG8_SA
#undef PG8_SB
#undef PG8_STAGE
#undef PG8_LDA
#undef PG8_LDB
#undef PG8_MMA
#undef PG8_WAIT_V
#undef PG8_WAIT_L
#undef PG8_BAR
#undef PG8_SCHED
}
}

#define LAS __attribute__((address_space(3)))
using pg8::bf16_t; using pg8::bf16x8; using pg8::f32x4; using pg8::u32x4;
typedef float f32x16 __attribute__((ext_vector_type(16)));
typedef float f32x2_t __attribute__((ext_vector_type(2)));
typedef __bf16 bf16x2_t __attribute__((ext_vector_type(2)));
typedef unsigned u32x2 __attribute__((ext_vector_type(2)));

constexpr int DM = 1024, NTOK = 16384, NCTX = 8192, DFF = 2816, DATT = 512, DIN = 4096, NMOD = 9;
constexpr float EPS = 1e-6f, LOG2E = 1.4426950408889634f;
constexpr size_t MiB = 1u << 20;
constexpr size_t WS_FF1IN = 0, WS_FF1OUT = 11 * MiB, WS_FF2IN = 17 * MiB, WS_FF2OUT = 28 * MiB, WS_WIN = 34 * MiB, WS_WBP = 42 * MiB, WS_WBA = 43 * MiB, WS_WOUT = 44 * MiB,
                 WS_WPOOL = 46 * MiB, WS_MOD = 47 * MiB, WS_KC = 48 * MiB, WS_VTC = 50 * MiB;
constexpr size_t WS_H = 52 * MiB;
constexpr size_t WS_ACT = 84 * MiB;
constexpr size_t WS_P = 172 * MiB;
constexpr size_t WS_Q = 204 * MiB;
constexpr size_t WS_K = 220 * MiB;
constexpr size_t WS_VT = 236 * MiB;
constexpr size_t WS_CTL = 252 * MiB, CTL_BYTES = 16384;
constexpr size_t WS_SS = 253 * MiB;
constexpr size_t WS_BVIN = 47 * MiB + 512 * 1024, WS_BVFF2 = WS_BVIN + 128 * 1024;
constexpr size_t WS_END = 254 * MiB;
static_assert(WS_END <= 256 * MiB, "d_ws map");
constexpr size_t KV_LAT = (size_t)32 * 8 * 8 * 2048;
constexpr size_t OUT_Y = 0, OUT_K = (size_t)NTOK * DM, OUT_V = OUT_K + (size_t)NCTX * DATT;

__device__ __forceinline__ unsigned pkbf(float lo, float hi) { f32x2_t v = {lo, hi}; bf16x2_t b = __builtin_convertvector(v, bf16x2_t); return __builtin_bit_cast(unsigned, b); }
__device__ __forceinline__ float bflo(unsigned w) { return __uint_as_float(w << 16); }
__device__ __forceinline__ float bfhi(unsigned w) { return __uint_as_float(w & 0xffff0000u); }
__device__ __forceinline__ float fast_sigmoid(float x) { return __builtin_amdgcn_rcpf(1.0f + __builtin_amdgcn_exp2f(-x * LOG2E)); }
__device__ __forceinline__ float wave_sum(float v) {
#pragma unroll
    for (int o = 1; o < 64; o <<= 1) v += __shfl_xor(v, o);
    return v;
}
__device__ __forceinline__ int cond_of_pm(int pm) { return pm < 32 ? 0 : 1 + ((pm - 32) >> 3); }

__device__ __forceinline__ float row_sumsq(const float* SS, int row, int fq) {
    const f32x4 a = *(const f32x4*)(SS + (size_t)row * 16 + 4 * fq); float s = (a[0] + a[1]) + (a[2] + a[3]);
    s += __shfl_xor(s, 16); s += __shfl_xor(s, 32); return s;
}
__device__ __forceinline__ float rstd_of(float sumsq) { return 1.0f / sqrtf(sumsq * (1.0f / DM) + EPS); }

__device__ __forceinline__ void rstd_table(const float* SS, const pg8::StaticOrder& S, LAS float* tbl, int nmax, int tid) {
    pg8::Unit u;
    for (int i = 0; i < nmax && S.next(i, u); ++i)
        if (tid < 256) { const f32x4* p = (const f32x4*)(SS + (size_t)(u.pm * 256 + tid) * 16); const f32x4 a = (p[0] + p[1]) + (p[2] + p[3]); tbl[i * 256 + tid] = rstd_of(((a[0] + a[1]) + (a[2] + a[3]))); }
    __syncthreads();
}

#define EPI_ROWS(ai, m) (u.pm * 256 + (ai) * 128 + wr * 64 + (m) * 16 + fr)

template <bool NORMED> struct EpiSwiGLU {
    static constexpr bool PERM = true, AFTER_DRAIN = false;
    unsigned char* ws; const LAS float* tbl; int nmax;
    __device__ __forceinline__ void operator()(const f32x4 (&acc)[2][2][4][2], const pg8::Unit& u, int wr, int wc, int fr, int fq) const {
        bf16_t* O = (bf16_t*)(ws + WS_ACT); const float* bvec = (const float*)(ws + WS_BVFF2); const float* SS = (const float*)(ws + WS_SS);
        const int col = u.pn * 128 + wc * 32 + 8 * fq;
        f32x4 bv[2][2];
        if (NORMED) { const float* bp = bvec + (size_t)cond_of_pm(u.pm) * (2 * DFF) + u.pn * 256 + wc * 32 + 8 * fq;
#pragma unroll
            for (int bj = 0; bj < 2; ++bj)
#pragma unroll
                for (int n = 0; n < 2; ++n) bv[bj][n] = *(const f32x4*)(bp + bj * 128 + 4 * n); }
#pragma unroll
        for (int ai = 0; ai < 2; ++ai)
#pragma unroll
            for (int m = 0; m < 4; ++m) {
                const int row = EPI_ROWS(ai, m);
                const float rs = NORMED ? (u.ord < nmax ? tbl[u.ord * 256 + ai * 128 + wr * 64 + m * 16 + fr] : rstd_of(row_sumsq(SS, row, fq))) : 1.f;
                float v[8];
#pragma unroll
                for (int n = 0; n < 2; ++n)
#pragma unroll
                    for (int j = 0; j < 4; ++j) { float g = acc[ai][0][m][n][j], up = acc[ai][1][m][n][j]; if (NORMED) { g = g * rs + bv[0][n][j]; up = up * rs + bv[1][n][j]; } v[4 * n + j] = g * fast_sigmoid(g) * up; }
                u32x4 w; w.x = pkbf(v[0], v[1]); w.y = pkbf(v[2], v[3]); w.z = pkbf(v[4], v[5]); w.w = pkbf(v[6], v[7]);
                *(u32x4*)(O + (size_t)row * DFF + col) = w;
            }
    }
};
template <bool NEXT, int GI, int COEF2, int MNEXT> struct EpiResid {
    static constexpr bool PERM = true, AFTER_DRAIN = false;
    const float* base0; long d1;
    float* out; unsigned char* ws; const float* gnext;
    __device__ __forceinline__ void operator()(const f32x4 (&acc)[2][2][4][2], const pg8::Unit& u, int wr, int wc, int fr, int fq) const {
        constexpr int gi = GI, mnext = MNEXT; constexpr float coef = 0.5f * COEF2;
        bf16_t* XA = (bf16_t*)(ws + WS_H); float* SS = (float*)(ws + WS_SS);
        const float* mc = (const float*)(ws + WS_MOD) + (size_t)cond_of_pm(u.pm) * (NMOD * DM);
        const float* gv = mc + gi * DM;
        const float* base = base0 + (u.pm < 32 ? 0L : d1);
        const int col = u.pn * 256 + wc * 32 + 8 * fq;
        f32x4 g[2][2], an[2][2];
#pragma unroll
        for (int bj = 0; bj < 2; ++bj)
#pragma unroll
            for (int n = 0; n < 2; ++n) { g[bj][n] = *(const f32x4*)(gv + col + bj * 128 + 4 * n) * coef;
                if (NEXT) an[bj][n] = *(const f32x4*)(gnext + col + bj * 128 + 4 * n) * (*(const f32x4*)(mc + (mnext + 1) * DM + col + bj * 128 + 4 * n) + 1.0f); }
#pragma unroll
        for (int ai = 0; ai < 2; ++ai)
#pragma unroll
            for (int m = 0; m < 4; ++m) { const int row = EPI_ROWS(ai, m); const size_t off = (size_t)row * DM + col; float ss = 0.f;
#pragma unroll
                for (int bj = 0; bj < 2; ++bj) { f32x4 o[2];
#pragma unroll
                    for (int n = 0; n < 2; ++n) { const f32x4 b = *(const f32x4*)(base + off + bj * 128 + 4 * n); o[n] = b + g[bj][n] * acc[ai][bj][m][n]; if (NEXT) *(f32x4*)(out + off + bj * 128 + 4 * n) = o[n]; else __builtin_nontemporal_store(o[n], (f32x4*)(out + off + bj * 128 + 4 * n));
                        if (NEXT) ss += (o[n][0] * o[n][0] + o[n][1] * o[n][1]) + (o[n][2] * o[n][2] + o[n][3] * o[n][3]); }
                    if (NEXT) { const f32x4 xa = o[0] * an[bj][0], xb = o[1] * an[bj][1]; u32x4 w; w.x = pkbf(xa[0], xa[1]); w.y = pkbf(xa[2], xa[3]); w.z = pkbf(xb[0], xb[1]); w.w = pkbf(xb[2], xb[3]);
                        *(u32x4*)(XA + off + bj * 128) = w; }
                }
                if (NEXT) { ss += __shfl_xor(ss, 16); ss += __shfl_xor(ss, 32); if (fq == 0) SS[(size_t)row * 16 + u.pn * 4 + wc] = ss; }
            }
    }
};
struct EpiWin {
    static constexpr bool PERM = true, AFTER_DRAIN = false;
    unsigned char* ws; float* outk; const float* qgain; const float* kgain; LAS unsigned char* scr; const LAS float* tbl; int nmax;
    __device__ __forceinline__ void operator()(const f32x4 (&accr)[2][2][4][2], const pg8::Unit& u, int wr, int wc, int fr, int fq) const {
        const int pn = u.pn;
        float* P = (float*)(ws + WS_P); bf16_t* Q = (bf16_t*)(ws + WS_Q); bf16_t* Kb = (bf16_t*)(ws + WS_K); bf16_t* VT = (bf16_t*)(ws + WS_VT); bf16_t* Gt = (bf16_t*)(ws + WS_ACT);
        float* outv = outk + (size_t)NCTX * DATT; const float* bvec = (const float*)(ws + WS_BVIN);
        f32x4 (&acc)[2][2][4][2] = const_cast<f32x4 (&)[2][2][4][2]>(accr);
        { const float* bp = bvec + (size_t)cond_of_pm(u.pm) * DIN + pn * 256 + wc * 32 + 8 * fq; f32x4 bv[2][2];
#pragma unroll
            for (int bj = 0; bj < 2; ++bj)
#pragma unroll
                for (int n = 0; n < 2; ++n) bv[bj][n] = *(const f32x4*)(bp + bj * 128 + 4 * n);
#pragma unroll
            for (int ai = 0; ai < 2; ++ai)
#pragma unroll
                for (int m = 0; m < 4; ++m) { const float rs = u.ord < nmax ? tbl[u.ord * 256 + ai * 128 + wr * 64 + m * 16 + fr] : rstd_of(row_sumsq((const float*)(ws + WS_SS), EPI_ROWS(ai, m), fq));
#pragma unroll
                    for (int bj = 0; bj < 2; ++bj)
#pragma unroll
                        for (int n = 0; n < 2; ++n) acc[ai][bj][m][n] = accr[ai][bj][m][n] * rs + bv[bj][n]; } }

        if (pn < 2) {
            const int col = pn * 256 + wc * 32 + 8 * fq;
#pragma unroll
            for (int ai = 0; ai < 2; ++ai)
#pragma unroll
                for (int m = 0; m < 4; ++m) { float* rp = P + (size_t)EPI_ROWS(ai, m) * DATT + col;
#pragma unroll
                    for (int bj = 0; bj < 2; ++bj)
#pragma unroll
                        for (int n = 0; n < 2; ++n) *(f32x4*)(rp + bj * 128 + 4 * n) = acc[ai][bj][m][n]; }
        } else if (pn < 6) {
            const bool isk = pn >= 4;
            const float* gain = isk ? kgain : qgain;
            const int head = 4 * (pn & 1) + wc;
            f32x4 gn[2][2];
#pragma unroll
            for (int bj = 0; bj < 2; ++bj)
#pragma unroll
                for (int n = 0; n < 2; ++n) gn[bj][n] = *(const f32x4*)(gain + 32 * bj + 8 * fq + 4 * n);
#pragma unroll
            for (int ai = 0; ai < 2; ++ai)
#pragma unroll
                for (int m = 0; m < 4; ++m) {
                    float ss = 0.f;
#pragma unroll
                    for (int bj = 0; bj < 2; ++bj)
#pragma unroll
                        for (int n = 0; n < 2; ++n) { const f32x4 x = acc[ai][bj][m][n]; ss += (x[0] * x[0] + x[1] * x[1]) + (x[2] * x[2] + x[3] * x[3]); }
                    ss += __shfl_xor(ss, 16); ss += __shfl_xor(ss, 32);
                    const float rstd = 1.0f / sqrtf(ss * (1.0f / 64.0f) + EPS);
                    const int row = EPI_ROWS(ai, m);
#pragma unroll
                    for (int bj = 0; bj < 2; ++bj) {
                        const f32x4 a = acc[ai][bj][m][0] * rstd * gn[bj][0], b = acc[ai][bj][m][1] * rstd * gn[bj][1];
                        const int c = head * 64 + 32 * bj + 8 * fq;
                        u32x4 w; w.x = pkbf(a[0], a[1]); w.y = pkbf(a[2], a[3]); w.z = pkbf(b[0], b[1]); w.w = pkbf(b[2], b[3]);
                        if (!isk) *(u32x4*)(Q + (size_t)row * DATT + c) = w;
                        else {
                            const bool ctx = u.pm < 32; const int rl = row - u.pm * 256, tok = ctx ? rl : ((u.pm - 32) & 7) * 256 + rl;
                            const size_t tile = ctx ? (size_t)(u.pm * 8 + head) * 8 + (tok >> 5) : KV_LAT / 2048 + (size_t)(((u.pm - 32) >> 3) * 8 + head) * 64 + (tok >> 5);
                            *(u32x4*)(Kb + tile * 2048 + (2 * bj + (fq >> 1)) * 512 + (32 * (fq & 1) + (tok & 31)) * 8) = w; }
                        if (isk && u.pm < 32) { __builtin_nontemporal_store(a, (f32x4*)(outk + (size_t)row * DATT + c)); __builtin_nontemporal_store(b, (f32x4*)(outk + (size_t)row * DATT + c + 4)); }
                    }
                }
        } else if (pn < 8) {
            const bool ctx = u.pm < 32;
            LAS unsigned char* pad = scr + (wr * 4 + wc) * 1280;
            const int lane_ = fq * 16 + fr, d_ = lane_ & 31, hh_ = lane_ >> 5;
#pragma unroll
            for (int ai = 0; ai < 2; ++ai)
#pragma unroll
                for (int m = 0; m < 4; ++m) {
                    const int rl0 = ai * 128 + wr * 64 + m * 16, row = u.pm * 256 + rl0 + fr, tok0 = ctx ? rl0 : ((u.pm - 32) & 7) * 256 + rl0;
#pragma unroll
                    for (int bj = 0; bj < 2; ++bj) {
                        const int c = (pn - 6) * 256 + bj * 128 + wc * 32 + 8 * fq, head = c >> 6;
                        const f32x4 a = acc[ai][bj][m][0], b = acc[ai][bj][m][1];
                        u32x4 w; w.x = pkbf(a[0], a[1]); w.y = pkbf(a[2], a[3]); w.z = pkbf(b[0], b[1]); w.w = pkbf(b[2], b[3]);
                        *(LAS u32x4*)(pad + fr * 80 + fq * 16) = w;
                        if (ctx) { __builtin_nontemporal_store(a, (f32x4*)(outv + (size_t)row * DATT + c)); __builtin_nontemporal_store(b, (f32x4*)(outv + (size_t)row * DATT + c + 4)); }
                        unsigned short e[8];
#pragma unroll
                        for (int j = 0; j < 8; ++j) e[j] = *(const LAS unsigned short*)(pad + (8 * (j >> 2) + 4 * hh_ + (j & 3)) * 80 + d_ * 2);
                        u32x4 o; o.x = e[0] | ((unsigned)e[1] << 16); o.y = e[2] | ((unsigned)e[3] << 16); o.z = e[4] | ((unsigned)e[5] << 16); o.w = e[6] | ((unsigned)e[7] << 16);
                        const size_t tile = ctx ? (size_t)(u.pm * 8 + head) * 8 + (tok0 >> 5) : KV_LAT / 2048 + (size_t)(((u.pm - 32) >> 3) * 8 + head) * 64 + (tok0 >> 5);
                        *(u32x4*)(VT + tile * 2048 + ((wc & 1) * 2 + ((tok0 >> 4) & 1)) * 512 + lane_ * 8) = o;
                    }
                }
        } else {
            const int col = (pn - 8) * 256 + wc * 32 + 8 * fq;
#pragma unroll
            for (int ai = 0; ai < 2; ++ai)
#pragma unroll
                for (int m = 0; m < 4; ++m) { bf16_t* rp = Gt + (size_t)EPI_ROWS(ai, m) * 2048 + col;
#pragma unroll
                    for (int bj = 0; bj < 2; ++bj) { const f32x4 a = acc[ai][bj][m][0], b = acc[ai][bj][m][1];
                        u32x4 w; w.x = pkbf(fast_sigmoid(a[0]), fast_sigmoid(a[1])); w.y = pkbf(fast_sigmoid(a[2]), fast_sigmoid(a[3]));
                        w.z = pkbf(fast_sigmoid(b[0]), fast_sigmoid(b[1])); w.w = pkbf(fast_sigmoid(b[2]), fast_sigmoid(b[3]));
                        *(u32x4*)(rp + bj * 128) = w; }
                }
        }
    }
};
template <int MODE> struct EpiMix {
    static constexpr bool PERM = true, AFTER_DRAIN = false;
    unsigned char* ws; const float* vec;
    __device__ __forceinline__ void operator()(const f32x4 (&acc)[2][2][4][2], const pg8::Unit& u, int wr, int wc, int fr, int fq) const {
        bf16_t* O = (bf16_t*)(ws + (MODE == 0 ? WS_H + 16 * MiB : MODE == 1 ? WS_K : WS_P)); constexpr int ldo = MODE == 0 ? DATT : DM;
        const bf16_t* Gt = (const bf16_t*)(ws + WS_ACT); const bf16_t* T1 = (const bf16_t*)(ws + WS_K);
        const int col = u.pn * 256 + wc * 32 + 8 * fq;
        f32x4 sv[2][2];
        if (MODE == 0) {
#pragma unroll
            for (int bj = 0; bj < 2; ++bj)
#pragma unroll
                for (int n = 0; n < 2; ++n) sv[bj][n] = *(const f32x4*)(vec + col + bj * 128 + 4 * n);
        }
#pragma unroll
        for (int ai = 0; ai < 2; ++ai)
#pragma unroll
            for (int m = 0; m < 4; ++m) { const int row = EPI_ROWS(ai, m);
#pragma unroll
                for (int bj = 0; bj < 2; ++bj) {
                    f32x4 a = acc[ai][bj][m][0], b = acc[ai][bj][m][1];
                    const int c = col + bj * 128;
                    if (MODE == 0) { a = a * sv[bj][0]; b = b * sv[bj][1]; }
                    else {
                        const u32x4 gw = *(const u32x4*)(Gt + (size_t)row * 2048 + (MODE == 2 ? 1024 : 0) + c);
                        const f32x4 ga = {bflo(gw.x), bfhi(gw.x), bflo(gw.y), bfhi(gw.y)}, gb = {bflo(gw.z), bfhi(gw.z), bflo(gw.w), bfhi(gw.w)};
                        a = a * ga; b = b * gb;
                        if (MODE == 2) { const u32x4 tw = *(const u32x4*)(T1 + (size_t)row * DM + c);
                            a = a + (f32x4){bflo(tw.x), bfhi(tw.x), bflo(tw.y), bfhi(tw.y)}; b = b + (f32x4){bflo(tw.z), bfhi(tw.z), bflo(tw.w), bfhi(tw.w)}; }
                    }
                    u32x4 w; w.x = pkbf(a[0], a[1]); w.y = pkbf(a[2], a[3]); w.z = pkbf(b[0], b[1]); w.w = pkbf(b[2], b[3]);
                    *(u32x4*)(O + (size_t)row * ldo + c) = w;
                }
            }
    }
};

__device__ __forceinline__ unsigned f2bf(float f) { unsigned u = __builtin_bit_cast(unsigned, f); return (u + 0x7fffu + ((u >> 16) & 1u)) >> 16; }
__device__ __forceinline__ unsigned pk2(float lo, float hi) { return f2bf(lo) | (f2bf(hi) << 16); }
__device__ __forceinline__ int dest_row(int mode, int n) {
    if (mode == 1) { const int up = n >= DFF, j = up ? n - DFF : n; return 256 * (j >> 7) + (up ? 128 : 0) + (j & 127); }
    if (mode == 2) { if (n >= 512 && n < 1536) { const int tb = n & ~255, cc = n & 255, hh = cc >> 6, d = cc & 63; return tb + 128 * (d >> 5) + 32 * hh + (d & 31); } return n; }
    return n;
}
__device__ __forceinline__ void tr_item(const float* W, int N, bf16_t* WT, int ldt, int mode, LAS float* scr, int item, int lane) {
    const int nblk = N / 32, kb = item / nblk, nb = item % nblk, k0 = 64 * kb, n0 = 32 * nb;
#pragma unroll
    for (int i = 0; i < 32; ++i) { const int kk = 2 * i + (lane >> 5); scr[kk * 33 + (lane & 31)] = W[(size_t)(k0 + kk) * N + n0 + (lane & 31)]; }
    asm volatile("s_waitcnt lgkmcnt(0)" ::: "memory");
    const int c = lane & 7;
#pragma unroll
    for (int j = 0; j < 4; ++j) { const int n = (lane >> 3) + 8 * j; const LAS float* s = scr + (8 * c) * 33 + n;
        u32x4 o; o.x = pk2(s[0 * 33], s[1 * 33]); o.y = pk2(s[2 * 33], s[3 * 33]); o.z = pk2(s[4 * 33], s[5 * 33]); o.w = pk2(s[6 * 33], s[7 * 33]);
        *(u32x4*)(WT + (size_t)dest_row(mode, n0 + n) * ldt + k0 + 8 * c) = o; }
    asm volatile("s_waitcnt lgkmcnt(0)" ::: "memory");
}

struct Args { const float* in[24]; float* out; unsigned char* ws; int ph_lo, ph_hi; };
enum { I_XP = 0, I_XS, I_CK, I_CV, I_C, I_CCTX, I_WADA, I_BADA, I_GFF1, I_WFF1IN, I_WFF1OUT, I_GMIX, I_WIN, I_QG, I_KG, I_WPOOL, I_PSCALE, I_RPB, I_WBP, I_WBA, I_WOUT, I_GFF2, I_WFF2IN, I_WFF2OUT };

__device__ __forceinline__ void phase0(const Args& a, LAS unsigned char* lds, int tid, int lane, int wave, int G) {
    unsigned char* ws = a.ws;
    if ((int)blockIdx.x < 144) {
        LAS float* sc = (LAS float*)lds; LAS float* red = sc + 5 * 1024;
        for (int i = tid; i < 5 * 1024; i += 512) { const float v = i < 1024 ? a.in[I_CCTX][i] : a.in[I_C][i - 1024]; sc[i] = v * fast_sigmoid(v); }
        __syncthreads();
        float* mod = (float*)(ws + WS_MOD);
        for (int u = blockIdx.x; u < 144; u += G) {
            const int rsub = lane >> 4, c4 = (lane & 15) * 4;
            f32x4 acc[5];
#pragma unroll
            for (int c = 0; c < 5; ++c) acc[c] = (f32x4){0.f, 0.f, 0.f, 0.f};
            const float* wp = a.in[I_WADA] + (size_t)(wave * 128 + rsub) * (NMOD * DM) + u * 64 + c4;
            const LAS float* scw = sc + wave * 128 + rsub;
#pragma unroll 8
            for (int i = 0; i < 32; ++i) {
                const f32x4 wv = *(const f32x4*)(wp + (size_t)(4 * i) * (NMOD * DM));
#pragma unroll
                for (int c = 0; c < 5; ++c) acc[c] += wv * scw[c * 1024 + 4 * i];
            }
#pragma unroll
            for (int c = 0; c < 5; ++c)
#pragma unroll
                for (int j = 0; j < 4; ++j) { float v = acc[c][j]; v += __shfl_xor(v, 16); v += __shfl_xor(v, 32); acc[c][j] = v; }
            if (lane < 16) {
#pragma unroll
                for (int c = 0; c < 5; ++c) *(LAS f32x4*)(red + (wave * 5 + c) * 64 + c4) = acc[c]; }
            __syncthreads();
            if (tid < 320) { const int c = tid >> 6, l = tid & 63; float s = 0.f;
#pragma unroll
                for (int w = 0; w < 8; ++w) s += red[(w * 5 + c) * 64 + l];
                mod[c * (NMOD * DM) + u * 64 + l] = s + a.in[I_BADA][u * 64 + l]; }
            __syncthreads();
        }
    }
    LAS float* scr = (LAS float*)(lds + wave * 16384);
    constexpr int I_FIN = 16 * 176, I_IN = 16 * 128, I_FOUT = 44 * 32;
    constexpr int NITEMS = I_FIN + I_IN + I_FOUT;
    const bool bal = (G == 256); const int bx = blockIdx.x;
    if (bal && bx < 144) return;
    const int slot0 = bal ? (bx - 144) * 8 + wave : bx * 8 + wave, nslots = bal ? 112 * 8 : G * 8;
    for (int it = slot0; it < NITEMS; it += nslots) {
        int r = it;
        if (r < I_FIN) { tr_item(a.in[I_WFF1IN], 2 * DFF, (bf16_t*)(ws + WS_FF1IN), DM, 1, scr, r, lane); continue; } r -= I_FIN;
        if (r < I_IN) { tr_item(a.in[I_WIN], DIN, (bf16_t*)(ws + WS_WIN), DM, 2, scr, r, lane); continue; } r -= I_IN;
        tr_item(a.in[I_WFF1OUT], DM, (bf16_t*)(ws + WS_FF1OUT), DFF, 0, scr, r, lane);
    }
}

__device__ __forceinline__ void late_copies(const Args& a, LAS unsigned char* lds, int lane, int wave, int wi, int nw) {
    unsigned char* ws = a.ws;
    LAS float* scr = (LAS float*)(lds + wave * 16384);
    constexpr int I_FIN = 16 * 176, I_FOUT = 44 * 32, I_BR = 8 * 32, I_OUT = 16 * 32, I_FOLD = 4 * 8 * 16;
    constexpr int NITEMS = I_FIN + I_FOUT + I_BR + I_OUT + I_FOLD;
    for (int it = wi; it < NITEMS; it += nw) {
        int r = it;
        if (r < I_FIN) { tr_item(a.in[I_WFF2IN], 2 * DFF, (bf16_t*)(ws + WS_FF2IN), DM, 1, scr, r, lane); continue; } r -= I_FIN;
        if (r < I_FOUT) { tr_item(a.in[I_WFF2OUT], DM, (bf16_t*)(ws + WS_FF2OUT), DFF, 0, scr, r, lane); continue; } r -= I_FOUT;
        if (r < I_BR) { tr_item(a.in[I_WBA], DM, (bf16_t*)(ws + WS_WBA), DATT, 0, scr, r, lane); continue; } r -= I_BR;
        if (r < I_OUT) { tr_item(a.in[I_WOUT], DM, (bf16_t*)(ws + WS_WOUT), DM, 0, scr, r, lane); continue; } r -= I_OUT;
        {
            const int g = r >> 7, ib = (r >> 4) & 7, n = (r & 15) * 64 + lane;
            const float* wp = a.in[I_WPOOL] + (size_t)g * 128 * 128 + (size_t)(ib * 16) * 128; const float* ps = a.in[I_PSCALE] + g * 128; const float* wb = a.in[I_WBP] + (size_t)(g * 128) * DM + n;
#pragma unroll
            for (int q = 0; q < 8; ++q) { const int e4 = q * 64 + lane, i = e4 >> 5, j4 = (e4 & 31) * 4; const f32x4 w4 = *(const f32x4*)(wp + i * 128 + j4) * *(const f32x4*)(ps + j4); *(LAS f32x4*)(scr + i * 128 + j4) = w4; }
            asm volatile("s_waitcnt lgkmcnt(0)" ::: "memory");
            float acc[16];
#pragma unroll
            for (int i = 0; i < 16; ++i) acc[i] = 0.f;
#pragma unroll 2
            for (int j = 0; j < 128; j += 4) { const float w0 = wb[(size_t)j * DM], w1 = wb[(size_t)(j + 1) * DM], w2 = wb[(size_t)(j + 2) * DM], w3 = wb[(size_t)(j + 3) * DM];
#pragma unroll
                for (int i = 0; i < 16; ++i) { const f32x4 p4 = *(const LAS f32x4*)(scr + i * 128 + j); acc[i] += (p4[0] * w0 + p4[1] * w1) + (p4[2] * w2 + p4[3] * w3); } }
            asm volatile("s_waitcnt lgkmcnt(0)" ::: "memory");
            u32x4 o0, o1; o0.x = pk2(acc[0], acc[1]); o0.y = pk2(acc[2], acc[3]); o0.z = pk2(acc[4], acc[5]); o0.w = pk2(acc[6], acc[7]);
            o1.x = pk2(acc[8], acc[9]); o1.y = pk2(acc[10], acc[11]); o1.z = pk2(acc[12], acc[13]); o1.w = pk2(acc[14], acc[15]);
            bf16_t* dst = (bf16_t*)(ws + WS_WBP) + (size_t)n * DATT + g * 128 + ib * 16; *(u32x4*)dst = o0; *(u32x4*)(dst + 8) = o1;
        }
    }
    const int gt = wi * 64 + lane, NGT = nw * 64;
    for (int i = gt; i < 2 * 32 * 16 * 256; i += NGT) {
        const int isv = i >= 32 * 16 * 256, ch = isv ? i - 32 * 16 * 256 : i, ln = ch & 63, q4 = (ch >> 6) & 3, tile = (ch >> 8) & 15, bh = ch >> 12, b = bh >> 3, h = bh & 7, r32 = ln & 31, hh = ln >> 5;
        u32x4 o;
        if (!isv) { const float* src = a.in[I_CK] + ((size_t)(b * 512 + tile * 32 + r32) * 8 + h) * 64 + 16 * q4 + 8 * hh; const f32x4 v0 = *(const f32x4*)src, v1 = *(const f32x4*)(src + 4);
            o.x = pk2(v0[0], v0[1]); o.y = pk2(v0[2], v0[3]); o.z = pk2(v1[0], v1[1]); o.w = pk2(v1[2], v1[3]);
            *(u32x4*)((bf16_t*)(ws + WS_KC) + (size_t)ch * 8) = o; }
        else { const int t = q4 >> 1, sK = q4 & 1; float v[8];
#pragma unroll
            for (int j = 0; j < 8; ++j) { const int key = 16 * sK + 8 * (j >> 2) + 4 * hh + (j & 3); v[j] = a.in[I_CV][((size_t)(b * 512 + tile * 32 + key) * 8 + h) * 64 + 32 * t + r32]; }
            o.x = pk2(v[0], v[1]); o.y = pk2(v[2], v[3]); o.z = pk2(v[4], v[5]); o.w = pk2(v[6], v[7]);
            *(u32x4*)((bf16_t*)(ws + WS_VTC) + (size_t)ch * 8) = o; }
    }
}

__device__ __forceinline__ void norm_phase(const float* src0, const float* src1, const float* gvec, const float* mod, int mi, bf16_t* H, int G, int wave, int lane) {
    for (int rb = blockIdx.x; rb < NTOK / 64; rb += G) {
        const int rbase = rb * 64, cond = rbase < NCTX ? 0 : 1 + ((rbase - NCTX) >> 11);
        const float* sh = mod + (size_t)cond * (NMOD * DM) + mi * DM; const float* scl = sh + DM;
        f32x4 av[4], sv[4];
#pragma unroll
        for (int j = 0; j < 4; ++j) { const int c = 4 * lane + 256 * j; av[j] = *(const f32x4*)(gvec + c) * (*(const f32x4*)(scl + c) + 1.0f); sv[j] = *(const f32x4*)(sh + c); }
        for (int i0 = 0; i0 < 8; i0 += 4) {
            f32x4 v[4][4]; float s[4];
#pragma unroll
            for (int i = 0; i < 4; ++i) {
                const int row = rbase + wave * 8 + i0 + i;
                const float* xr = row < NCTX ? src0 + (size_t)row * DM : src1 + (size_t)(row - NCTX) * DM;
#pragma unroll
                for (int j = 0; j < 4; ++j) v[i][j] = *(const f32x4*)(xr + 4 * lane + 256 * j);
            }
#pragma unroll
            for (int i = 0; i < 4; ++i) { s[i] = 0.f;
#pragma unroll
                for (int j = 0; j < 4; ++j) s[i] += (v[i][j][0] * v[i][j][0] + v[i][j][1] * v[i][j][1]) + (v[i][j][2] * v[i][j][2] + v[i][j][3] * v[i][j][3]); }
#pragma unroll
            for (int o = 1; o < 64; o <<= 1) {
#pragma unroll
                for (int i = 0; i < 4; ++i) s[i] += __shfl_xor(s[i], o); }
#pragma unroll
            for (int i = 0; i < 4; ++i) {
                const int row = rbase + wave * 8 + i0 + i;
                const float rstd = 1.0f / sqrtf(s[i] * (1.0f / DM) + EPS);
#pragma unroll
                for (int j = 0; j < 4; ++j) { const f32x4 o = v[i][j] * rstd * av[j] + sv[j]; u32x2 w; w.x = pkbf(o[0], o[1]); w.y = pkbf(o[2], o[3]); *(u32x2*)(H + (size_t)row * DM + 4 * lane + 256 * j) = w; }
            }
        }
    }
}

__device__ __forceinline__ void bvec_items(const bf16_t* Bt, int N, const float* mod, int mi, float* out, int gw, int NGW, int lane) {
    float sh[5][16];
#pragma unroll
    for (int c = 0; c < 5; ++c)
#pragma unroll
        for (int q = 0; q < 4; ++q) { const f32x4 v = *(const f32x4*)(mod + (size_t)c * (NMOD * DM) + mi * DM + 16 * lane + 4 * q); sh[c][4 * q] = v[0]; sh[c][4 * q + 1] = v[1]; sh[c][4 * q + 2] = v[2]; sh[c][4 * q + 3] = v[3]; }
    for (int n = gw; n < N; n += NGW) {
        const u32x4 w0 = *(const u32x4*)(Bt + (size_t)n * DM + 16 * lane), w1 = *(const u32x4*)(Bt + (size_t)n * DM + 16 * lane + 8);
        const float w[16] = {bflo(w0.x), bfhi(w0.x), bflo(w0.y), bfhi(w0.y), bflo(w0.z), bfhi(w0.z), bflo(w0.w), bfhi(w0.w), bflo(w1.x), bfhi(w1.x), bflo(w1.y), bfhi(w1.y), bflo(w1.z), bfhi(w1.z), bflo(w1.w), bfhi(w1.w)};
        float acc[5];
#pragma unroll
        for (int c = 0; c < 5; ++c) { float a = 0.f;
#pragma unroll
            for (int k = 0; k < 16; ++k) a += sh[c][k] * w[k];
            acc[c] = a; }
#pragma unroll
        for (int o = 1; o < 64; o <<= 1) {
#pragma unroll
            for (int c = 0; c < 5; ++c) acc[c] += __shfl_xor(acc[c], o); }
        if (lane == 0) {
#pragma unroll
            for (int c = 0; c < 5; ++c) out[(size_t)c * N + n] = acc[c]; }
    }
}

__device__ __forceinline__ int crow(int r, int hh) { return (r & 3) + 8 * (r >> 2) + 4 * hh; }
#define MFMA32(a, b, c) __builtin_amdgcn_mfma_f32_32x32x16_bf16((a), (b), (c), 0, 0, 0)
struct KVFrag { bf16x8 k[4]; bf16x8 v[4]; };
__device__ __forceinline__ void kv_load(KVFrag& f, const bf16_t* kt, const bf16_t* vt, int lane) {
#pragma unroll
    for (int i = 0; i < 4; ++i) { f.k[i] = *(const bf16x8*)(kt + i * 512 + lane * 8); f.v[i] = *(const bf16x8*)(vt + i * 512 + lane * 8); }
}
struct AttnState { f32x16 o0, o1; float mrun, lrun; };
template <bool LOCAL, int FAR = 0> __device__ __forceinline__ void attn_tile(AttnState& st, const KVFrag& f, const bf16x8 (&qf)[4], const LAS float* bq, int okb) {
    constexpr float C2 = 0.125f * LOG2E;
    constexpr int R0 = FAR == 2 ? 12 : 0, R1 = FAR == 1 ? 4 : 16;
    f32x16 s;
#pragma unroll
    for (int r = 0; r < 16; ++r) s[r] = 0.f;
#pragma unroll
    for (int d0 = 0; d0 < 4; ++d0) s = MFMA32(f.k[d0], qf[d0], s);
    if (LOCAL) {
#pragma unroll
        for (int r = R0; r < R1; ++r) { const int cr = (r & 3) + 8 * (r >> 2); const bool ok = (unsigned)(okb + cr) < 16u; s[r] = ok ? __builtin_fmaf(s[r], C2, bq[cr]) : -1e30f; }
    }
    float mx = s[R0];
#pragma unroll
    for (int r = R0 + 1; r < R1; ++r) mx = fmaxf(mx, s[r]);
    if (!LOCAL) mx *= C2;
    mx = fmaxf(mx, __shfl_xor(mx, 32));
    const float mnew = fmaxf(st.mrun, mx);
    if (__builtin_amdgcn_ballot_w64(mnew > st.mrun) != 0ull) {
        const float alpha = __builtin_amdgcn_exp2f(st.mrun - mnew);
        st.lrun *= alpha;
#pragma unroll
        for (int r = 0; r < 16; ++r) { st.o0[r] *= alpha; st.o1[r] *= alpha; }
        st.mrun = mnew;
    }
    float ps = 0.f;
#pragma unroll
    for (int r = 0; r < 16; ++r) { if (r >= R0 && r < R1) { s[r] = __builtin_amdgcn_exp2f(LOCAL ? s[r] - mnew : __builtin_fmaf(s[r], C2, -mnew)); ps += s[r]; } else s[r] = 0.f; }
    st.lrun += ps;
    u32x4 p0, p1;
    p0.x = pkbf(s[0], s[1]); p0.y = pkbf(s[2], s[3]); p0.z = pkbf(s[4], s[5]); p0.w = pkbf(s[6], s[7]);
    p1.x = pkbf(s[8], s[9]); p1.y = pkbf(s[10], s[11]); p1.z = pkbf(s[12], s[13]); p1.w = pkbf(s[14], s[15]);
    const bf16x8 pb0 = __builtin_bit_cast(bf16x8, p0), pb1 = __builtin_bit_cast(bf16x8, p1);
    if (FAR != 2) { st.o0 = MFMA32(f.v[0], pb0, st.o0); st.o1 = MFMA32(f.v[2], pb0, st.o1); }
    if (FAR != 1) { st.o0 = MFMA32(f.v[1], pb1, st.o0); st.o1 = MFMA32(f.v[3], pb1, st.o1); }
}
__device__ __forceinline__ void attn_wave(const bf16_t* Qp, bf16_t* Op, int nd, const bf16_t* KFd, const bf16_t* VFd,
                                          int nl, const bf16_t* KFl, const bf16_t* VFl, int rq, int r0, int g, const LAS float* rpbh, int lane) {
    const int r32 = lane & 31, hh = lane >> 5;
    bf16x8 qf[4];
#pragma unroll
    for (int d0 = 0; d0 < 4; ++d0) qf[d0] = *(const bf16x8*)(Qp + (size_t)r32 * DATT + d0 * 16 + 8 * hh);
    AttnState st;
#pragma unroll
    for (int r = 0; r < 16; ++r) { st.o0[r] = 0.f; st.o1[r] = 0.f; }
    st.mrun = -1e30f; st.lrun = 0.f;
    const int nt = nd + nl;
    const int qc = 32 * g + r32; int c0 = qc - 8; c0 = c0 < 0 ? 0 : (c0 > 48 ? 48 : c0);
    KVFrag f0, f1, f2;
#define ATT_LOAD(f, ti) do { const int ti_ = (ti); if (ti_ < nt) { if (ti_ < nd) kv_load(f, KFd + (size_t)ti_ * 2048, VFd + (size_t)ti_ * 2048, lane); \
        else { const int tx_ = 2 * r0 + (ti_ - nd); kv_load(f, KFl + (size_t)tx_ * 2048, VFl + (size_t)tx_ * 2048, lane); } } } while (0)
#define ATT_TILE(f, ti) do { const int ti_ = (ti); if (ti_ < nt) { if (ti_ < nd) attn_tile<false, 0>(st, f, qf, nullptr, 0); \
        else { const int tl_ = ti_ - nd, kb_ = 32 * (tl_ & 1) + 4 * hh; const LAS float* bq_ = rpbh + (r0 + (tl_ >> 1) - rq + 7) * 31 + (kb_ - qc + 15); \
            if ((tl_ & 1) == g) attn_tile<true, 0>(st, f, qf, bq_, kb_ - c0); else if (g == 0) attn_tile<true, 1>(st, f, qf, bq_, kb_ - c0); else attn_tile<true, 2>(st, f, qf, bq_, kb_ - c0); } } } while (0)
    ATT_LOAD(f0, 0); ATT_LOAD(f1, 1);
    for (int ti = 0; ti < nt; ti += 3) {
        ATT_LOAD(f2, ti + 2); ATT_TILE(f0, ti);
        ATT_LOAD(f0, ti + 3); ATT_TILE(f1, ti + 1);
        ATT_LOAD(f1, ti + 4); ATT_TILE(f2, ti + 2);
    }
#undef ATT_LOAD
#undef ATT_TILE
    float lrun = st.lrun; lrun += __shfl_xor(lrun, 32);
    const float inv = 1.0f / lrun;
    bf16_t* op = Op + (size_t)r32 * DATT + 4 * hh;
#pragma unroll
    for (int rg = 0; rg < 4; ++rg) {
        u32x2 w; w.x = pkbf(st.o0[4 * rg] * inv, st.o0[4 * rg + 1] * inv); w.y = pkbf(st.o0[4 * rg + 2] * inv, st.o0[4 * rg + 3] * inv); *(u32x2*)(op + 8 * rg) = w;
        u32x2 x; x.x = pkbf(st.o1[4 * rg] * inv, st.o1[4 * rg + 1] * inv); x.y = pkbf(st.o1[4 * rg + 2] * inv, st.o1[4 * rg + 3] * inv); *(u32x2*)(op + 32 + 8 * rg) = x;
    }
}

template <int HW> __device__ __forceinline__ void dpass_item(const float* ps, bf16_t* ds, int t0, int L) {
    f32x2_t x[32 + 2 * HW];
#pragma unroll
    for (int j = 0; j < 32 + 2 * HW; ++j) { const int t = t0 - HW + j; const bool ok = t >= 0 && t < L; const f32x2_t v = *(const f32x2_t*)(ps + (size_t)(ok ? t : t0) * DATT); x[j] = ok ? v : (f32x2_t){0.f, 0.f}; }
    f32x2_t s = {0.f, 0.f};
#pragma unroll
    for (int j = 0; j < 2 * HW; ++j) s += x[j];
#pragma unroll
    for (int i = 0; i < 32; ++i) {
        const int t = t0 + i; const int lo = t - HW < 0 ? 0 : t - HW, hi = t + HW > L ? L : t + HW;
        const f32x2_t d = s * (1.0f / (float)(hi - lo)) - x[i + HW];
        *(unsigned*)(ds + (size_t)t * DATT) = pkbf(d[0], d[1]);
        if (i < 31) s += x[i + 2 * HW] - x[i];
    }
}

__device__ __forceinline__ void mixer_phase(const Args& a, LAS unsigned char* lds, int tid, int lane, int wave, int G, int what, int vb) {
    unsigned char* ws = a.ws;
    if (what & 1) {
    const bf16_t* Q = (const bf16_t*)(ws + WS_Q); const bf16_t* Kb = (const bf16_t*)(ws + WS_K); const bf16_t* VT = (const bf16_t*)(ws + WS_VT);
    const bf16_t* KC = (const bf16_t*)(ws + WS_KC); const bf16_t* VTC = (const bf16_t*)(ws + WS_VTC);
    bf16_t* ATT = (bf16_t*)(ws + WS_H);
    LAS float* rpbl = (LAS float*)(lds + 1024);
    for (int i = tid; i < 8 * 15 * 31; i += 512) rpbl[i] = a.in[I_RPB][i] * LOG2E;
    __syncthreads();
    for (int u = vb; u < 256; u += G) {
        {
            const int ul = (u & 7) * 32 + (u >> 3), bh = ul >> 3, b = bh >> 3, h = bh & 7, rq = 4 * (ul & 7) + (wave >> 1), g = wave & 1;
            int r0 = rq - 4; r0 = r0 < 0 ? 0 : (r0 > 24 ? 24 : r0);
            const size_t row0 = (size_t)NCTX + (size_t)b * 2048 + rq * 64 + 32 * g;
            attn_wave(Q + row0 * DATT + h * 64, ATT + row0 * DATT + h * 64, 16, KC + (size_t)bh * 16 * 2048, VTC + (size_t)bh * 16 * 2048,
                      16, Kb + KV_LAT + (size_t)bh * 64 * 2048, VT + KV_LAT + (size_t)bh * 64 * 2048, rq, r0, g, rpbl + h * 15 * 31, lane);
        }
        {
            const int b = u >> 3, h = u & 7;
            const size_t row0 = (size_t)b * 256 + 32 * wave;
            attn_wave(Q + row0 * DATT + h * 64, ATT + row0 * DATT + h * 64, 8, Kb + (size_t)u * 8 * 2048, VT + (size_t)u * 8 * 2048,
                      0, Kb, VT, 0, 0, 0, rpbl, lane);
        }
    }
    }
    if (!(what & 2)) return;
    const float* P = (const float*)(ws + WS_P); bf16_t* D = (bf16_t*)(ws + WS_ACT + 64 * MiB);
    const int gw = blockIdx.x * 8 + wave, NGW = G * 8;
    for (int it = gw; it < (NTOK / 32) * 4; it += NGW) {
        const int g = it & 3, row0 = (it >> 2) * 32;
        int t0, L; if (row0 < NCTX) { t0 = row0 & 255; L = 256; } else { t0 = (row0 - NCTX) & 2047; L = 2048; }
        const float* ps = P + (size_t)(row0 - t0) * DATT + g * 128 + 2 * lane; bf16_t* ds = D + (size_t)(row0 - t0) * DATT + g * 128 + 2 * lane;
        if (g == 0) dpass_item<1>(ps, ds, t0, L); else if (g == 1) dpass_item<2>(ps, ds, t0, L); else if (g == 2) dpass_item<4>(ps, ds, t0, L); else dpass_item<8>(ps, ds, t0, L);
    }
}


typedef unsigned v4u __attribute__((ext_vector_type(4)));
#define XB_TMO      128
#define XB_XCNT(j)  (256  + 64 * (j))
#define XB_XSUB(j)  (1280 + 64 * (j))
#define XB_XGEN(j)  (2304 + 64 * (j))
#define XB_TOP      3328
#define XB_TOPGEN   3392
#define XCD_BAR_WORDS 3456
#define XB_SPIN_CAP (1u << 18)

__device__ __forceinline__ unsigned xb_ld(unsigned* p)              { return __hip_atomic_load(p, __ATOMIC_RELAXED, __HIP_MEMORY_SCOPE_AGENT); }
__device__ __forceinline__ unsigned xb_add(unsigned* p, unsigned v) { return __hip_atomic_fetch_add(p, v, __ATOMIC_RELAXED, __HIP_MEMORY_SCOPE_AGENT); }
__device__ __forceinline__ unsigned xb_xcc_id() { return (unsigned)__builtin_amdgcn_s_getreg((3 << 11) | 20) & 0xFu; }
#define XB_SPIN(cond, bar) do { unsigned _sp = 0; while (cond) { __builtin_amdgcn_s_sleep(1); \
    if ((++_sp & 255u) == 0u) { if (xb_ld(&(bar)[XB_TMO])) break; if (_sp > XB_SPIN_CAP) { atomicAdd(&(bar)[XB_TMO], 1u); break; } } } } while (0)

struct XcdBarrier {
    unsigned* bar; unsigned x;
    volatile LAS unsigned* st;
};

__device__ __forceinline__ XcdBarrier xcd_barrier_post(unsigned* bar, volatile LAS unsigned* st) {
    XcdBarrier b; b.bar = bar; b.x = xb_xcc_id(); b.st = st;
    if (threadIdx.x == 0) st[2] = xb_add(&bar[XB_XCNT(b.x)], 1u);
    return b;
}
__device__ __forceinline__ void xcd_barrier_complete(unsigned* bar, unsigned x, unsigned& nloc, unsigned& nx) {
    const unsigned G = gridDim.x * gridDim.y * gridDim.z;
    unsigned sum, cnt, mine, sp = 0u;
    for (;;) {
        sum = 0u; cnt = 0u; mine = 0u;
#pragma unroll
        for (unsigned j = 0; j < 16; ++j) { const unsigned c = xb_ld(&bar[XB_XCNT(j)]); sum += c; cnt += (c > 0u) ? 1u : 0u; mine = (j == x) ? c : mine; }
        if (sum == G) break;
        __builtin_amdgcn_s_sleep(1);
        if ((++sp & 255u) == 0u) { if (xb_ld(&bar[XB_TMO])) break; if (sp > XB_SPIN_CAP) { atomicAdd(&bar[XB_TMO], 1u); break; } }
    }
    nloc = mine > 0u ? mine : 1u; nx = cnt > 0u ? cnt : 1u;
}

__device__ __forceinline__ void xcd_barrier(const XcdBarrier& b) {
    asm volatile("s_waitcnt vmcnt(0)" ::: "memory");
    __syncthreads();
    if (threadIdx.x == 0) {
        unsigned* bar = b.bar;
        __builtin_amdgcn_s_waitcnt(0);
        unsigned nloc = b.st[0], nx = b.st[1];
        if (nloc == 0u) { xcd_barrier_complete(bar, b.x, nloc, nx); b.st[0] = nloc; b.st[1] = nx; }
        const unsigned old = xb_add(&bar[XB_XSUB(b.x)], 1u);
        const unsigned gen = old / nloc;
        if (old + 1u == (gen + 1u) * nloc) {
            __builtin_amdgcn_fence(__ATOMIC_RELEASE, "agent");
            asm volatile("s_waitcnt vmcnt(0)" ::: "memory");
            const unsigned og = xb_add(&bar[XB_TOP], 1u);
            const unsigned tg = og / nx;
            if (og + 1u == (tg + 1u) * nx) xb_add(&bar[XB_TOPGEN], 1u);
            else XB_SPIN(xb_ld(&bar[XB_TOPGEN]) == tg, bar);
            __builtin_amdgcn_fence(__ATOMIC_ACQUIRE, "agent");
            xb_add(&bar[XB_XGEN(b.x)], 1u);
            asm volatile("s_waitcnt vmcnt(0)" ::: "memory");
        } else {
            XB_SPIN(xb_ld(&bar[XB_XGEN(b.x)]) == gen, bar);
            __builtin_amdgcn_fence(__ATOMIC_ACQUIRE, "agent");
            asm volatile("s_waitcnt vmcnt(0)" ::: "memory");
        }
    }
    __syncthreads();
}

#ifndef PROBE_DUP
#define PROBE_DUP -1
#endif
constexpr int LDS_BYTES = 147456;
__global__ void __launch_bounds__(512, 2) mk_fwd(Args args) {
    extern __shared__ __attribute__((aligned(16))) unsigned char lds_raw[];
    LAS unsigned char* lds = (LAS unsigned char*)lds_raw;
    cg::grid_group grid = cg::this_grid();
    const int tid = threadIdx.x, lane = tid & 63, wave = __builtin_amdgcn_readfirstlane(tid >> 6), G = gridDim.x;
    unsigned char* ws = args.ws;
    const int lo = args.ph_lo, hi = args.ph_hi;
    if (tid < 64) ((LAS unsigned*)(lds + 131072))[tid] = 0u;
    __syncthreads();
    XcdBarrier bar = xcd_barrier_post((unsigned*)(ws + WS_CTL), (volatile LAS unsigned*)(lds + 131072 + 64));
    if (hi > 1000) grid.sync();
    const float* mod = (const float*)(ws + WS_MOD);
    float* Y = args.out + OUT_Y;
    bf16_t* H = (bf16_t*)(ws + WS_H); bf16_t* ACT = (bf16_t*)(ws + WS_ACT);
#define IN(k) (lo <= (k) && (k) < hi)
#define SEAM(k) do { if (IN(k) && IN((k) + 1)) xcd_barrier(bar); } while (0)
#define GEMM_PHASE(EPI, e, Aptr, Bptr, N_, K_) do { pg8::Gemm g_{(const bf16_t*)(Aptr), (const bf16_t*)(Bptr), NTOK, (N_), (K_)}; pg8::StaticOrder S_; S_.init(NTOK, (N_), G, vb); \
        pg8::gemm_phase<EPI, pg8::StaticOrder, true, true>(lds, g_, S_, e); } while (0)

    float* SSb = (float*)(ws + WS_SS); float* BVIN = (float*)(ws + WS_BVIN); float* BVFF2 = (float*)(ws + WS_BVFF2);
    const int gwv = blockIdx.x * 8 + wave, NGWv = G * 8;
#define PHASE(k, ...) if (IN(k)) { __VA_ARGS__ if (PROBE_DUP == (k)) { xcd_barrier(bar); __VA_ARGS__ } }
    PHASE(0, { phase0(args, lds, tid, lane, wave, G); }) SEAM(0);
    int vb = blockIdx.x;
    if (IN(0) && IN(1)) {
        volatile LAS unsigned* stw = (volatile LAS unsigned*)(lds + 131072 + 64);
        if (tid == 0) { const unsigned* bw = (const unsigned*)(ws + WS_CTL); bool ok = (G % 8 == 0) && bar.x < 8u;
            for (int j = 0; j < 8; ++j) ok = ok && (xb_ld((unsigned*)&bw[XB_XCNT(j)]) == (unsigned)(G / 8));
            stw[3] = ok ? (stw[2] * 8u + bar.x) : (unsigned)blockIdx.x; }
        __syncthreads();
        vb = (int)stw[3];
    }
    vb = __builtin_amdgcn_readfirstlane(vb);
    PHASE(1, { norm_phase(args.in[I_XP], args.in[I_XS], args.in[I_GFF1], mod, 0, H, G, wave, lane);
               bvec_items((const bf16_t*)(ws + WS_WIN), DIN, mod, 3, BVIN, gwv, NGWv, lane); }) SEAM(1);
    PHASE(2, { EpiSwiGLU<false> e{ws, nullptr, 0}; GEMM_PHASE(EpiSwiGLU<false>, e, H, ws + WS_FF1IN, 2 * DFF, DM);
               if (G == 256) { if (vb >= 128) late_copies(args, lds, lane, wave, (vb - 128) * 8 + wave, 1024); } else late_copies(args, lds, lane, wave, vb * 8 + wave, G * 8); }) SEAM(2);
    PHASE(3, { typedef EpiResid<true, 2, 1, 3> E3; E3 e{args.in[I_XP], (long)(args.in[I_XS] - args.in[I_XP]) - (long)NCTX * DM, Y, ws, args.in[I_GMIX]}; GEMM_PHASE(E3, e, ACT, ws + WS_FF1OUT, DM, DFF); }) SEAM(3);
    PHASE(4, { LAS float* tbl = (LAS float*)(lds + 141824); { pg8::StaticOrder S_; S_.init(NTOK, DIN, G, vb); rstd_table(SSb, S_, tbl, 5, tid); }
               EpiWin e{ws, args.out + OUT_K, args.in[I_QG], args.in[I_KG], lds + 131072 + 512, tbl, 5};
               GEMM_PHASE(EpiWin, e, H, ws + WS_WIN, DIN, DM); }) SEAM(4);
    PHASE(5, { mixer_phase(args, lds, tid, lane, wave, G, 3, vb); bvec_items((const bf16_t*)(ws + WS_FF2IN), 2 * DFF, mod, 6, BVFF2, gwv, NGWv, lane); }) SEAM(5);
    PHASE(6, { { EpiMix<1> e{ws, nullptr}; GEMM_PHASE(EpiMix<1>, e, ws + WS_ACT + 64 * MiB, ws + WS_WBP, DM, DATT); }
               { EpiMix<2> e{ws, nullptr}; GEMM_PHASE(EpiMix<2>, e, H, ws + WS_WBA, DM, DATT); } }) SEAM(6);
    if (IN(7)) { typedef EpiResid<true, 5, 2, 6> E8; E8 e{Y, 0L, Y, ws, args.in[I_GFF2]}; GEMM_PHASE(E8, e, ws + WS_P, ws + WS_WOUT, DM, DM); } SEAM(7);
    PHASE(8, { LAS float* tbl = (LAS float*)(lds + 131072 + 512); { pg8::StaticOrder S_; S_.init(NTOK, 2 * DFF, G, vb); rstd_table(SSb, S_, tbl, 15, tid); }
               EpiSwiGLU<true> e{ws, tbl, 15}; GEMM_PHASE(EpiSwiGLU<true>, e, H, ws + WS_FF2IN, 2 * DFF, DM); }) SEAM(8);
    if (IN(9)) { typedef EpiResid<false, 8, 1, 0> E10; E10 e{Y, 0L, Y, ws, nullptr}; GEMM_PHASE(E10, e, ACT, ws + WS_FF2OUT, DM, DFF); }
}

#ifndef MK_PER_PHASE
#define MK_PER_PHASE 0
#endif
extern "C" void kernel_launch(void* const* d_in, const int* in_sizes, int n_in, void* d_out, int out_size, void* d_ws, size_t ws_size, hipStream_t stream) {
    static int grid = 0;
    if (grid == 0) {
        if (n_in != 24 || ws_size < WS_END) { fprintf(stderr, "kernel_launch: unexpected n_in %d / ws_size %zu (need %zu)\n", n_in, ws_size, (size_t)WS_END); grid = -1; return; }
        int dev = 0, cus = 0, per_cu = 0;
        hipGetDevice(&dev); hipDeviceGetAttribute(&cus, hipDeviceAttributeMultiprocessorCount, dev);
        if (hipFuncSetAttribute((const void*)mk_fwd, hipFuncAttributeMaxDynamicSharedMemorySize, LDS_BYTES) != hipSuccess) { fprintf(stderr, "kernel_launch: hipFuncSetAttribute failed\n"); grid = -1; return; }
        if (hipOccupancyMaxActiveBlocksPerMultiprocessor(&per_cu, (const void*)mk_fwd, 512, LDS_BYTES) != hipSuccess || per_cu < 1) { fprintf(stderr, "kernel_launch: occupancy query says %d\n", per_cu); per_cu = 1; }
        (void)hipGetLastError();
        grid = cus * per_cu;
        fprintf(stderr, "kernel_launch: grid %d (cus %d x %d), ws %zu\n", grid, cus, per_cu, ws_size);
    }
    if (grid < 0) return;
    if (hipMemsetAsync((char*)d_ws + WS_CTL, 0, CTL_BYTES, stream) != hipSuccess) { fprintf(stderr, "kernel_launch: memset failed\n"); return; }
    Args a{};
    for (int i = 0; i < 24; ++i) a.in[i] = (const float*)d_in[i];
    a.out = (float*)d_out; a.ws = (unsigned char*)d_ws;
#if MK_PER_PHASE
    for (int p = 0; p < 10; ++p) { a.ph_lo = p; a.ph_hi = p + 1; hipLaunchKernelGGL(mk_fwd, dim3(grid), dim3(512), LDS_BYTES, stream, a); }
#else
    a.ph_lo = 0; a.ph_hi = 10;
    void* kargs[] = {&a};
    hipError_t e = hipLaunchCooperativeKernel((const void*)mk_fwd, dim3(grid), dim3(512), kargs, LDS_BYTES, stream);
    if (e != hipSuccess) fprintf(stderr, "kernel_launch: cooperative launch failed: %s (grid %d)\n", hipGetErrorString(e), grid);
#endif
}
```

```cpp
#include <hip/hip_runtime.h>
#include <hip/hip_cooperative_groups.h>
#include <cstdio>
#include <cstdint>
namespace cg = cooperative_groups;
namespace pg8 {
#define PG8_LAS __attribute__((address_space(3)))
typedef unsigned short bf16_t;
typedef short bf16x8 __attribute__((ext_vector_type(8)));
typedef float f32x4 __attribute__((ext_vector_type(4)));
typedef unsigned u32x4 __attribute__((ext_vector_type(4)));
constexpr int BM = 256, BK = 64, HALF = 128, HTB = HALF * BK * 2  , STAGE_BYTES = 8 * HTB, NXCD = 8, WGM = 8;

__host__ __device__ __forceinline__ int lds_byte(int r, int c) { const int st = (r >> 4) * 2 + (c >> 5), rr = r & 15, cc = c & 31, ob = rr * 64 + cc * 2; return st * 1024 + (ob ^ (((ob >> 9) & 1) << 5)); }
__host__ __device__ __forceinline__ void stage_rc(int b, int& R, int& C) { const int st = b / 1024, sb = b % 1024, swz = sb ^ (((sb >> 9) & 1) << 5); R = (st >> 1) * 16 + swz / 64; C = (st & 1) * 32 + (swz % 64) / 2; }
__host__ __device__ __forceinline__ int perm32(int rho) { const int n = rho >> 4, i = rho & 15; return 8 * (i >> 2) + 4 * n + (i & 3); }

struct Unit { int pm, pn, ord; };
struct Gemm { const bf16_t* A; const bf16_t* Bt; int M, N, K; };

struct StaticOrder {
    int nM, nN, nwg, G, c;
    __host__ __device__ void init(int M, int N, int G_, int c_) { nM = M / BM; nN = N / BM; nwg = nM * nN; G = G_; c = c_; }
    __host__ __device__ bool next(int i, Unit& u) const {
        const long L = (long)i * G + c; if (L >= nwg) return false;
        int wgid = (int)L; { const int q = nwg / NXCD, r = nwg % NXCD, xcd = wgid % NXCD, off = wgid / NXCD; wgid = (xcd < r ? xcd * (q + 1) : r * (q + 1) + (xcd - r) * q) + off; }
        const int nig = WGM * nN, gid = wgid / nig, fm = gid * WGM, gsz = (nM - fm) < WGM ? (nM - fm) : WGM;
        u.pm = fm + ((wgid % nig) % gsz); u.pn = (wgid % nig) / gsz; u.ord = i; return true;
    }
    __device__ __forceinline__ void a_ready(const Unit&) const {}
    __device__ __forceinline__ void done(const Unit&) const {}
};

__device__ __forceinline__ unsigned cvt_pk_bf16(float lo, float hi) { unsigned r; asm volatile("v_cvt_pk_bf16_f32 %0, %1, %2" : "=v"(r) : "v"(lo), "v"(hi)); return r; }
template <class Epi, class Sched, bool ALIGN_EPI = false, bool SP2 = false>
__device__ __forceinline__ void gemm_phase(PG8_LAS unsigned char* lds, const Gemm g, const Sched S, const Epi E) {
    const int tid = threadIdx.x, wid = __builtin_amdgcn_readfirstlane(tid >> 6), lane = tid & 63, wr = wid >> 2, wc = wid & 3, fr = lane & 15, fq = lane >> 4;
    const int K = g.K, nt = K / BK;
    unsigned voffA[2], voffB[2];
#pragma unroll
    for (int i = 0; i < 2; ++i) { int R, C; stage_rc(tid * 16 + i * 8192, R, C); const int Rb = Epi::PERM ? ((R & ~31) + perm32(R & 31)) : R;
        voffA[i] = (unsigned)(R * K + C) * 2u; voffB[i] = (unsigned)(Rb * K + C) * 2u; }
    const size_t kstep = (size_t)(BK * 2);
    const size_t hstep = (size_t)HALF * K * 2;
    const size_t tstep = 2 * hstep;
    const unsigned ldsw = (unsigned)wid * 1024u;
    const int aoff = lds_byte(wr * 64 + fr, fq * 8), boff = lds_byte(wc * 32 + fr, fq * 8);
#define PG8_SA(b, h) (((b) * 2 + (h)) * HTB)
#define PG8_SB(b, h) ((4 + (b) * 2 + (h)) * HTB)
#define PG8_STAGE(bufoff, gbase, voff) do { _Pragma("unroll") for (int _i = 0; _i < 2; ++_i) \
        __builtin_amdgcn_global_load_lds((const unsigned*)((const char*)(gbase) + (voff)[_i]), (PG8_LAS unsigned*)(lds + (bufoff) + ldsw + _i * 8192), 16, 0, 0); } while (0)
#define PG8_LDA(dst, b, h) do { _Pragma("unroll") for (int m = 0; m < 4; ++m) _Pragma("unroll") for (int k = 0; k < 2; ++k) dst[m][k] = *(const PG8_LAS bf16x8*)(lds + PG8_SA(b, h) + aoff + m * 2048 + k * 1024); } while (0)
#define PG8_LDB(dst, b, h) do { _Pragma("unroll") for (int n = 0; n < 2; ++n) _Pragma("unroll") for (int k = 0; k < 2; ++k) dst[n][k] = *(const PG8_LAS bf16x8*)(lds + PG8_SB(b, h) + boff + n * 2048 + k * 1024); } while (0)
#define PG8_MMA(ai, bj, At, Bt) do { __builtin_amdgcn_s_setprio(1); _Pragma("unroll") for (int m = 0; m < 4; ++m) _Pragma("unroll") for (int n = 0; n < 2; ++n) _Pragma("unroll") for (int k = 0; k < 2; ++k) \
        acc[ai][bj][m][n] = __builtin_amdgcn_mfma_f32_16x16x32_bf16(Bt[n][k], At[m][k], acc[ai][bj][m][n], 0, 0, 0); __builtin_amdgcn_s_setprio(0); } while (0)
#define PG8_WAIT_V(n) asm volatile("s_waitcnt vmcnt(" #n ")" ::: "memory")
#define PG8_WAIT_L(n) asm volatile("s_waitcnt lgkmcnt(" #n ")" ::: "memory")
#define PG8_BAR __builtin_amdgcn_s_barrier()
#define PG8_SCHED __builtin_amdgcn_sched_barrier(0)
    Unit cur, nxt; int ui = 0;
    if (!S.next(0, cur)) return;
    f32x4 acc[2][2][4][2];
#pragma unroll
    for (int a = 0; a < 2; ++a)
#pragma unroll
        for (int b = 0; b < 2; ++b)
#pragma unroll
            for (int m = 0; m < 4; ++m)
#pragma unroll
                for (int n = 0; n < 2; ++n) acc[a][b][m][n] = (f32x4){0.f, 0.f, 0.f, 0.f};
    bf16x8 At[4][2], B0[2][2], B1[2][2];
    const char* cA = (const char*)g.A + (size_t)cur.pm * tstep; const char* cB = (const char*)g.Bt + (size_t)cur.pn * tstep;
    S.a_ready(cur);
    if constexpr (SP2) {
        PG8_STAGE(PG8_SB(0, 0), cB, voffB); PG8_STAGE(PG8_SB(0, 1), cB + hstep, voffB); PG8_STAGE(PG8_SA(0, 0), cA, voffA); PG8_STAGE(PG8_SA(0, 1), cA + hstep, voffA);
        if (wr == 1) PG8_BAR;
        PG8_WAIT_V(2); PG8_BAR;
        PG8_STAGE(PG8_SB(1, 0), cB + kstep, voffB); PG8_STAGE(PG8_SA(1, 0), cA + kstep, voffA); PG8_STAGE(PG8_SB(1, 1), cB + hstep + kstep, voffB);
        PG8_WAIT_V(6); PG8_BAR;
    } else {
        PG8_STAGE(PG8_SB(0, 0), cB, voffB); PG8_STAGE(PG8_SA(0, 0), cA, voffA); PG8_STAGE(PG8_SB(0, 1), cB + hstep, voffB); PG8_STAGE(PG8_SA(0, 1), cA + hstep, voffA);
        if (wr == 1) PG8_BAR;
        PG8_WAIT_V(4); PG8_BAR;
        PG8_STAGE(PG8_SB(1, 0), cB + kstep, voffB); PG8_STAGE(PG8_SA(1, 0), cA + kstep, voffA); PG8_STAGE(PG8_SB(1, 1), cB + hstep + kstep, voffB);
        PG8_WAIT_V(6); PG8_BAR;
    }
    for (;;) {
        const bool has_next = S.next(ui + 1, nxt);
        const char* nA = has_next ? (const char*)g.A + (size_t)nxt.pm * tstep : cA; const char* nB = has_next ? (const char*)g.Bt + (size_t)nxt.pn * tstep : cB;
        for (int t = 0; t < nt; t += 2) {
            const bool last = (t == nt - 2);
            const char* a1 = cA + (size_t)(t + 1) * kstep;
            const char* a2 = last ? nA : cA + (size_t)(t + 2) * kstep; const char* b2 = last ? nB : cB + (size_t)(t + 2) * kstep;
            const char* a3 = a2 + kstep; const char* b3 = b2 + kstep;
            if (last && has_next) S.a_ready(nxt);
            if constexpr (SP2) {
            PG8_LDB(B0, 0, 0); PG8_LDB(B1, 0, 1); PG8_SCHED; PG8_LDA(At, 0, 0); PG8_STAGE(PG8_SA(1, 1), a1 + hstep, voffA);
            PG8_WAIT_V(8); PG8_WAIT_L(0); PG8_BAR; PG8_MMA(0, 0, At, B0); PG8_MMA(0, 1, At, B1); PG8_BAR; PG8_SCHED;
            PG8_LDA(At, 0, 1); PG8_STAGE(PG8_SB(0, 0), b2, voffB); PG8_STAGE(PG8_SB(0, 1), b2 + hstep, voffB); PG8_STAGE(PG8_SA(0, 0), a2, voffA);
            PG8_WAIT_V(8); PG8_WAIT_L(0); PG8_BAR; PG8_MMA(1, 0, At, B0); PG8_MMA(1, 1, At, B1); PG8_BAR; PG8_SCHED;
            PG8_LDB(B0, 1, 0); PG8_LDB(B1, 1, 1); PG8_SCHED; PG8_LDA(At, 1, 0); PG8_STAGE(PG8_SA(0, 1), a2 + hstep, voffA);
            PG8_WAIT_V(8); PG8_WAIT_L(0); PG8_BAR; PG8_MMA(0, 0, At, B0); PG8_MMA(0, 1, At, B1); PG8_BAR; PG8_SCHED;
            PG8_LDA(At, 1, 1); PG8_STAGE(PG8_SB(1, 0), b3, voffB); PG8_STAGE(PG8_SB(1, 1), b3 + hstep, voffB); PG8_STAGE(PG8_SA(1, 0), a3, voffA);
            PG8_WAIT_V(8); PG8_WAIT_L(0); PG8_BAR; PG8_MMA(1, 0, At, B0); PG8_MMA(1, 1, At, B1); PG8_BAR; PG8_SCHED;
            } else {
            PG8_LDB(B0, 0, 0); PG8_SCHED; PG8_LDA(At, 0, 0); PG8_STAGE(PG8_SA(1, 1), a1 + hstep, voffA);
            PG8_WAIT_L(8); PG8_BAR; PG8_WAIT_L(0); PG8_MMA(0, 0, At, B0); PG8_BAR; PG8_SCHED;
            PG8_LDB(B1, 0, 1); PG8_STAGE(PG8_SB(0, 0), b2, voffB);
            PG8_BAR; PG8_WAIT_L(0); PG8_MMA(0, 1, At, B1); PG8_BAR;
            PG8_LDA(At, 0, 1); PG8_STAGE(PG8_SA(0, 0), a2, voffA);
            PG8_BAR; PG8_WAIT_L(0); PG8_MMA(1, 0, At, B0); PG8_BAR; PG8_SCHED;
            PG8_STAGE(PG8_SB(0, 1), b2 + hstep, voffB);
            PG8_WAIT_V(6); PG8_BAR; PG8_MMA(1, 1, At, B1); PG8_BAR;
            PG8_LDB(B0, 1, 0); PG8_SCHED; PG8_LDA(At, 1, 0); PG8_STAGE(PG8_SA(0, 1), a2 + hstep, voffA);
            PG8_WAIT_L(8); PG8_BAR; PG8_WAIT_L(0); PG8_MMA(0, 0, At, B0); PG8_BAR; PG8_SCHED;
            PG8_LDB(B1, 1, 1); PG8_STAGE(PG8_SB(1, 0), b3, voffB);
            PG8_BAR; PG8_WAIT_L(0); PG8_MMA(0, 1, At, B1); PG8_BAR;
            PG8_LDA(At, 1, 1); PG8_STAGE(PG8_SA(1, 0), a3, voffA);
            PG8_BAR; PG8_WAIT_L(0); PG8_MMA(1, 0, At, B0); PG8_BAR; PG8_SCHED;
            PG8_STAGE(PG8_SB(1, 1), b3 + hstep, voffB);
            PG8_WAIT_V(6); PG8_BAR; PG8_MMA(1, 1, At, B1); PG8_BAR;
            }
        }
        if constexpr (ALIGN_EPI) { if (wr == 0) PG8_BAR; }
        if constexpr (!Epi::AFTER_DRAIN) { E(acc, cur, wr, wc, fr, fq); S.done(cur); }
        if (!has_next) break;
#pragma unroll
        for (int a = 0; a < 2; ++a)
#pragma unroll
            for (int b = 0; b < 2; ++b)
#pragma unroll
                for (int m = 0; m < 4; ++m)
#pragma unroll
                    for (int n = 0; n < 2; ++n) acc[a][b][m][n] = (f32x4){0.f, 0.f, 0.f, 0.f};
        cur = nxt; cA = nA; cB = nB; ++ui;
        if constexpr (ALIGN_EPI) { if (wr == 1) PG8_BAR; }
    }
    PG8_WAIT_V(0);
    if constexpr (!ALIGN_EPI) { if (wr == 0) PG8_BAR; }
    PG8_BAR;
    if constexpr (Epi::AFTER_DRAIN) { E.fused(acc, cur, wr, wc, fr, fq, lds, wid, lane); S.done(cur); }
#undef PG8_SA
#undef PG8_SB
#undef PG8_STAGE
#undef PG8_LDA
#undef PG8_LDB
#undef PG8_MMA
#undef PG8_WAIT_V
#undef PG8_WAIT_L
#undef PG8_BAR
#undef PG8_SCHED
}
}

#define LAS __attribute__((address_space(3)))
using pg8::bf16_t; using pg8::bf16x8; using pg8::f32x4; using pg8::u32x4;
typedef float f32x16 __attribute__((ext_vector_type(16)));
typedef float f32x2_t __attribute__((ext_vector_type(2)));
typedef __bf16 bf16x2_t __attribute__((ext_vector_type(2)));
typedef unsigned u32x2 __attribute__((ext_vector_type(2)));

constexpr int DM = 1024, NTOK = 16384, NCTX = 8192, DFF = 2816, DATT = 512, DIN = 4096, NMOD = 9;
constexpr float EPS = 1e-6f, LOG2E = 1.4426950408889634f;
constexpr size_t MiB = 1u << 20;
constexpr size_t WS_FF1IN = 0, WS_FF1OUT = 11 * MiB, WS_FF2IN = 17 * MiB, WS_FF2OUT = 28 * MiB, WS_WIN = 34 * MiB, WS_WBP = 42 * MiB, WS_WBA = 43 * MiB, WS_WOUT = 44 * MiB,
                 WS_WPOOL = 46 * MiB, WS_MOD = 47 * MiB, WS_KC = 48 * MiB, WS_VTC = 50 * MiB;
constexpr size_t WS_H = 52 * MiB;
constexpr size_t WS_ACT = 84 * MiB;
constexpr size_t WS_P = 172 * MiB;
constexpr size_t WS_Q = 204 * MiB;
constexpr size_t WS_K = 220 * MiB;
constexpr size_t WS_VT = 236 * MiB;
constexpr size_t WS_CTL = 252 * MiB, CTL_BYTES = 16384;
constexpr size_t WS_SS = 253 * MiB;
constexpr size_t WS_BVIN = 47 * MiB + 512 * 1024, WS_BVFF2 = WS_BVIN + 128 * 1024;
constexpr size_t WS_END = 254 * MiB;
static_assert(WS_END <= 256 * MiB, "d_ws map");
constexpr size_t KV_LAT = (size_t)32 * 8 * 8 * 2048;
constexpr size_t OUT_Y = 0, OUT_K = (size_t)NTOK * DM, OUT_V = OUT_K + (size_t)NCTX * DATT;

__device__ __forceinline__ unsigned pkbf(float lo, float hi) { f32x2_t v = {lo, hi}; bf16x2_t b = __builtin_convertvector(v, bf16x2_t); return __builtin_bit_cast(unsigned, b); }
__device__ __forceinline__ float bflo(unsigned w) { return __uint_as_float(w << 16); }
__device__ __forceinline__ float bfhi(unsigned w) { return __uint_as_float(w & 0xffff0000u); }
__device__ __forceinline__ float fast_sigmoid(float x) { return __builtin_amdgcn_rcpf(1.0f + __builtin_amdgcn_exp2f(-x * LOG2E)); }
__device__ __forceinline__ float wave_sum(float v) {
#pragma unroll
    for (int o = 1; o < 64; o <<= 1) v += __shfl_xor(v, o);
    return v;
}
__device__ __forceinline__ int cond_of_pm(int pm) { return pm < 32 ? 0 : 1 + ((pm - 32) >> 3); }

__device__ __forceinline__ float row_sumsq(const float* SS, int row, int fq) {
    const f32x4 a = *(const f32x4*)(SS + (size_t)row * 16 + 4 * fq); float s = (a[0] + a[1]) + (a[2] + a[3]);
    s += __shfl_xor(s, 16); s += __shfl_xor(s, 32); return s;
}
__device__ __forceinline__ float rstd_of(float sumsq) { return 1.0f / sqrtf(sumsq * (1.0f / DM) + EPS); }

__device__ __forceinline__ void rstd_table(const float* SS, const pg8::StaticOrder& S, LAS float* tbl, int nmax, int tid) {
    pg8::Unit u;
    for (int i = 0; i < nmax && S.next(i, u); ++i)
        if (tid < 256) { const f32x4* p = (const f32x4*)(SS + (size_t)(u.pm * 256 + tid) * 16); const f32x4 a = (p[0] + p[1]) + (p[2] + p[3]); tbl[i * 256 + tid] = rstd_of(((a[0] + a[1]) + (a[2] + a[3]))); }
    __syncthreads();
}

#define EPI_ROWS(ai, m) (u.pm * 256 + (ai) * 128 + wr * 64 + (m) * 16 + fr)

template <bool NORMED> struct EpiSwiGLU {
    static constexpr bool PERM = true, AFTER_DRAIN = false;
    unsigned char* ws; const LAS float* tbl; int nmax;
    __device__ __forceinline__ void operator()(const f32x4 (&acc)[2][2][4][2], const pg8::Unit& u, int wr, int wc, int fr, int fq) const {
        bf16_t* O = (bf16_t*)(ws + WS_ACT); const float* bvec = (const float*)(ws + WS_BVFF2); const float* SS = (const float*)(ws + WS_SS);
        const int col = u.pn * 128 + wc * 32 + 8 * fq;
        f32x4 bv[2][2];
        if (NORMED) { const float* bp = bvec + (size_t)cond_of_pm(u.pm) * (2 * DFF) + u.pn * 256 + wc * 32 + 8 * fq;
#pragma unroll
            for (int bj = 0; bj < 2; ++bj)
#pragma unroll
                for (int n = 0; n < 2; ++n) bv[bj][n] = *(const f32x4*)(bp + bj * 128 + 4 * n); }
#pragma unroll
        for (int ai = 0; ai < 2; ++ai)
#pragma unroll
            for (int m = 0; m < 4; ++m) {
                const int row = EPI_ROWS(ai, m);
                const float rs = NORMED ? (u.ord < nmax ? tbl[u.ord * 256 + ai * 128 + wr * 64 + m * 16 + fr] : rstd_of(row_sumsq(SS, row, fq))) : 1.f;
                float v[8];
#pragma unroll
                for (int n = 0; n < 2; ++n)
#pragma unroll
                    for (int j = 0; j < 4; ++j) { float g = acc[ai][0][m][n][j], up = acc[ai][1][m][n][j]; if (NORMED) { g = g * rs + bv[0][n][j]; up = up * rs + bv[1][n][j]; } v[4 * n + j] = g * fast_sigmoid(g) * up; }
                u32x4 w; w.x = pkbf(v[0], v[1]); w.y = pkbf(v[2], v[3]); w.z = pkbf(v[4], v[5]); w.w = pkbf(v[6], v[7]);
                *(u32x4*)(O + (size_t)row * DFF + col) = w;
            }
    }
};
template <bool NEXT, int GI, int COEF2, int MNEXT> struct EpiResid {
    static constexpr bool PERM = true, AFTER_DRAIN = false;
    const float* base0; long d1;
    float* out; unsigned char* ws; const float* gnext;
    __device__ __forceinline__ void operator()(const f32x4 (&acc)[2][2][4][2], const pg8::Unit& u, int wr, int wc, int fr, int fq) const {
        constexpr int gi = GI, mnext = MNEXT; constexpr float coef = 0.5f * COEF2;
        bf16_t* XA = (bf16_t*)(ws + WS_H); float* SS = (float*)(ws + WS_SS);
        const float* mc = (const float*)(ws + WS_MOD) + (size_t)cond_of_pm(u.pm) * (NMOD * DM);
        const float* gv = mc + gi * DM;
        const float* base = base0 + (u.pm < 32 ? 0L : d1);
        const int col = u.pn * 256 + wc * 32 + 8 * fq;
        f32x4 g[2][2], an[2][2];
#pragma unroll
        for (int bj = 0; bj < 2; ++bj)
#pragma unroll
            for (int n = 0; n < 2; ++n) { g[bj][n] = *(const f32x4*)(gv + col + bj * 128 + 4 * n) * coef;
                if (NEXT) an[bj][n] = *(const f32x4*)(gnext + col + bj * 128 + 4 * n) * (*(const f32x4*)(mc + (mnext + 1) * DM + col + bj * 128 + 4 * n) + 1.0f); }
#pragma unroll
        for (int ai = 0; ai < 2; ++ai)
#pragma unroll
            for (int m = 0; m < 4; ++m) { const int row = EPI_ROWS(ai, m); const size_t off = (size_t)row * DM + col; float ss = 0.f;
#pragma unroll
                for (int bj = 0; bj < 2; ++bj) { f32x4 o[2];
#pragma unroll
                    for (int n = 0; n < 2; ++n) { const f32x4 b = *(const f32x4*)(base + off + bj * 128 + 4 * n); o[n] = b + g[bj][n] * acc[ai][bj][m][n]; if (NEXT) *(f32x4*)(out + off + bj * 128 + 4 * n) = o[n]; else __builtin_nontemporal_store(o[n], (f32x4*)(out + off + bj * 128 + 4 * n));
                        if (NEXT) ss += (o[n][0] * o[n][0] + o[n][1] * o[n][1]) + (o[n][2] * o[n][2] + o[n][3] * o[n][3]); }
                    if (NEXT) { const f32x4 xa = o[0] * an[bj][0], xb = o[1] * an[bj][1]; u32x4 w; w.x = pkbf(xa[0], xa[1]); w.y = pkbf(xa[2], xa[3]); w.z = pkbf(xb[0], xb[1]); w.w = pkbf(xb[2], xb[3]);
                        *(u32x4*)(XA + off + bj * 128) = w; }
                }
                if (NEXT) { ss += __shfl_xor(ss, 16); ss += __shfl_xor(ss, 32); if (fq == 0) SS[(size_t)row * 16 + u.pn * 4 + wc] = ss; }
            }
    }
};
struct EpiWin {
    static constexpr bool PERM = true, AFTER_DRAIN = false;
    unsigned char* ws; float* outk; const float* qgain; const float* kgain; LAS unsigned char* scr; const LAS float* tbl; int nmax;
    __device__ __forceinline__ void operator()(const f32x4 (&accr)[2][2][4][2], const pg8::Unit& u, int wr, int wc, int fr, int fq) const {
        const int pn = u.pn;
        float* P = (float*)(ws + WS_P); bf16_t* Q = (bf16_t*)(ws + WS_Q); bf16_t* Kb = (bf16_t*)(ws + WS_K); bf16_t* VT = (bf16_t*)(ws + WS_VT); bf16_t* Gt = (bf16_t*)(ws + WS_ACT);
        float* outv = outk + (size_t)NCTX * DATT; const float* bvec = (const float*)(ws + WS_BVIN);
        f32x4 (&acc)[2][2][4][2] = const_cast<f32x4 (&)[2][2][4][2]>(accr);
        { const float* bp = bvec + (size_t)cond_of_pm(u.pm) * DIN + pn * 256 + wc * 32 + 8 * fq; f32x4 bv[2][2];
#pragma unroll
            for (int bj = 0; bj < 2; ++bj)
#pragma unroll
                for (int n = 0; n < 2; ++n) bv[bj][n] = *(const f32x4*)(bp + bj * 128 + 4 * n);
#pragma unroll
            for (int ai = 0; ai < 2; ++ai)
#pragma unroll
                for (int m = 0; m < 4; ++m) { const float rs = u.ord < nmax ? tbl[u.ord * 256 + ai * 128 + wr * 64 + m * 16 + fr] : rstd_of(row_sumsq((const float*)(ws + WS_SS), EPI_ROWS(ai, m), fq));
#pragma unroll
                    for (int bj = 0; bj < 2; ++bj)
#pragma unroll
                        for (int n = 0; n < 2; ++n) acc[ai][bj][m][n] = accr[ai][bj][m][n] * rs + bv[bj][n]; } }

        if (pn < 2) {
            const int col = pn * 256 + wc * 32 + 8 * fq;
#pragma unroll
            for (int ai = 0; ai < 2; ++ai)
#pragma unroll
                for (int m = 0; m < 4; ++m) { float* rp = P + (size_t)EPI_ROWS(ai, m) * DATT + col;
#pragma unroll
                    for (int bj = 0; bj < 2; ++bj)
#pragma unroll
                        for (int n = 0; n < 2; ++n) *(f32x4*)(rp + bj * 128 + 4 * n) = acc[ai][bj][m][n]; }
        } else if (pn < 6) {
            const bool isk = pn >= 4;
            const float* gain = isk ? kgain : qgain;
            const int head = 4 * (pn & 1) + wc;
            f32x4 gn[2][2];
#pragma unroll
            for (int bj = 0; bj < 2; ++bj)
#pragma unroll
                for (int n = 0; n < 2; ++n) gn[bj][n] = *(const f32x4*)(gain + 32 * bj + 8 * fq + 4 * n);
#pragma unroll
            for (int ai = 0; ai < 2; ++ai)
#pragma unroll
                for (int m = 0; m < 4; ++m) {
                    float ss = 0.f;
#pragma unroll
                    for (int bj = 0; bj < 2; ++bj)
#pragma unroll
                        for (int n = 0; n < 2; ++n) { const f32x4 x = acc[ai][bj][m][n]; ss += (x[0] * x[0] + x[1] * x[1]) + (x[2] * x[2] + x[3] * x[3]); }
                    ss += __shfl_xor(ss, 16); ss += __shfl_xor(ss, 32);
                    const float rstd = 1.0f / sqrtf(ss * (1.0f / 64.0f) + EPS);
                    const int row = EPI_ROWS(ai, m);
#pragma unroll
                    for (int bj = 0; bj < 2; ++bj) {
                        const f32x4 a = acc[ai][bj][m][0] * rstd * gn[bj][0], b = acc[ai][bj][m][1] * rstd * gn[bj][1];
                        const int c = head * 64 + 32 * bj + 8 * fq;
                        u32x4 w; w.x = pkbf(a[0], a[1]); w.y = pkbf(a[2], a[3]); w.z = pkbf(b[0], b[1]); w.w = pkbf(b[2], b[3]);
                        if (!isk) *(u32x4*)(Q + (size_t)row * DATT + c) = w;
                        else {
                            const bool ctx = u.pm < 32; const int rl = row - u.pm * 256, tok = ctx ? rl : ((u.pm - 32) & 7) * 256 + rl;
                            const size_t tile = ctx ? (size_t)(u.pm * 8 + head) * 8 + (tok >> 5) : KV_LAT / 2048 + (size_t)(((u.pm - 32) >> 3) * 8 + head) * 64 + (tok >> 5);
                            *(u32x4*)(Kb + tile * 2048 + (2 * bj + (fq >> 1)) * 512 + (32 * (fq & 1) + (tok & 31)) * 8) = w; }
                        if (isk && u.pm < 32) { __builtin_nontemporal_store(a, (f32x4*)(outk + (size_t)row * DATT + c)); __builtin_nontemporal_store(b, (f32x4*)(outk + (size_t)row * DATT + c + 4)); }
                    }
                }
        } else if (pn < 8) {
            const bool ctx = u.pm < 32;
            LAS unsigned char* pad = scr + (wr * 4 + wc) * 1280;
            const int lane_ = fq * 16 + fr, d_ = lane_ & 31, hh_ = lane_ >> 5;
#pragma unroll
            for (int ai = 0; ai < 2; ++ai)
#pragma unroll
                for (int m = 0; m < 4; ++m) {
                    const int rl0 = ai * 128 + wr * 64 + m * 16, row = u.pm * 256 + rl0 + fr, tok0 = ctx ? rl0 : ((u.pm - 32) & 7) * 256 + rl0;
#pragma unroll
                    for (int bj = 0; bj < 2; ++bj) {
                        const int c = (pn - 6) * 256 + bj * 128 + wc * 32 + 8 * fq, head = c >> 6;
                        const f32x4 a = acc[ai][bj][m][0], b = acc[ai][bj][m][1];
                        u32x4 w; w.x = pkbf(a[0], a[1]); w.y = pkbf(a[2], a[3]); w.z = pkbf(b[0], b[1]); w.w = pkbf(b[2], b[3]);
                        *(LAS u32x4*)(pad + fr * 80 + fq * 16) = w;
                        if (ctx) { __builtin_nontemporal_store(a, (f32x4*)(outv + (size_t)row * DATT + c)); __builtin_nontemporal_store(b, (f32x4*)(outv + (size_t)row * DATT + c + 4)); }
                        unsigned short e[8];
#pragma unroll
                        for (int j = 0; j < 8; ++j) e[j] = *(const LAS unsigned short*)(pad + (8 * (j >> 2) + 4 * hh_ + (j & 3)) * 80 + d_ * 2);
                        u32x4 o; o.x = e[0] | ((unsigned)e[1] << 16); o.y = e[2] | ((unsigned)e[3] << 16); o.z = e[4] | ((unsigned)e[5] << 16); o.w = e[6] | ((unsigned)e[7] << 16);
                        const size_t tile = ctx ? (size_t)(u.pm * 8 + head) * 8 + (tok0 >> 5) : KV_LAT / 2048 + (size_t)(((u.pm - 32) >> 3) * 8 + head) * 64 + (tok0 >> 5);
                        *(u32x4*)(VT + tile * 2048 + ((wc & 1) * 2 + ((tok0 >> 4) & 1)) * 512 + lane_ * 8) = o;
                    }
                }
        } else {
            const int col = (pn - 8) * 256 + wc * 32 + 8 * fq;
#pragma unroll
            for (int ai = 0; ai < 2; ++ai)
#pragma unroll
                for (int m = 0; m < 4; ++m) { bf16_t* rp = Gt + (size_t)EPI_ROWS(ai, m) * 2048 + col;
#pragma unroll
                    for (int bj = 0; bj < 2; ++bj) { const f32x4 a = acc[ai][bj][m][0], b = acc[ai][bj][m][1];
                        u32x4 w; w.x = pkbf(fast_sigmoid(a[0]), fast_sigmoid(a[1])); w.y = pkbf(fast_sigmoid(a[2]), fast_sigmoid(a[3]));
                        w.z = pkbf(fast_sigmoid(b[0]), fast_sigmoid(b[1])); w.w = pkbf(fast_sigmoid(b[2]), fast_sigmoid(b[3]));
                        *(u32x4*)(rp + bj * 128) = w; }
                }
        }
    }
};
template <int MODE> struct EpiMix {
    static constexpr bool PERM = true, AFTER_DRAIN = false;
    unsigned char* ws; const float* vec;
    __device__ __forceinline__ void operator()(const f32x4 (&acc)[2][2][4][2], const pg8::Unit& u, int wr, int wc, int fr, int fq) const {
        bf16_t* O = (bf16_t*)(ws + (MODE == 0 ? WS_H + 16 * MiB : MODE == 1 ? WS_K : WS_P)); constexpr int ldo = MODE == 0 ? DATT : DM;
        const bf16_t* Gt = (const bf16_t*)(ws + WS_ACT); const bf16_t* T1 = (const bf16_t*)(ws + WS_K);
        const int col = u.pn * 256 + wc * 32 + 8 * fq;
        f32x4 sv[2][2];
        if (MODE == 0) {
#pragma unroll
            for (int bj = 0; bj < 2; ++bj)
#pragma unroll
                for (int n = 0; n < 2; ++n) sv[bj][n] = *(const f32x4*)(vec + col + bj * 128 + 4 * n);
        }
#pragma unroll
        for (int ai = 0; ai < 2; ++ai)
#pragma unroll
            for (int m = 0; m < 4; ++m) { const int row = EPI_ROWS(ai, m);
#pragma unroll
                for (int bj = 0; bj < 2; ++bj) {
                    f32x4 a = acc[ai][bj][m][0], b = acc[ai][bj][m][1];
                    const int c = col + bj * 128;
                    if (MODE == 0) { a = a * sv[bj][0]; b = b * sv[bj][1]; }
                    else {
                        const u32x4 gw = *(const u32x4*)(Gt + (size_t)row * 2048 + (MODE == 2 ? 1024 : 0) + c);
                        const f32x4 ga = {bflo(gw.x), bfhi(gw.x), bflo(gw.y), bfhi(gw.y)}, gb = {bflo(gw.z), bfhi(gw.z), bflo(gw.w), bfhi(gw.w)};
                        a = a * ga; b = b * gb;
                        if (MODE == 2) { const u32x4 tw = *(const u32x4*)(T1 + (size_t)row * DM + c);
                            a = a + (f32x4){bflo(tw.x), bfhi(tw.x), bflo(tw.y), bfhi(tw.y)}; b = b + (f32x4){bflo(tw.z), bfhi(tw.z), bflo(tw.w), bfhi(tw.w)}; }
                    }
                    u32x4 w; w.x = pkbf(a[0], a[1]); w.y = pkbf(a[2], a[3]); w.z = pkbf(b[0], b[1]); w.w = pkbf(b[2], b[3]);
                    *(u32x4*)(O + (size_t)row * ldo + c) = w;
                }
            }
    }
};

__device__ __forceinline__ unsigned f2bf(float f) { unsigned u = __builtin_bit_cast(unsigned, f); return (u + 0x7fffu + ((u >> 16) & 1u)) >> 16; }
__device__ __forceinline__ unsigned pk2(float lo, float hi) { return f2bf(lo) | (f2bf(hi) << 16); }
__device__ __forceinline__ int dest_row(int mode, int n) {
    if (mode == 1) { const int up = n >= DFF, j = up ? n - DFF : n; return 256 * (j >> 7) + (up ? 128 : 0) + (j & 127); }
    if (mode == 2) { if (n >= 512 && n < 1536) { const int tb = n & ~255, cc = n & 255, hh = cc >> 6, d = cc & 63; return tb + 128 * (d >> 5) + 32 * hh + (d & 31); } return n; }
    return n;
}
__device__ __forceinline__ void tr_item(const float* W, int N, bf16_t* WT, int ldt, int mode, LAS float* scr, int item, int lane) {
    const int nblk = N / 32, kb = item / nblk, nb = item % nblk, k0 = 64 * kb, n0 = 32 * nb;
#pragma unroll
    for (int i = 0; i < 32; ++i) { const int kk = 2 * i + (lane >> 5); scr[kk * 33 + (lane & 31)] = __builtin_nontemporal_load(W + (size_t)(k0 + kk) * N + n0 + (lane & 31)); }
    asm volatile("s_waitcnt lgkmcnt(0)" ::: "memory");
    const int c = lane & 7;
#pragma unroll
    for (int j = 0; j < 4; ++j) { const int n = (lane >> 3) + 8 * j; const LAS float* s = scr + (8 * c) * 33 + n;
        u32x4 o; o.x = pk2(s[0 * 33], s[1 * 33]); o.y = pk2(s[2 * 33], s[3 * 33]); o.z = pk2(s[4 * 33], s[5 * 33]); o.w = pk2(s[6 * 33], s[7 * 33]);
        *(u32x4*)(WT + (size_t)dest_row(mode, n0 + n) * ldt + k0 + 8 * c) = o; }
    asm volatile("s_waitcnt lgkmcnt(0)" ::: "memory");
}

struct Args { const float* in[24]; float* out; unsigned char* ws; int ph_lo, ph_hi; };
enum { I_XP = 0, I_XS, I_CK, I_CV, I_C, I_CCTX, I_WADA, I_BADA, I_GFF1, I_WFF1IN, I_WFF1OUT, I_GMIX, I_WIN, I_QG, I_KG, I_WPOOL, I_PSCALE, I_RPB, I_WBP, I_WBA, I_WOUT, I_GFF2, I_WFF2IN, I_WFF2OUT };

__device__ __forceinline__ void phase0(const Args& a, LAS unsigned char* lds, int tid, int lane, int wave, int G) {
    unsigned char* ws = a.ws;
    if ((int)blockIdx.x < 144) {
        LAS float* sc = (LAS float*)lds; LAS float* red = sc + 5 * 1024;
        for (int i = tid; i < 5 * 1024; i += 512) { const float v = i < 1024 ? a.in[I_CCTX][i] : a.in[I_C][i - 1024]; sc[i] = v * fast_sigmoid(v); }
        __syncthreads();
        float* mod = (float*)(ws + WS_MOD);
        for (int u = blockIdx.x; u < 144; u += G) {
            const int rsub = lane >> 4, c4 = (lane & 15) * 4;
            f32x4 acc[5];
#pragma unroll
            for (int c = 0; c < 5; ++c) acc[c] = (f32x4){0.f, 0.f, 0.f, 0.f};
            const float* wp = a.in[I_WADA] + (size_t)(wave * 128 + rsub) * (NMOD * DM) + u * 64 + c4;
            const LAS float* scw = sc + wave * 128 + rsub;
#pragma unroll 8
            for (int i = 0; i < 32; ++i) {
                const f32x4 wv = __builtin_nontemporal_load((const f32x4*)(wp + (size_t)(4 * i) * (NMOD * DM)));
#pragma unroll
                for (int c = 0; c < 5; ++c) acc[c] += wv * scw[c * 1024 + 4 * i];
            }
#pragma unroll
            for (int c = 0; c < 5; ++c)
#pragma unroll
                for (int j = 0; j < 4; ++j) { float v = acc[c][j]; v += __shfl_xor(v, 16); v += __shfl_xor(v, 32); acc[c][j] = v; }
            if (lane < 16) {
#pragma unroll
                for (int c = 0; c < 5; ++c) *(LAS f32x4*)(red + (wave * 5 + c) * 64 + c4) = acc[c]; }
            __syncthreads();
            if (tid < 320) { const int c = tid >> 6, l = tid & 63; float s = 0.f;
#pragma unroll
                for (int w = 0; w < 8; ++w) s += red[(w * 5 + c) * 64 + l];
                mod[c * (NMOD * DM) + u * 64 + l] = s + a.in[I_BADA][u * 64 + l]; }
            __syncthreads();
        }
    }
    LAS float* scr = (LAS float*)(lds + wave * 16384);
    constexpr int I_FIN = 16 * 176, I_IN = 16 * 128, I_FOUT = 44 * 32;
    constexpr int NITEMS = I_FIN + I_IN + I_FOUT;
    const bool bal = (G == 256); const int bx = blockIdx.x;
    if (bal && bx < 144) return;
    const int slot0 = bal ? (bx - 144) * 8 + wave : bx * 8 + wave, nslots = bal ? 112 * 8 : G * 8;
    for (int it = slot0; it < NITEMS; it += nslots) {
        int r = it;
        if (r < I_FIN) { tr_item(a.in[I_WFF1IN], 2 * DFF, (bf16_t*)(ws + WS_FF1IN), DM, 1, scr, r, lane); continue; } r -= I_FIN;
        if (r < I_IN) { tr_item(a.in[I_WIN], DIN, (bf16_t*)(ws + WS_WIN), DM, 2, scr, r, lane); continue; } r -= I_IN;
        tr_item(a.in[I_WFF1OUT], DM, (bf16_t*)(ws + WS_FF1OUT), DFF, 0, scr, r, lane);
    }
}

__device__ __forceinline__ void late_copies(const Args& a, LAS unsigned char* lds, int lane, int wave, int wi, int nw) {
    unsigned char* ws = a.ws;
    LAS float* scr = (LAS float*)(lds + wave * 16384);
    constexpr int I_FIN = 16 * 176, I_FOUT = 44 * 32, I_BR = 8 * 32, I_OUT = 16 * 32, I_FOLD = 4 * 8 * 16;
    constexpr int NITEMS = I_FIN + I_FOUT + I_BR + I_OUT + I_FOLD;
    for (int it = wi; it < NITEMS; it += nw) {
        int r = it;
        if (r < I_FIN) { tr_item(a.in[I_WFF2IN], 2 * DFF, (bf16_t*)(ws + WS_FF2IN), DM, 1, scr, r, lane); continue; } r -= I_FIN;
        if (r < I_FOUT) { tr_item(a.in[I_WFF2OUT], DM, (bf16_t*)(ws + WS_FF2OUT), DFF, 0, scr, r, lane); continue; } r -= I_FOUT;
        if (r < I_BR) { tr_item(a.in[I_WBA], DM, (bf16_t*)(ws + WS_WBA), DATT, 0, scr, r, lane); continue; } r -= I_BR;
        if (r < I_OUT) { tr_item(a.in[I_WOUT], DM, (bf16_t*)(ws + WS_WOUT), DM, 0, scr, r, lane); continue; } r -= I_OUT;
        {
            const int g = r >> 7, ib = (r >> 4) & 7, n = (r & 15) * 64 + lane;
            const float* wp = a.in[I_WPOOL] + (size_t)g * 128 * 128 + (size_t)(ib * 16) * 128; const float* ps = a.in[I_PSCALE] + g * 128; const float* wb = a.in[I_WBP] + (size_t)(g * 128) * DM + n;
#pragma unroll
            for (int q = 0; q < 8; ++q) { const int e4 = q * 64 + lane, i = e4 >> 5, j4 = (e4 & 31) * 4; const f32x4 w4 = *(const f32x4*)(wp + i * 128 + j4) * *(const f32x4*)(ps + j4); *(LAS f32x4*)(scr + i * 128 + j4) = w4; }
            asm volatile("s_waitcnt lgkmcnt(0)" ::: "memory");
            float acc[16];
#pragma unroll
            for (int i = 0; i < 16; ++i) acc[i] = 0.f;
#pragma unroll 2
            for (int j = 0; j < 128; j += 4) { const float w0 = wb[(size_t)j * DM], w1 = wb[(size_t)(j + 1) * DM], w2 = wb[(size_t)(j + 2) * DM], w3 = wb[(size_t)(j + 3) * DM];
#pragma unroll
                for (int i = 0; i < 16; ++i) { const f32x4 p4 = *(const LAS f32x4*)(scr + i * 128 + j); acc[i] += (p4[0] * w0 + p4[1] * w1) + (p4[2] * w2 + p4[3] * w3); } }
            asm volatile("s_waitcnt lgkmcnt(0)" ::: "memory");
            u32x4 o0, o1; o0.x = pk2(acc[0], acc[1]); o0.y = pk2(acc[2], acc[3]); o0.z = pk2(acc[4], acc[5]); o0.w = pk2(acc[6], acc[7]);
            o1.x = pk2(acc[8], acc[9]); o1.y = pk2(acc[10], acc[11]); o1.z = pk2(acc[12], acc[13]); o1.w = pk2(acc[14], acc[15]);
            bf16_t* dst = (bf16_t*)(ws + WS_WBP) + (size_t)n * DATT + g * 128 + ib * 16; *(u32x4*)dst = o0; *(u32x4*)(dst + 8) = o1;
        }
    }
    const int gt = wi * 64 + lane, NGT = nw * 64;
    for (int i = gt; i < 2 * 32 * 16 * 256; i += NGT) {
        const int isv = i >= 32 * 16 * 256, ch = isv ? i - 32 * 16 * 256 : i, ln = ch & 63, q4 = (ch >> 6) & 3, tile = (ch >> 8) & 15, bh = ch >> 12, b = bh >> 3, h = bh & 7, r32 = ln & 31, hh = ln >> 5;
        u32x4 o;
        if (!isv) { const float* src = a.in[I_CK] + ((size_t)(b * 512 + tile * 32 + r32) * 8 + h) * 64 + 16 * q4 + 8 * hh; const f32x4 v0 = *(const f32x4*)src, v1 = *(const f32x4*)(src + 4);
            o.x = pk2(v0[0], v0[1]); o.y = pk2(v0[2], v0[3]); o.z = pk2(v1[0], v1[1]); o.w = pk2(v1[2], v1[3]);
            *(u32x4*)((bf16_t*)(ws + WS_KC) + (size_t)ch * 8) = o; }
        else { const int t = q4 >> 1, sK = q4 & 1; float v[8];
#pragma unroll
            for (int j = 0; j < 8; ++j) { const int key = 16 * sK + 8 * (j >> 2) + 4 * hh + (j & 3); v[j] = a.in[I_CV][((size_t)(b * 512 + tile * 32 + key) * 8 + h) * 64 + 32 * t + r32]; }
            o.x = pk2(v[0], v[1]); o.y = pk2(v[2], v[3]); o.z = pk2(v[4], v[5]); o.w = pk2(v[6], v[7]);
            *(u32x4*)((bf16_t*)(ws + WS_VTC) + (size_t)ch * 8) = o; }
    }
}

__device__ __forceinline__ void norm_phase(const float* src0, const float* src1, const float* gvec, const float* mod, int mi, bf16_t* H, int G, int wave, int lane) {
    for (int rb = blockIdx.x; rb < NTOK / 64; rb += G) {
        const int rbase = rb * 64, cond = rbase < NCTX ? 0 : 1 + ((rbase - NCTX) >> 11);
        const float* sh = mod + (size_t)cond * (NMOD * DM) + mi * DM; const float* scl = sh + DM;
        f32x4 av[4], sv[4];
#pragma unroll
        for (int j = 0; j < 4; ++j) { const int c = 4 * lane + 256 * j; av[j] = *(const f32x4*)(gvec + c) * (*(const f32x4*)(scl + c) + 1.0f); sv[j] = *(const f32x4*)(sh + c); }
        for (int i0 = 0; i0 < 8; i0 += 4) {
            f32x4 v[4][4]; float s[4];
#pragma unroll
            for (int i = 0; i < 4; ++i) {
                const int row = rbase + wave * 8 + i0 + i;
                const float* xr = row < NCTX ? src0 + (size_t)row * DM : src1 + (size_t)(row - NCTX) * DM;
#pragma unroll
                for (int j = 0; j < 4; ++j) v[i][j] = *(const f32x4*)(xr + 4 * lane + 256 * j);
            }
#pragma unroll
            for (int i = 0; i < 4; ++i) { s[i] = 0.f;
#pragma unroll
                for (int j = 0; j < 4; ++j) s[i] += (v[i][j][0] * v[i][j][0] + v[i][j][1] * v[i][j][1]) + (v[i][j][2] * v[i][j][2] + v[i][j][3] * v[i][j][3]); }
#pragma unroll
            for (int o = 1; o < 64; o <<= 1) {
#pragma unroll
                for (int i = 0; i < 4; ++i) s[i] += __shfl_xor(s[i], o); }
#pragma unroll
            for (int i = 0; i < 4; ++i) {
                const int row = rbase + wave * 8 + i0 + i;
                const float rstd = 1.0f / sqrtf(s[i] * (1.0f / DM) + EPS);
#pragma unroll
                for (int j = 0; j < 4; ++j) { const f32x4 o = v[i][j] * rstd * av[j] + sv[j]; u32x2 w; w.x = pkbf(o[0], o[1]); w.y = pkbf(o[2], o[3]); *(u32x2*)(H + (size_t)row * DM + 4 * lane + 256 * j) = w; }
            }
        }
    }
}

__device__ __forceinline__ void bvec_items(const bf16_t* Bt, int N, const float* mod, int mi, float* out, int gw, int NGW, int lane) {
    float sh[5][16];
#pragma unroll
    for (int c = 0; c < 5; ++c)
#pragma unroll
        for (int q = 0; q < 4; ++q) { const f32x4 v = *(const f32x4*)(mod + (size_t)c * (NMOD * DM) + mi * DM + 16 * lane + 4 * q); sh[c][4 * q] = v[0]; sh[c][4 * q + 1] = v[1]; sh[c][4 * q + 2] = v[2]; sh[c][4 * q + 3] = v[3]; }
    for (int n = gw; n < N; n += NGW) {
        const u32x4 w0 = *(const u32x4*)(Bt + (size_t)n * DM + 16 * lane), w1 = *(const u32x4*)(Bt + (size_t)n * DM + 16 * lane + 8);
        const float w[16] = {bflo(w0.x), bfhi(w0.x), bflo(w0.y), bfhi(w0.y), bflo(w0.z), bfhi(w0.z), bflo(w0.w), bfhi(w0.w), bflo(w1.x), bfhi(w1.x), bflo(w1.y), bfhi(w1.y), bflo(w1.z), bfhi(w1.z), bflo(w1.w), bfhi(w1.w)};
        float acc[5];
#pragma unroll
        for (int c = 0; c < 5; ++c) { float a = 0.f;
#pragma unroll
            for (int k = 0; k < 16; ++k) a += sh[c][k] * w[k];
            acc[c] = a; }
#pragma unroll
        for (int o = 1; o < 64; o <<= 1) {
#pragma unroll
            for (int c = 0; c < 5; ++c) acc[c] += __shfl_xor(acc[c], o); }
        if (lane == 0) {
#pragma unroll
            for (int c = 0; c < 5; ++c) out[(size_t)c * N + n] = acc[c]; }
    }
}

__device__ __forceinline__ int crow(int r, int hh) { return (r & 3) + 8 * (r >> 2) + 4 * hh; }
#define MFMA32(a, b, c) __builtin_amdgcn_mfma_f32_32x32x16_bf16((a), (b), (c), 0, 0, 0)
struct KVFrag { bf16x8 k[4]; bf16x8 v[4]; };
__device__ __forceinline__ void kv_load(KVFrag& f, const bf16_t* kt, const bf16_t* vt, int lane) {
#pragma unroll
    for (int i = 0; i < 4; ++i) { f.k[i] = *(const bf16x8*)(kt + i * 512 + lane * 8); f.v[i] = *(const bf16x8*)(vt + i * 512 + lane * 8); }
}
struct AttnState { f32x16 o0, o1; float mrun, lrun; };
template <bool LOCAL, int FAR = 0> __device__ __forceinline__ void attn_tile(AttnState& st, const KVFrag& f, const bf16x8 (&qf)[4], const LAS float* bq, int okb) {
    constexpr float C2 = 0.125f * LOG2E;
    constexpr int R0 = FAR == 2 ? 12 : 0, R1 = FAR == 1 ? 4 : 16;
    f32x16 s;
#pragma unroll
    for (int r = 0; r < 16; ++r) s[r] = 0.f;
#pragma unroll
    for (int d0 = 0; d0 < 4; ++d0) s = MFMA32(f.k[d0], qf[d0], s);
    if (LOCAL) {
#pragma unroll
        for (int r = R0; r < R1; ++r) { const int cr = (r & 3) + 8 * (r >> 2); const bool ok = (unsigned)(okb + cr) < 16u; s[r] = ok ? __builtin_fmaf(s[r], C2, bq[cr]) : -1e30f; }
    }
    float mx = s[R0];
#pragma unroll
    for (int r = R0 + 1; r < R1; ++r) mx = fmaxf(mx, s[r]);
    if (!LOCAL) mx *= C2;
    mx = fmaxf(mx, __shfl_xor(mx, 32));
    const float mnew = fmaxf(st.mrun, mx);
    if (__builtin_amdgcn_ballot_w64(mnew > st.mrun) != 0ull) {
        const float alpha = __builtin_amdgcn_exp2f(st.mrun - mnew);
        st.lrun *= alpha;
#pragma unroll
        for (int r = 0; r < 16; ++r) { st.o0[r] *= alpha; st.o1[r] *= alpha; }
        st.mrun = mnew;
    }
    float ps = 0.f;
#pragma unroll
    for (int r = 0; r < 16; ++r) { if (r >= R0 && r < R1) { s[r] = __builtin_amdgcn_exp2f(LOCAL ? s[r] - mnew : __builtin_fmaf(s[r], C2, -mnew)); ps += s[r]; } else s[r] = 0.f; }
    st.lrun += ps;
    u32x4 p0, p1;
    p0.x = pkbf(s[0], s[1]); p0.y = pkbf(s[2], s[3]); p0.z = pkbf(s[4], s[5]); p0.w = pkbf(s[6], s[7]);
    p1.x = pkbf(s[8], s[9]); p1.y = pkbf(s[10], s[11]); p1.z = pkbf(s[12], s[13]); p1.w = pkbf(s[14], s[15]);
    const bf16x8 pb0 = __builtin_bit_cast(bf16x8, p0), pb1 = __builtin_bit_cast(bf16x8, p1);
    if (FAR != 2) { st.o0 = MFMA32(f.v[0], pb0, st.o0); st.o1 = MFMA32(f.v[2], pb0, st.o1); }
    if (FAR != 1) { st.o0 = MFMA32(f.v[1], pb1, st.o0); st.o1 = MFMA32(f.v[3], pb1, st.o1); }
}
__device__ __forceinline__ void attn_wave(const bf16_t* Qp, bf16_t* Op, int nd, const bf16_t* KFd, const bf16_t* VFd,
                                          int nl, const bf16_t* KFl, const bf16_t* VFl, int rq, int r0, int g, const LAS float* rpbh, int lane) {
    const int r32 = lane & 31, hh = lane >> 5;
    bf16x8 qf[4];
#pragma unroll
    for (int d0 = 0; d0 < 4; ++d0) qf[d0] = *(const bf16x8*)(Qp + (size_t)r32 * DATT + d0 * 16 + 8 * hh);
    AttnState st;
#pragma unroll
    for (int r = 0; r < 16; ++r) { st.o0[r] = 0.f; st.o1[r] = 0.f; }
    st.mrun = -1e30f; st.lrun = 0.f;
    const int nt = nd + nl;
    const int qc = 32 * g + r32; int c0 = qc - 8; c0 = c0 < 0 ? 0 : (c0 > 48 ? 48 : c0);
    KVFrag f0, f1, f2;
#define ATT_LOAD(f, ti) do { const int ti_ = (ti); if (ti_ < nt) { if (ti_ < nd) kv_load(f, KFd + (size_t)ti_ * 2048, VFd + (size_t)ti_ * 2048, lane); \
        else { const int tx_ = 2 * r0 + (ti_ - nd); kv_load(f, KFl + (size_t)tx_ * 2048, VFl + (size_t)tx_ * 2048, lane); } } } while (0)
#define ATT_TILE(f, ti) do { const int ti_ = (ti); if (ti_ < nt) { if (ti_ < nd) attn_tile<false, 0>(st, f, qf, nullptr, 0); \
        else { const int tl_ = ti_ - nd, kb_ = 32 * (tl_ & 1) + 4 * hh; const LAS float* bq_ = rpbh + (r0 + (tl_ >> 1) - rq + 7) * 31 + (kb_ - qc + 15); \
            if ((tl_ & 1) == g) attn_tile<true, 0>(st, f, qf, bq_, kb_ - c0); else if (g == 0) attn_tile<true, 1>(st, f, qf, bq_, kb_ - c0); else attn_tile<true, 2>(st, f, qf, bq_, kb_ - c0); } } } while (0)
    ATT_LOAD(f0, 0); ATT_LOAD(f1, 1);
    for (int ti = 0; ti < nt; ti += 3) {
        ATT_LOAD(f2, ti + 2); ATT_TILE(f0, ti);
        ATT_LOAD(f0, ti + 3); ATT_TILE(f1, ti + 1);
        ATT_LOAD(f1, ti + 4); ATT_TILE(f2, ti + 2);
    }
#undef ATT_LOAD
#undef ATT_TILE
    float lrun = st.lrun; lrun += __shfl_xor(lrun, 32);
    const float inv = 1.0f / lrun;
    bf16_t* op = Op + (size_t)r32 * DATT + 4 * hh;
#pragma unroll
    for (int rg = 0; rg < 4; ++rg) {
        u32x2 w; w.x = pkbf(st.o0[4 * rg] * inv, st.o0[4 * rg + 1] * inv); w.y = pkbf(st.o0[4 * rg + 2] * inv, st.o0[4 * rg + 3] * inv); *(u32x2*)(op + 8 * rg) = w;
        u32x2 x; x.x = pkbf(st.o1[4 * rg] * inv, st.o1[4 * rg + 1] * inv); x.y = pkbf(st.o1[4 * rg + 2] * inv, st.o1[4 * rg + 3] * inv); *(u32x2*)(op + 32 + 8 * rg) = x;
    }
}

template <int HW> __device__ __forceinline__ void dpass_item(const float* ps, bf16_t* ds, int t0, int L) {
    f32x2_t x[32 + 2 * HW];
#pragma unroll
    for (int j = 0; j < 32 + 2 * HW; ++j) { const int t = t0 - HW + j; const bool ok = t >= 0 && t < L; const f32x2_t v = *(const f32x2_t*)(ps + (size_t)(ok ? t : t0) * DATT); x[j] = ok ? v : (f32x2_t){0.f, 0.f}; }
    f32x2_t s = {0.f, 0.f};
#pragma unroll
    for (int j = 0; j < 2 * HW; ++j) s += x[j];
#pragma unroll
    for (int i = 0; i < 32; ++i) {
        const int t = t0 + i; const int lo = t - HW < 0 ? 0 : t - HW, hi = t + HW > L ? L : t + HW;
        const f32x2_t d = s * (1.0f / (float)(hi - lo)) - x[i + HW];
        *(unsigned*)(ds + (size_t)t * DATT) = pkbf(d[0], d[1]);
        if (i < 31) s += x[i + 2 * HW] - x[i];
    }
}

__device__ __forceinline__ void mixer_phase(const Args& a, LAS unsigned char* lds, int tid, int lane, int wave, int G, int what, int vb) {
    unsigned char* ws = a.ws;
    if (what & 1) {
    const bf16_t* Q = (const bf16_t*)(ws + WS_Q); const bf16_t* Kb = (const bf16_t*)(ws + WS_K); const bf16_t* VT = (const bf16_t*)(ws + WS_VT);
    const bf16_t* KC = (const bf16_t*)(ws + WS_KC); const bf16_t* VTC = (const bf16_t*)(ws + WS_VTC);
    bf16_t* ATT = (bf16_t*)(ws + WS_H);
    LAS float* rpbl = (LAS float*)(lds + 1024);
    for (int i = tid; i < 8 * 15 * 31; i += 512) rpbl[i] = a.in[I_RPB][i] * LOG2E;
    __syncthreads();
    for (int u = vb; u < 256; u += G) {
        {
            const int ul = (u & 7) * 32 + (u >> 3), bh = ul >> 3, b = bh >> 3, h = bh & 7, rq = 4 * (ul & 7) + (wave >> 1), g = wave & 1;
            int r0 = rq - 4; r0 = r0 < 0 ? 0 : (r0 > 24 ? 24 : r0);
            const size_t row0 = (size_t)NCTX + (size_t)b * 2048 + rq * 64 + 32 * g;
            attn_wave(Q + row0 * DATT + h * 64, ATT + row0 * DATT + h * 64, 16, KC + (size_t)bh * 16 * 2048, VTC + (size_t)bh * 16 * 2048,
                      16, Kb + KV_LAT + (size_t)bh * 64 * 2048, VT + KV_LAT + (size_t)bh * 64 * 2048, rq, r0, g, rpbl + h * 15 * 31, lane);
        }
        {
            const int b = u >> 3, h = u & 7;
            const size_t row0 = (size_t)b * 256 + 32 * wave;
            attn_wave(Q + row0 * DATT + h * 64, ATT + row0 * DATT + h * 64, 8, Kb + (size_t)u * 8 * 2048, VT + (size_t)u * 8 * 2048,
                      0, Kb, VT, 0, 0, 0, rpbl, lane);
        }
    }
    }
    if (!(what & 2)) return;
    const float* P = (const float*)(ws + WS_P); bf16_t* D = (bf16_t*)(ws + WS_ACT + 64 * MiB);
    const int gw = blockIdx.x * 8 + wave, NGW = G * 8;
    for (int it = gw; it < (NTOK / 32) * 4; it += NGW) {
        const int g = it & 3, row0 = (it >> 2) * 32;
        int t0, L; if (row0 < NCTX) { t0 = row0 & 255; L = 256; } else { t0 = (row0 - NCTX) & 2047; L = 2048; }
        const float* ps = P + (size_t)(row0 - t0) * DATT + g * 128 + 2 * lane; bf16_t* ds = D + (size_t)(row0 - t0) * DATT + g * 128 + 2 * lane;
        if (g == 0) dpass_item<1>(ps, ds, t0, L); else if (g == 1) dpass_item<2>(ps, ds, t0, L); else if (g == 2) dpass_item<4>(ps, ds, t0, L); else dpass_item<8>(ps, ds, t0, L);
    }
}


typedef unsigned v4u __attribute__((ext_vector_type(4)));
#define XB_TMO      128
#define XB_XCNT(j)  (256  + 64 * (j))
#define XB_XSUB(j)  (1280 + 64 * (j))
#define XB_XGEN(j)  (2304 + 64 * (j))
#define XB_TOP      3328
#define XB_TOPGEN   3392
#define XCD_BAR_WORDS 3456
#define XB_SPIN_CAP (1u << 18)

__device__ __forceinline__ unsigned xb_ld(unsigned* p)              { return __hip_atomic_load(p, __ATOMIC_RELAXED, __HIP_MEMORY_SCOPE_AGENT); }
__device__ __forceinline__ unsigned xb_add(unsigned* p, unsigned v) { return __hip_atomic_fetch_add(p, v, __ATOMIC_RELAXED, __HIP_MEMORY_SCOPE_AGENT); }
__device__ __forceinline__ unsigned xb_xcc_id() { return (unsigned)__builtin_amdgcn_s_getreg((3 << 11) | 20) & 0xFu; }
#define XB_SPIN(cond, bar) do { unsigned _sp = 0; while (cond) { __builtin_amdgcn_s_sleep(1); \
    if ((++_sp & 255u) == 0u) { if (xb_ld(&(bar)[XB_TMO])) break; if (_sp > XB_SPIN_CAP) { atomicAdd(&(bar)[XB_TMO], 1u); break; } } } } while (0)

struct XcdBarrier {
    unsigned* bar; unsigned x;
    volatile LAS unsigned* st;
};

__device__ __forceinline__ XcdBarrier xcd_barrier_post(unsigned* bar, volatile LAS unsigned* st) {
    XcdBarrier b; b.bar = bar; b.x = xb_xcc_id(); b.st = st;
    if (threadIdx.x == 0) st[2] = xb_add(&bar[XB_XCNT(b.x)], 1u);
    return b;
}
__device__ __forceinline__ void xcd_barrier_complete(unsigned* bar, unsigned x, unsigned& nloc, unsigned& nx) {
    const unsigned G = gridDim.x * gridDim.y * gridDim.z;
    unsigned sum, cnt, mine, sp = 0u;
    for (;;) {
        sum = 0u; cnt = 0u; mine = 0u;
#pragma unroll
        for (unsigned j = 0; j < 16; ++j) { const unsigned c = xb_ld(&bar[XB_XCNT(j)]); sum += c; cnt += (c > 0u) ? 1u : 0u; mine = (j == x) ? c : mine; }
        if (sum == G) break;
        __builtin_amdgcn_s_sleep(1);
        if ((++sp & 255u) == 0u) { if (xb_ld(&bar[XB_TMO])) break; if (sp > XB_SPIN_CAP) { atomicAdd(&bar[XB_TMO], 1u); break; } }
    }
    nloc = mine > 0u ? mine : 1u; nx = cnt > 0u ? cnt : 1u;
}

__device__ __forceinline__ void xcd_barrier(const XcdBarrier& b) {
    asm volatile("s_waitcnt vmcnt(0)" ::: "memory");
    __syncthreads();
    if (threadIdx.x == 0) {
        unsigned* bar = b.bar;
        __builtin_amdgcn_s_waitcnt(0);
        unsigned nloc = b.st[0], nx = b.st[1];
        if (nloc == 0u) { xcd_barrier_complete(bar, b.x, nloc, nx); b.st[0] = nloc; b.st[1] = nx; }
        const unsigned old = xb_add(&bar[XB_XSUB(b.x)], 1u);
        const unsigned gen = old / nloc;
        if (old + 1u == (gen + 1u) * nloc) {
            __builtin_amdgcn_fence(__ATOMIC_RELEASE, "agent");
            asm volatile("s_waitcnt vmcnt(0)" ::: "memory");
            const unsigned og = xb_add(&bar[XB_TOP], 1u);
            const unsigned tg = og / nx;
            if (og + 1u == (tg + 1u) * nx) xb_add(&bar[XB_TOPGEN], 1u);
            else XB_SPIN(xb_ld(&bar[XB_TOPGEN]) == tg, bar);
            __builtin_amdgcn_fence(__ATOMIC_ACQUIRE, "agent");
            xb_add(&bar[XB_XGEN(b.x)], 1u);
            asm volatile("s_waitcnt vmcnt(0)" ::: "memory");
        } else {
            XB_SPIN(xb_ld(&bar[XB_XGEN(b.x)]) == gen, bar);
            __builtin_amdgcn_fence(__ATOMIC_ACQUIRE, "agent");
            asm volatile("s_waitcnt vmcnt(0)" ::: "memory");
        }
    }
    __syncthreads();
}

#ifndef PROBE_DUP
#define PROBE_DUP -1
#endif
constexpr int LDS_BYTES = 147456;
__global__ void __launch_bounds__(512, 2) mk_fwd(Args args) {
    extern __shared__ __attribute__((aligned(16))) unsigned char lds_raw[];
    LAS unsigned char* lds = (LAS unsigned char*)lds_raw;
    cg::grid_group grid = cg::this_grid();
    const int tid = threadIdx.x, lane = tid & 63, wave = __builtin_amdgcn_readfirstlane(tid >> 6), G = gridDim.x;
    unsigned char* ws = args.ws;
    const int lo = args.ph_lo, hi = args.ph_hi;
    if (tid < 64) ((LAS unsigned*)(lds + 131072))[tid] = 0u;
    __syncthreads();
    XcdBarrier bar = xcd_barrier_post((unsigned*)(ws + WS_CTL), (volatile LAS unsigned*)(lds + 131072 + 64));
    if (hi > 1000) grid.sync();
    const float* mod = (const float*)(ws + WS_MOD);
    float* Y = args.out + OUT_Y;
    bf16_t* H = (bf16_t*)(ws + WS_H); bf16_t* ACT = (bf16_t*)(ws + WS_ACT);
#define IN(k) (lo <= (k) && (k) < hi)
#define SEAM(k) do { if (IN(k) && IN((k) + 1)) xcd_barrier(bar); } while (0)
#define GEMM_PHASE(EPI, e, Aptr, Bptr, N_, K_) do { pg8::Gemm g_{(const bf16_t*)(Aptr), (const bf16_t*)(Bptr), NTOK, (N_), (K_)}; pg8::StaticOrder S_; S_.init(NTOK, (N_), G, vb); \
        pg8::gemm_phase<EPI, pg8::StaticOrder, true, true>(lds, g_, S_, e); } while (0)

    float* SSb = (float*)(ws + WS_SS); float* BVIN = (float*)(ws + WS_BVIN); float* BVFF2 = (float*)(ws + WS_BVFF2);
    const int gwv = blockIdx.x * 8 + wave, NGWv = G * 8;
#define PHASE(k, ...) if (IN(k)) { __VA_ARGS__ if (PROBE_DUP == (k)) { xcd_barrier(bar); __VA_ARGS__ } }
    PHASE(0, { phase0(args, lds, tid, lane, wave, G); }) SEAM(0);
    int vb = blockIdx.x;
    if (IN(0) && IN(1)) {
        volatile LAS unsigned* stw = (volatile LAS unsigned*)(lds + 131072 + 64);
        if (tid == 0) { const unsigned* bw = (const unsigned*)(ws + WS_CTL); bool ok = (G % 8 == 0) && bar.x < 8u;
            for (int j = 0; j < 8; ++j) ok = ok && (xb_ld((unsigned*)&bw[XB_XCNT(j)]) == (unsigned)(G / 8));
            stw[3] = ok ? (stw[2] * 8u + bar.x) : (unsigned)blockIdx.x; }
        __syncthreads();
        vb = (int)stw[3];
    }
    vb = __builtin_amdgcn_readfirstlane(vb);
    PHASE(1, { norm_phase(args.in[I_XP], args.in[I_XS], args.in[I_GFF1], mod, 0, H, G, wave, lane);
               bvec_items((const bf16_t*)(ws + WS_WIN), DIN, mod, 3, BVIN, gwv, NGWv, lane); }) SEAM(1);
    PHASE(2, { EpiSwiGLU<false> e{ws, nullptr, 0}; GEMM_PHASE(EpiSwiGLU<false>, e, H, ws + WS_FF1IN, 2 * DFF, DM);
               if (G == 256) { if (vb >= 128) late_copies(args, lds, lane, wave, (vb - 128) * 8 + wave, 1024); } else late_copies(args, lds, lane, wave, vb * 8 + wave, G * 8); }) SEAM(2);
    PHASE(3, { typedef EpiResid<true, 2, 1, 3> E3; E3 e{args.in[I_XP], (long)(args.in[I_XS] - args.in[I_XP]) - (long)NCTX * DM, Y, ws, args.in[I_GMIX]}; GEMM_PHASE(E3, e, ACT, ws + WS_FF1OUT, DM, DFF); }) SEAM(3);
    PHASE(4, { LAS float* tbl = (LAS float*)(lds + 141824); { pg8::StaticOrder S_; S_.init(NTOK, DIN, G, vb); rstd_table(SSb, S_, tbl, 5, tid); }
               EpiWin e{ws, args.out + OUT_K, args.in[I_QG], args.in[I_KG], lds + 131072 + 512, tbl, 5};
               GEMM_PHASE(EpiWin, e, H, ws + WS_WIN, DIN, DM); }) SEAM(4);
    PHASE(5, { mixer_phase(args, lds, tid, lane, wave, G, 3, vb); bvec_items((const bf16_t*)(ws + WS_FF2IN), 2 * DFF, mod, 6, BVFF2, gwv, NGWv, lane); }) SEAM(5);
    PHASE(6, { { EpiMix<1> e{ws, nullptr}; GEMM_PHASE(EpiMix<1>, e, ws + WS_ACT + 64 * MiB, ws + WS_WBP, DM, DATT); }
               { EpiMix<2> e{ws, nullptr}; GEMM_PHASE(EpiMix<2>, e, H, ws + WS_WBA, DM, DATT); } }) SEAM(6);
    if (IN(7)) { typedef EpiResid<true, 5, 2, 6> E8; E8 e{Y, 0L, Y, ws, args.in[I_GFF2]}; GEMM_PHASE(E8, e, ws + WS_P, ws + WS_WOUT, DM, DM); } SEAM(7);
    PHASE(8, { LAS float* tbl = (LAS float*)(lds + 131072 + 512); { pg8::StaticOrder S_; S_.init(NTOK, 2 * DFF, G, vb); rstd_table(SSb, S_, tbl, 15, tid); }
               EpiSwiGLU<true> e{ws, tbl, 15}; GEMM_PHASE(EpiSwiGLU<true>, e, H, ws + WS_FF2IN, 2 * DFF, DM); }) SEAM(8);
    if (IN(9)) { typedef EpiResid<false, 8, 1, 0> E10; E10 e{Y, 0L, Y, ws, nullptr}; GEMM_PHASE(E10, e, ACT, ws + WS_FF2OUT, DM, DFF); }
}

#ifndef MK_PER_PHASE
#define MK_PER_PHASE 0
#endif
extern "C" void kernel_launch(void* const* d_in, const int* in_sizes, int n_in, void* d_out, int out_size, void* d_ws, size_t ws_size, hipStream_t stream) {
    static int grid = 0;
    if (grid == 0) {
        if (n_in != 24 || ws_size < WS_END) { fprintf(stderr, "kernel_launch: unexpected n_in %d / ws_size %zu (need %zu)\n", n_in, ws_size, (size_t)WS_END); grid = -1; return; }
        int dev = 0, cus = 0, per_cu = 0;
        hipGetDevice(&dev); hipDeviceGetAttribute(&cus, hipDeviceAttributeMultiprocessorCount, dev);
        if (hipFuncSetAttribute((const void*)mk_fwd, hipFuncAttributeMaxDynamicSharedMemorySize, LDS_BYTES) != hipSuccess) { fprintf(stderr, "kernel_launch: hipFuncSetAttribute failed\n"); grid = -1; return; }
        if (hipOccupancyMaxActiveBlocksPerMultiprocessor(&per_cu, (const void*)mk_fwd, 512, LDS_BYTES) != hipSuccess || per_cu < 1) { fprintf(stderr, "kernel_launch: occupancy query says %d\n", per_cu); per_cu = 1; }
        (void)hipGetLastError();
        grid = cus * per_cu;
        fprintf(stderr, "kernel_launch: grid %d (cus %d x %d), ws %zu\n", grid, cus, per_cu, ws_size);
    }
    if (grid < 0) return;
    if (hipMemsetAsync((char*)d_ws + WS_CTL, 0, CTL_BYTES, stream) != hipSuccess) { fprintf(stderr, "kernel_launch: memset failed\n"); return; }
    Args a{};
    for (int i = 0; i < 24; ++i) a.in[i] = (const float*)d_in[i];
    a.out = (float*)d_out; a.ws = (unsigned char*)d_ws;
#if MK_PER_PHASE
    for (int p = 0; p < 10; ++p) { a.ph_lo = p; a.ph_hi = p + 1; hipLaunchKernelGGL(mk_fwd, dim3(grid), dim3(512), LDS_BYTES, stream, a); }
#else
    a.ph_lo = 0; a.ph_hi = 10;
    void* kargs[] = {&a};
    hipError_t e = hipLaunchCooperativeKernel((const void*)mk_fwd, dim3(grid), dim3(512), kargs, LDS_BYTES, stream);
    if (e != hipSuccess) fprintf(stderr, "kernel_launch: cooperative launch failed: %s (grid %d)\n", hipGetErrorString(e), grid);
#endif
}
```

```cpp
#include <hip/hip_runtime.h>
#include <hip/hip_cooperative_groups.h>
#include <cstdio>
#include <cstdint>
namespace cg = cooperative_groups;
namespace pg8 {
#define PG8_LAS __attribute__((address_space(3)))
typedef unsigned short bf16_t;
typedef short bf16x8 __attribute__((ext_vector_type(8)));
typedef float f32x4 __attribute__((ext_vector_type(4)));
typedef unsigned u32x4 __attribute__((ext_vector_type(4)));
constexpr int BM = 256, BK = 64, HALF = 128, HTB = HALF * BK * 2  , STAGE_BYTES = 8 * HTB, NXCD = 8, WGM = 8;

__host__ __device__ __forceinline__ int lds_byte(int r, int c) { const int st = (r >> 4) * 2 + (c >> 5), rr = r & 15, cc = c & 31, ob = rr * 64 + cc * 2; return st * 1024 + (ob ^ (((ob >> 9) & 1) << 5)); }
__host__ __device__ __forceinline__ void stage_rc(int b, int& R, int& C) { const int st = b / 1024, sb = b % 1024, swz = sb ^ (((sb >> 9) & 1) << 5); R = (st >> 1) * 16 + swz / 64; C = (st & 1) * 32 + (swz % 64) / 2; }
__host__ __device__ __forceinline__ int perm32(int rho) { const int n = rho >> 4, i = rho & 15; return 8 * (i >> 2) + 4 * n + (i & 3); }

struct Unit { int pm, pn, ord; };
struct Gemm { const bf16_t* A; const bf16_t* Bt; int M, N, K; };

struct StaticOrder {
    int nM, nN, nwg, G, c;
    __host__ __device__ void init(int M, int N, int G_, int c_) { nM = M / BM; nN = N / BM; nwg = nM * nN; G = G_; c = c_; }
    __host__ __device__ bool next(int i, Unit& u) const {
        const long L = (long)i * G + c; if (L >= nwg) return false;
        int wgid = (int)L; { const int q = nwg / NXCD, r = nwg % NXCD, xcd = wgid % NXCD, off = wgid / NXCD; wgid = (xcd < r ? xcd * (q + 1) : r * (q + 1) + (xcd - r) * q) + off; }
        const int nig = WGM * nN, gid = wgid / nig, fm = gid * WGM, gsz = (nM - fm) < WGM ? (nM - fm) : WGM;
        u.pm = fm + ((wgid % nig) % gsz); u.pn = (wgid % nig) / gsz; u.ord = i; return true;
    }
    __device__ __forceinline__ void a_ready(const Unit&) const {}
    __device__ __forceinline__ void done(const Unit&) const {}
};

__device__ __forceinline__ unsigned cvt_pk_bf16(float lo, float hi) { unsigned r; asm volatile("v_cvt_pk_bf16_f32 %0, %1, %2" : "=v"(r) : "v"(lo), "v"(hi)); return r; }
template <class Epi, class Sched, bool ALIGN_EPI = false, bool SP2 = false>
__device__ __forceinline__ void gemm_phase(PG8_LAS unsigned char* lds, const Gemm g, const Sched S, const Epi E) {
    const int tid = threadIdx.x, wid = __builtin_amdgcn_readfirstlane(tid >> 6), lane = tid & 63, wr = wid >> 2, wc = wid & 3, fr = lane & 15, fq = lane >> 4;
    const int K = g.K, nt = K / BK;
    unsigned voffA[2], voffB[2];
#pragma unroll
    for (int i = 0; i < 2; ++i) { int R, C; stage_rc(tid * 16 + i * 8192, R, C); const int Rb = Epi::PERM ? ((R & ~31) + perm32(R & 31)) : R;
        voffA[i] = (unsigned)(R * K + C) * 2u; voffB[i] = (unsigned)(Rb * K + C) * 2u; }
    const size_t kstep = (size_t)(BK * 2);
    const size_t hstep = (size_t)HALF * K * 2;
    const size_t tstep = 2 * hstep;
    const unsigned ldsw = (unsigned)wid * 1024u;
    const int aoff = lds_byte(wr * 64 + fr, fq * 8), boff = lds_byte(wc * 32 + fr, fq * 8);
#define PG8_SA(b, h) (((b) * 2 + (h)) * HTB)
#define PG8_SB(b, h) ((4 + (b) * 2 + (h)) * HTB)
#define PG8_STAGE(bufoff, gbase, voff) do { _Pragma("unroll") for (int _i = 0; _i < 2; ++_i) \
        __builtin_amdgcn_global_load_lds((const unsigned*)((const char*)(gbase) + (voff)[_i]), (PG8_LAS unsigned*)(lds + (bufoff) + ldsw + _i * 8192), 16, 0, 0); } while (0)
#define PG8_LDA(dst, b, h) do { _Pragma("unroll") for (int m = 0; m < 4; ++m) _Pragma("unroll") for (int k = 0; k < 2; ++k) dst[m][k] = *(const PG8_LAS bf16x8*)(lds + PG8_SA(b, h) + aoff + m * 2048 + k * 1024); } while (0)
#define PG8_LDB(dst, b, h) do { _Pragma("unroll") for (int n = 0; n < 2; ++n) _Pragma("unroll") for (int k = 0; k < 2; ++k) dst[n][k] = *(const PG8_LAS bf16x8*)(lds + PG8_SB(b, h) + boff + n * 2048 + k * 1024); } while (0)
#define PG8_MMA(ai, bj, At, Bt) do { __builtin_amdgcn_s_setprio(1); _Pragma("unroll") for (int m = 0; m < 4; ++m) _Pragma("unroll") for (int n = 0; n < 2; ++n) _Pragma("unroll") for (int k = 0; k < 2; ++k) \
        acc[ai][bj][m][n] = __builtin_amdgcn_mfma_f32_16x16x32_bf16(Bt[n][k], At[m][k], acc[ai][bj][m][n], 0, 0, 0); __builtin_amdgcn_s_setprio(0); } while (0)
#define PG8_WAIT_V(n) asm volatile("s_waitcnt vmcnt(" #n ")" ::: "memory")
#define PG8_WAIT_L(n) asm volatile("s_waitcnt lgkmcnt(" #n ")" ::: "memory")
#define PG8_BAR __builtin_amdgcn_s_barrier()
#define PG8_SCHED __builtin_amdgcn_sched_barrier(0)
    Unit cur, nxt; int ui = 0;
    if (!S.next(0, cur)) return;
    f32x4 acc[2][2][4][2];
#pragma unroll
    for (int a = 0; a < 2; ++a)
#pragma unroll
        for (int b = 0; b < 2; ++b)
#pragma unroll
            for (int m = 0; m < 4; ++m)
#pragma unroll
                for (int n = 0; n < 2; ++n) acc[a][b][m][n] = (f32x4){0.f, 0.f, 0.f, 0.f};
    bf16x8 At[4][2], B0[2][2], B1[2][2];
    const char* cA = (const char*)g.A + (size_t)cur.pm * tstep; const char* cB = (const char*)g.Bt + (size_t)cur.pn * tstep;
    S.a_ready(cur);
    if constexpr (SP2) {
        PG8_STAGE(PG8_SB(0, 0), cB, voffB); PG8_STAGE(PG8_SB(0, 1), cB + hstep, voffB); PG8_STAGE(PG8_SA(0, 0), cA, voffA); PG8_STAGE(PG8_SA(0, 1), cA + hstep, voffA);
        if (wr == 1) PG8_BAR;
        PG8_WAIT_V(2); PG8_BAR;
        PG8_STAGE(PG8_SB(1, 0), cB + kstep, voffB); PG8_STAGE(PG8_SA(1, 0), cA + kstep, voffA); PG8_STAGE(PG8_SB(1, 1), cB + hstep + kstep, voffB);
        PG8_WAIT_V(6); PG8_BAR;
    } else {
        PG8_STAGE(PG8_SB(0, 0), cB, voffB); PG8_STAGE(PG8_SA(0, 0), cA, voffA); PG8_STAGE(PG8_SB(0, 1), cB + hstep, voffB); PG8_STAGE(PG8_SA(0, 1), cA + hstep, voffA);
        if (wr == 1) PG8_BAR;
        PG8_WAIT_V(4); PG8_BAR;
        PG8_STAGE(PG8_SB(1, 0), cB + kstep, voffB); PG8_STAGE(PG8_SA(1, 0), cA + kstep, voffA); PG8_STAGE(PG8_SB(1, 1), cB + hstep + kstep, voffB);
        PG8_WAIT_V(6); PG8_BAR;
    }
    for (;;) {
        const bool has_next = S.next(ui + 1, nxt);
        const char* nA = has_next ? (const char*)g.A + (size_t)nxt.pm * tstep : cA; const char* nB = has_next ? (const char*)g.Bt + (size_t)nxt.pn * tstep : cB;
        for (int t = 0; t < nt; t += 2) {
            const bool last = (t == nt - 2);
            const char* a1 = cA + (size_t)(t + 1) * kstep;
            const char* a2 = last ? nA : cA + (size_t)(t + 2) * kstep; const char* b2 = last ? nB : cB + (size_t)(t + 2) * kstep;
            const char* a3 = a2 + kstep; const char* b3 = b2 + kstep;
            if (last && has_next) S.a_ready(nxt);
            if constexpr (SP2) {
            PG8_LDB(B0, 0, 0); PG8_LDB(B1, 0, 1); PG8_SCHED; PG8_LDA(At, 0, 0); PG8_STAGE(PG8_SA(1, 1), a1 + hstep, voffA);
            PG8_WAIT_V(8); PG8_WAIT_L(0); PG8_BAR; PG8_MMA(0, 0, At, B0); PG8_MMA(0, 1, At, B1); PG8_BAR; PG8_SCHED;
            PG8_LDA(At, 0, 1); PG8_STAGE(PG8_SB(0, 0), b2, voffB); PG8_STAGE(PG8_SB(0, 1), b2 + hstep, voffB); PG8_STAGE(PG8_SA(0, 0), a2, voffA);
            PG8_WAIT_V(8); PG8_WAIT_L(0); PG8_BAR; PG8_MMA(1, 0, At, B0); PG8_MMA(1, 1, At, B1); PG8_BAR; PG8_SCHED;
            PG8_LDB(B0, 1, 0); PG8_LDB(B1, 1, 1); PG8_SCHED; PG8_LDA(At, 1, 0); PG8_STAGE(PG8_SA(0, 1), a2 + hstep, voffA);
            PG8_WAIT_V(8); PG8_WAIT_L(0); PG8_BAR; PG8_MMA(0, 0, At, B0); PG8_MMA(0, 1, At, B1); PG8_BAR; PG8_SCHED;
            PG8_LDA(At, 1, 1); PG8_STAGE(PG8_SB(1, 0), b3, voffB); PG8_STAGE(PG8_SB(1, 1), b3 + hstep, voffB); PG8_STAGE(PG8_SA(1, 0), a3, voffA);
            PG8_WAIT_V(8); PG8_WAIT_L(0); PG8_BAR; PG8_MMA(1, 0, At, B0); PG8_MMA(1, 1, At, B1); PG8_BAR; PG8_SCHED;
            } else {
            PG8_LDB(B0, 0, 0); PG8_SCHED; PG8_LDA(At, 0, 0); PG8_STAGE(PG8_SA(1, 1), a1 + hstep, voffA);
            PG8_WAIT_L(8); PG8_BAR; PG8_WAIT_L(0); PG8_MMA(0, 0, At, B0); PG8_BAR; PG8_SCHED;
            PG8_LDB(B1, 0, 1); PG8_STAGE(PG8_SB(0, 0), b2, voffB);
            PG8_BAR; PG8_WAIT_L(0); PG8_MMA(0, 1, At, B1); PG8_BAR;
            PG8_LDA(At, 0, 1); PG8_STAGE(PG8_SA(0, 0), a2, voffA);
            PG8_BAR; PG8_WAIT_L(0); PG8_MMA(1, 0, At, B0); PG8_BAR; PG8_SCHED;
            PG8_STAGE(PG8_SB(0, 1), b2 + hstep, voffB);
            PG8_WAIT_V(6); PG8_BAR; PG8_MMA(1, 1, At, B1); PG8_BAR;
            PG8_LDB(B0, 1, 0); PG8_SCHED; PG8_LDA(At, 1, 0); PG8_STAGE(PG8_SA(0, 1), a2 + hstep, voffA);
            PG8_WAIT_L(8); PG8_BAR; PG8_WAIT_L(0); PG8_MMA(0, 0, At, B0); PG8_BAR; PG8_SCHED;
            PG8_LDB(B1, 1, 1); PG8_STAGE(PG8_SB(1, 0), b3, voffB);
            PG8_BAR; PG8_WAIT_L(0); PG8_MMA(0, 1, At, B1); PG8_BAR;
            PG8_LDA(At, 1, 1); PG8_STAGE(PG8_SA(1, 0), a3, voffA);
            PG8_BAR; PG8_WAIT_L(0); PG8_MMA(1, 0, At, B0); PG8_BAR; PG8_SCHED;
            PG8_STAGE(PG8_SB(1, 1), b3 + hstep, voffB);
            PG8_WAIT_V(6); PG8_BAR; PG8_MMA(1, 1, At, B1); PG8_BAR;
            }
        }
        if constexpr (ALIGN_EPI) { if (wr == 0) PG8_BAR; }
        if constexpr (!Epi::AFTER_DRAIN) { E(acc, cur, wr, wc, fr, fq); S.done(cur); }
        if (!has_next) break;
#pragma unroll
        for (int a = 0; a < 2; ++a)
#pragma unroll
            for (int b = 0; b < 2; ++b)
#pragma unroll
                for (int m = 0; m < 4; ++m)
#pragma unroll
                    for (int n = 0; n < 2; ++n) acc[a][b][m][n] = (f32x4){0.f, 0.f, 0.f, 0.f};
        cur = nxt; cA = nA; cB = nB; ++ui;
        if constexpr (ALIGN_EPI) { if (wr == 1) PG8_BAR; }
    }
    PG8_WAIT_V(0);
    if constexpr (!ALIGN_EPI) { if (wr == 0) PG8_BAR; }
    PG8_BAR;
    if constexpr (Epi::AFTER_DRAIN) { E.fused(acc, cur, wr, wc, fr, fq, lds, wid, lane); S.done(cur); }
#undef PG8_SA
#undef PG8_SB
#undef PG8_STAGE
#undef PG8_LDA
#undef PG8_LDB
#undef PG8_MMA
#undef PG8_WAIT_V
#undef PG8_WAIT_L
#undef PG8_BAR
#undef PG8_SCHED
}
}

#define LAS __attribute__((address_space(3)))
using pg8::bf16_t; using pg8::bf16x8; using pg8::f32x4; using pg8::u32x4;
typedef float f32x16 __attribute__((ext_vector_type(16)));
typedef float f32x2_t __attribute__((ext_vector_type(2)));
typedef __bf16 bf16x2_t __attribute__((ext_vector_type(2)));
typedef unsigned u32x2 __attribute__((ext_vector_type(2)));

constexpr int DM = 1024, NTOK = 16384, NCTX = 8192, DFF = 2816, DATT = 512, DIN = 4096, NMOD = 9;
constexpr float EPS = 1e-6f, LOG2E = 1.4426950408889634f;
constexpr size_t MiB = 1u << 20;
constexpr size_t WS_FF1IN = 0, WS_FF1OUT = 11 * MiB, WS_FF2IN = 17 * MiB, WS_FF2OUT = 28 * MiB, WS_WIN = 34 * MiB, WS_WBP = 42 * MiB, WS_WBA = 43 * MiB, WS_WOUT = 44 * MiB,
                 WS_WPOOL = 46 * MiB, WS_MOD = 47 * MiB, WS_KC = 48 * MiB, WS_VTC = 50 * MiB;
constexpr size_t WS_H = 52 * MiB;
constexpr size_t WS_ACT = 84 * MiB;
constexpr size_t WS_P = 172 * MiB;
constexpr size_t WS_Q = 204 * MiB;
constexpr size_t WS_K = 220 * MiB;
constexpr size_t WS_VT = 236 * MiB;
constexpr size_t WS_CTL = 252 * MiB, CTL_BYTES = 16384;
constexpr size_t WS_SS = 253 * MiB;
constexpr size_t WS_BVIN = 47 * MiB + 512 * 1024, WS_BVFF2 = WS_BVIN + 128 * 1024;
constexpr size_t WS_END = 254 * MiB;
static_assert(WS_END <= 256 * MiB, "d_ws map");
constexpr size_t KV_LAT = (size_t)32 * 8 * 8 * 2048;
constexpr size_t OUT_Y = 0, OUT_K = (size_t)NTOK * DM, OUT_V = OUT_K + (size_t)NCTX * DATT;

__device__ __forceinline__ unsigned pkbf(float lo, float hi) { f32x2_t v = {lo, hi}; bf16x2_t b = __builtin_convertvector(v, bf16x2_t); return __builtin_bit_cast(unsigned, b); }
__device__ __forceinline__ float bflo(unsigned w) { return __uint_as_float(w << 16); }
__device__ __forceinline__ float bfhi(unsigned w) { return __uint_as_float(w & 0xffff0000u); }
__device__ __forceinline__ float fast_sigmoid(float x) { return __builtin_amdgcn_rcpf(1.0f + __builtin_amdgcn_exp2f(-x * LOG2E)); }
__device__ __forceinline__ float wave_sum(float v) {
#pragma unroll
    for (int o = 1; o < 64; o <<= 1) v += __shfl_xor(v, o);
    return v;
}
__device__ __forceinline__ int cond_of_pm(int pm) { return pm < 32 ? 0 : 1 + ((pm - 32) >> 3); }

__device__ __forceinline__ float row_sumsq(const float* SS, int row, int fq) {
    const f32x4 a = *(const f32x4*)(SS + (size_t)row * 16 + 4 * fq); float s = (a[0] + a[1]) + (a[2] + a[3]);
    s += __shfl_xor(s, 16); s += __shfl_xor(s, 32); return s;
}
__device__ __forceinline__ float rstd_of(float sumsq) { return 1.0f / sqrtf(sumsq * (1.0f / DM) + EPS); }

__device__ __forceinline__ void rstd_table(const float* SS, const pg8::StaticOrder& S, LAS float* tbl, int nmax, int tid) {
    pg8::Unit u;
    for (int i = 0; i < nmax && S.next(i, u); ++i)
        if (tid < 256) { const f32x4* p = (const f32x4*)(SS + (size_t)(u.pm * 256 + tid) * 16); const f32x4 a = (p[0] + p[1]) + (p[2] + p[3]); tbl[i * 256 + tid] = rstd_of(((a[0] + a[1]) + (a[2] + a[3]))); }
    __syncthreads();
}

#define EPI_ROWS(ai, m) (u.pm * 256 + (ai) * 128 + wr * 64 + (m) * 16 + fr)

template <bool NORMED> struct EpiSwiGLU {
    static constexpr bool PERM = true, AFTER_DRAIN = false;
    unsigned char* ws; const LAS float* tbl; int nmax;
    __device__ __forceinline__ void operator()(const f32x4 (&acc)[2][2][4][2], const pg8::Unit& u, int wr, int wc, int fr, int fq) const {
        bf16_t* O = (bf16_t*)(ws + WS_ACT); const float* bvec = (const float*)(ws + WS_BVFF2); const float* SS = (const float*)(ws + WS_SS);
        const int col = u.pn * 128 + wc * 32 + 8 * fq;
        f32x4 bv[2][2];
        if (NORMED) { const float* bp = bvec + (size_t)cond_of_pm(u.pm) * (2 * DFF) + u.pn * 256 + wc * 32 + 8 * fq;
#pragma unroll
            for (int bj = 0; bj < 2; ++bj)
#pragma unroll
                for (int n = 0; n < 2; ++n) bv[bj][n] = *(const f32x4*)(bp + bj * 128 + 4 * n); }
#pragma unroll
        for (int ai = 0; ai < 2; ++ai)
#pragma unroll
            for (int m = 0; m < 4; ++m) {
                const int row = EPI_ROWS(ai, m);
                const float rs = NORMED ? (u.ord < nmax ? tbl[u.ord * 256 + ai * 128 + wr * 64 + m * 16 + fr] : rstd_of(row_sumsq(SS, row, fq))) : 1.f;
                float v[8];
#pragma unroll
                for (int n = 0; n < 2; ++n)
#pragma unroll
                    for (int j = 0; j < 4; ++j) { float g = acc[ai][0][m][n][j], up = acc[ai][1][m][n][j]; if (NORMED) { g = g * rs + bv[0][n][j]; up = up * rs + bv[1][n][j]; } v[4 * n + j] = g * fast_sigmoid(g) * up; }
                u32x4 w; w.x = pkbf(v[0], v[1]); w.y = pkbf(v[2], v[3]); w.z = pkbf(v[4], v[5]); w.w = pkbf(v[6], v[7]);
                *(u32x4*)(O + (size_t)row * DFF + col) = w;
            }
    }
};
template <bool NEXT, int GI, int COEF2, int MNEXT> struct EpiResid {
    static constexpr bool PERM = true, AFTER_DRAIN = false;
    const float* base0; long d1;
    float* out; unsigned char* ws; const float* gnext;
    __device__ __forceinline__ void operator()(const f32x4 (&acc)[2][2][4][2], const pg8::Unit& u, int wr, int wc, int fr, int fq) const {
        constexpr int gi = GI, mnext = MNEXT; constexpr float coef = 0.5f * COEF2;
        bf16_t* XA = (bf16_t*)(ws + WS_H); float* SS = (float*)(ws + WS_SS);
        const float* mc = (const float*)(ws + WS_MOD) + (size_t)cond_of_pm(u.pm) * (NMOD * DM);
        const float* gv = mc + gi * DM;
        const float* base = base0 + (u.pm < 32 ? 0L : d1);
        const int col = u.pn * 256 + wc * 32 + 8 * fq;
        f32x4 g[2][2], an[2][2];
#pragma unroll
        for (int bj = 0; bj < 2; ++bj)
#pragma unroll
            for (int n = 0; n < 2; ++n) { g[bj][n] = *(const f32x4*)(gv + col + bj * 128 + 4 * n) * coef;
                if (NEXT) an[bj][n] = *(const f32x4*)(gnext + col + bj * 128 + 4 * n) * (*(const f32x4*)(mc + (mnext + 1) * DM + col + bj * 128 + 4 * n) + 1.0f); }
#pragma unroll
        for (int ai = 0; ai < 2; ++ai)
#pragma unroll
            for (int m = 0; m < 4; ++m) { const int row = EPI_ROWS(ai, m); const size_t off = (size_t)row * DM + col; float ss = 0.f;
#pragma unroll
                for (int bj = 0; bj < 2; ++bj) { f32x4 o[2];
#pragma unroll
                    for (int n = 0; n < 2; ++n) { const f32x4 b = *(const f32x4*)(base + off + bj * 128 + 4 * n); o[n] = b + g[bj][n] * acc[ai][bj][m][n]; if (NEXT) *(f32x4*)(out + off + bj * 128 + 4 * n) = o[n]; else __builtin_nontemporal_store(o[n], (f32x4*)(out + off + bj * 128 + 4 * n));
                        if (NEXT) ss += (o[n][0] * o[n][0] + o[n][1] * o[n][1]) + (o[n][2] * o[n][2] + o[n][3] * o[n][3]); }
                    if (NEXT) { const f32x4 xa = o[0] * an[bj][0], xb = o[1] * an[bj][1]; u32x4 w; w.x = pkbf(xa[0], xa[1]); w.y = pkbf(xa[2], xa[3]); w.z = pkbf(xb[0], xb[1]); w.w = pkbf(xb[2], xb[3]);
                        *(u32x4*)(XA + off + bj * 128) = w; }
                }
                if (NEXT) { ss += __shfl_xor(ss, 16); ss += __shfl_xor(ss, 32); if (fq == 0) SS[(size_t)row * 16 + u.pn * 4 + wc] = ss; }
            }
    }
};
struct EpiWin {
    static constexpr bool PERM = true, AFTER_DRAIN = false;
    unsigned char* ws; float* outk; const float* qgain; const float* kgain; LAS unsigned char* scr; const LAS float* tbl; int nmax;
    __device__ __forceinline__ void operator()(const f32x4 (&accr)[2][2][4][2], const pg8::Unit& u, int wr, int wc, int fr, int fq) const {
        const int pn = u.pn;
        float* P = (float*)(ws + WS_P); bf16_t* Q = (bf16_t*)(ws + WS_Q); bf16_t* Kb = (bf16_t*)(ws + WS_K); bf16_t* VT = (bf16_t*)(ws + WS_VT); bf16_t* Gt = (bf16_t*)(ws + WS_ACT);
        float* outv = outk + (size_t)NCTX * DATT; const float* bvec = (const float*)(ws + WS_BVIN);
        f32x4 (&acc)[2][2][4][2] = const_cast<f32x4 (&)[2][2][4][2]>(accr);
        { const float* bp = bvec + (size_t)cond_of_pm(u.pm) * DIN + pn * 256 + wc * 32 + 8 * fq; f32x4 bv[2][2];
#pragma unroll
            for (int bj = 0; bj < 2; ++bj)
#pragma unroll
                for (int n = 0; n < 2; ++n) bv[bj][n] = *(const f32x4*)(bp + bj * 128 + 4 * n);
#pragma unroll
            for (int ai = 0; ai < 2; ++ai)
#pragma unroll
                for (int m = 0; m < 4; ++m) { const float rs = u.ord < nmax ? tbl[u.ord * 256 + ai * 128 + wr * 64 + m * 16 + fr] : rstd_of(row_sumsq((const float*)(ws + WS_SS), EPI_ROWS(ai, m), fq));
#pragma unroll
                    for (int bj = 0; bj < 2; ++bj)
#pragma unroll
                        for (int n = 0; n < 2; ++n) acc[ai][bj][m][n] = accr[ai][bj][m][n] * rs + bv[bj][n]; } }

        if (pn < 2) {
            const int col = pn * 256 + wc * 32 + 8 * fq;
#pragma unroll
            for (int ai = 0; ai < 2; ++ai)
#pragma unroll
                for (int m = 0; m < 4; ++m) { float* rp = P + (size_t)EPI_ROWS(ai, m) * DATT + col;
#pragma unroll
                    for (int bj = 0; bj < 2; ++bj)
#pragma unroll
                        for (int n = 0; n < 2; ++n) *(f32x4*)(rp + bj * 128 + 4 * n) = acc[ai][bj][m][n]; }
        } else if (pn < 6) {
            const bool isk = pn >= 4;
            const float* gain = isk ? kgain : qgain;
            const int head = 4 * (pn & 1) + wc;
            f32x4 gn[2][2];
#pragma unroll
            for (int bj = 0; bj < 2; ++bj)
#pragma unroll
                for (int n = 0; n < 2; ++n) gn[bj][n] = *(const f32x4*)(gain + 32 * bj + 8 * fq + 4 * n);
#pragma unroll
            for (int ai = 0; ai < 2; ++ai)
#pragma unroll
                for (int m = 0; m < 4; ++m) {
                    float ss = 0.f;
#pragma unroll
                    for (int bj = 0; bj < 2; ++bj)
#pragma unroll
                        for (int n = 0; n < 2; ++n) { const f32x4 x = acc[ai][bj][m][n]; ss += (x[0] * x[0] + x[1] * x[1]) + (x[2] * x[2] + x[3] * x[3]); }
                    ss += __shfl_xor(ss, 16); ss += __shfl_xor(ss, 32);
                    const float rstd = 1.0f / sqrtf(ss * (1.0f / 64.0f) + EPS);
                    const int row = EPI_ROWS(ai, m);
#pragma unroll
                    for (int bj = 0; bj < 2; ++bj) {
                        const f32x4 a = acc[ai][bj][m][0] * rstd * gn[bj][0], b = acc[ai][bj][m][1] * rstd * gn[bj][1];
                        const int c = head * 64 + 32 * bj + 8 * fq;
                        u32x4 w; w.x = pkbf(a[0], a[1]); w.y = pkbf(a[2], a[3]); w.z = pkbf(b[0], b[1]); w.w = pkbf(b[2], b[3]);
                        if (!isk) *(u32x4*)(Q + (size_t)row * DATT + c) = w;
                        else {
                            const bool ctx = u.pm < 32; const int rl = row - u.pm * 256, tok = ctx ? rl : ((u.pm - 32) & 7) * 256 + rl;
                            const size_t tile = ctx ? (size_t)(u.pm * 8 + head) * 8 + (tok >> 5) : KV_LAT / 2048 + (size_t)(((u.pm - 32) >> 3) * 8 + head) * 64 + (tok >> 5);
                            *(u32x4*)(Kb + tile * 2048 + (2 * bj + (fq >> 1)) * 512 + (32 * (fq & 1) + (tok & 31)) * 8) = w; }
                        if (isk && u.pm < 32) { __builtin_nontemporal_store(a, (f32x4*)(outk + (size_t)row * DATT + c)); __builtin_nontemporal_store(b, (f32x4*)(outk + (size_t)row * DATT + c + 4)); }
                    }
                }
        } else if (pn < 8) {
            const bool ctx = u.pm < 32;
            LAS unsigned char* pad = scr + (wr * 4 + wc) * 1280;
            const int lane_ = fq * 16 + fr, d_ = lane_ & 31, hh_ = lane_ >> 5;
#pragma unroll
            for (int ai = 0; ai < 2; ++ai)
#pragma unroll
                for (int m = 0; m < 4; ++m) {
                    const int rl0 = ai * 128 + wr * 64 + m * 16, row = u.pm * 256 + rl0 + fr, tok0 = ctx ? rl0 : ((u.pm - 32) & 7) * 256 + rl0;
#pragma unroll
                    for (int bj = 0; bj < 2; ++bj) {
                        const int c = (pn - 6) * 256 + bj * 128 + wc * 32 + 8 * fq, head = c >> 6;
                        const f32x4 a = acc[ai][bj][m][0], b = acc[ai][bj][m][1];
                        u32x4 w; w.x = pkbf(a[0], a[1]); w.y = pkbf(a[2], a[3]); w.z = pkbf(b[0], b[1]); w.w = pkbf(b[2], b[3]);
                        *(LAS u32x4*)(pad + fr * 80 + fq * 16) = w;
                        if (ctx) { __builtin_nontemporal_store(a, (f32x4*)(outv + (size_t)row * DATT + c)); __builtin_nontemporal_store(b, (f32x4*)(outv + (size_t)row * DATT + c + 4)); }
                        unsigned short e[8];
#pragma unroll
                        for (int j = 0; j < 8; ++j) e[j] = *(const LAS unsigned short*)(pad + (8 * (j >> 2) + 4 * hh_ + (j & 3)) * 80 + d_ * 2);
                        u32x4 o; o.x = e[0] | ((unsigned)e[1] << 16); o.y = e[2] | ((unsigned)e[3] << 16); o.z = e[4] | ((unsigned)e[5] << 16); o.w = e[6] | ((unsigned)e[7] << 16);
                        const size_t tile = ctx ? (size_t)(u.pm * 8 + head) * 8 + (tok0 >> 5) : KV_LAT / 2048 + (size_t)(((u.pm - 32) >> 3) * 8 + head) * 64 + (tok0 >> 5);
                        *(u32x4*)(VT + tile * 2048 + ((wc & 1) * 2 + ((tok0 >> 4) & 1)) * 512 + lane_ * 8) = o;
                    }
                }
        } else {
            const int col = (pn - 8) * 256 + wc * 32 + 8 * fq;
#pragma unroll
            for (int ai = 0; ai < 2; ++ai)
#pragma unroll
                for (int m = 0; m < 4; ++m) { bf16_t* rp = Gt + (size_t)EPI_ROWS(ai, m) * 2048 + col;
#pragma unroll
                    for (int bj = 0; bj < 2; ++bj) { const f32x4 a = acc[ai][bj][m][0], b = acc[ai][bj][m][1];
                        u32x4 w; w.x = pkbf(fast_sigmoid(a[0]), fast_sigmoid(a[1])); w.y = pkbf(fast_sigmoid(a[2]), fast_sigmoid(a[3]));
                        w.z = pkbf(fast_sigmoid(b[0]), fast_sigmoid(b[1])); w.w = pkbf(fast_sigmoid(b[2]), fast_sigmoid(b[3]));
                        *(u32x4*)(rp + bj * 128) = w; }
                }
        }
    }
};
template <int MODE> struct EpiMix {
    static constexpr bool PERM = true, AFTER_DRAIN = false;
    unsigned char* ws; const float* vec;
    __device__ __forceinline__ void operator()(const f32x4 (&acc)[2][2][4][2], const pg8::Unit& u, int wr, int wc, int fr, int fq) const {
        bf16_t* O = (bf16_t*)(ws + (MODE == 0 ? WS_H + 16 * MiB : MODE == 1 ? WS_K : WS_P)); constexpr int ldo = MODE == 0 ? DATT : DM;
        const bf16_t* Gt = (const bf16_t*)(ws + WS_ACT); const bf16_t* T1 = (const bf16_t*)(ws + WS_K);
        const int col = u.pn * 256 + wc * 32 + 8 * fq;
        f32x4 sv[2][2];
        if (MODE == 0) {
#pragma unroll
            for (int bj = 0; bj < 2; ++bj)
#pragma unroll
                for (int n = 0; n < 2; ++n) sv[bj][n] = *(const f32x4*)(vec + col + bj * 128 + 4 * n);
        }
#pragma unroll
        for (int ai = 0; ai < 2; ++ai)
#pragma unroll
            for (int m = 0; m < 4; ++m) { const int row = EPI_ROWS(ai, m);
#pragma unroll
                for (int bj = 0; bj < 2; ++bj) {
                    f32x4 a = acc[ai][bj][m][0], b = acc[ai][bj][m][1];
                    const int c = col + bj * 128;
                    if (MODE == 0) { a = a * sv[bj][0]; b = b * sv[bj][1]; }
                    else {
                        const u32x4 gw = *(const u32x4*)(Gt + (size_t)row * 2048 + (MODE == 2 ? 1024 : 0) + c);
                        const f32x4 ga = {bflo(gw.x), bfhi(gw.x), bflo(gw.y), bfhi(gw.y)}, gb = {bflo(gw.z), bfhi(gw.z), bflo(gw.w), bfhi(gw.w)};
                        a = a * ga; b = b * gb;
                        if (MODE == 2) { const u32x4 tw = *(const u32x4*)(T1 + (size_t)row * DM + c);
                            a = a + (f32x4){bflo(tw.x), bfhi(tw.x), bflo(tw.y), bfhi(tw.y)}; b = b + (f32x4){bflo(tw.z), bfhi(tw.z), bflo(tw.w), bfhi(tw.w)}; }
                    }
                    u32x4 w; w.x = pkbf(a[0], a[1]); w.y = pkbf(a[2], a[3]); w.z = pkbf(b[0], b[1]); w.w = pkbf(b[2], b[3]);
                    *(u32x4*)(O + (size_t)row * ldo + c) = w;
                }
            }
    }
};

__device__ __forceinline__ unsigned f2bf(float f) { unsigned u = __builtin_bit_cast(unsigned, f); return (u + 0x7fffu + ((u >> 16) & 1u)) >> 16; }
__device__ __forceinline__ unsigned pk2(float lo, float hi) { return f2bf(lo) | (f2bf(hi) << 16); }
__device__ __forceinline__ int dest_row(int mode, int n) {
    if (mode == 1) { const int up = n >= DFF, j = up ? n - DFF : n; return 256 * (j >> 7) + (up ? 128 : 0) + (j & 127); }
    if (mode == 2) { if (n >= 512 && n < 1536) { const int tb = n & ~255, cc = n & 255, hh = cc >> 6, d = cc & 63; return tb + 128 * (d >> 5) + 32 * hh + (d & 31); } return n; }
    return n;
}
__device__ __forceinline__ void tr_item(const float* W, int N, bf16_t* WT, int ldt, int mode, LAS float* scr, int item, int lane) {
    const int nblk = N / 32, kb = item / nblk, nb = item % nblk, k0 = 64 * kb, n0 = 32 * nb;
#pragma unroll
    for (int i = 0; i < 32; ++i) { const int kk = 2 * i + (lane >> 5); scr[kk * 33 + (lane & 31)] = __builtin_nontemporal_load(W + (size_t)(k0 + kk) * N + n0 + (lane & 31)); }
    asm volatile("s_waitcnt lgkmcnt(0)" ::: "memory");
    const int c = lane & 7;
#pragma unroll
    for (int j = 0; j < 4; ++j) { const int n = (lane >> 3) + 8 * j; const LAS float* s = scr + (8 * c) * 33 + n;
        u32x4 o; o.x = pk2(s[0 * 33], s[1 * 33]); o.y = pk2(s[2 * 33], s[3 * 33]); o.z = pk2(s[4 * 33], s[5 * 33]); o.w = pk2(s[6 * 33], s[7 * 33]);
        *(u32x4*)(WT + (size_t)dest_row(mode, n0 + n) * ldt + k0 + 8 * c) = o; }
    asm volatile("s_waitcnt lgkmcnt(0)" ::: "memory");
}

struct Args { const float* in[24]; float* out; unsigned char* ws; int ph_lo, ph_hi; };
enum { I_XP = 0, I_XS, I_CK, I_CV, I_C, I_CCTX, I_WADA, I_BADA, I_GFF1, I_WFF1IN, I_WFF1OUT, I_GMIX, I_WIN, I_QG, I_KG, I_WPOOL, I_PSCALE, I_RPB, I_WBP, I_WBA, I_WOUT, I_GFF2, I_WFF2IN, I_WFF2OUT };

__device__ __forceinline__ void phase0(const Args& a, LAS unsigned char* lds, int tid, int lane, int wave, int G) {
    unsigned char* ws = a.ws;
    if ((int)blockIdx.x < 144) {
        LAS float* sc = (LAS float*)lds; LAS float* red = sc + 5 * 1024;
        for (int i = tid; i < 5 * 1024; i += 512) { const float v = i < 1024 ? a.in[I_CCTX][i] : a.in[I_C][i - 1024]; sc[i] = v * fast_sigmoid(v); }
        __syncthreads();
        float* mod = (float*)(ws + WS_MOD);
        for (int u = blockIdx.x; u < 144; u += G) {
            const int rsub = lane >> 4, c4 = (lane & 15) * 4;
            f32x4 acc[5];
#pragma unroll
            for (int c = 0; c < 5; ++c) acc[c] = (f32x4){0.f, 0.f, 0.f, 0.f};
            const float* wp = a.in[I_WADA] + (size_t)(wave * 128 + rsub) * (NMOD * DM) + u * 64 + c4;
            const LAS float* scw = sc + wave * 128 + rsub;
#pragma unroll 8
            for (int i = 0; i < 32; ++i) {
                const f32x4 wv = __builtin_nontemporal_load((const f32x4*)(wp + (size_t)(4 * i) * (NMOD * DM)));
#pragma unroll
                for (int c = 0; c < 5; ++c) acc[c] += wv * scw[c * 1024 + 4 * i];
            }
#pragma unroll
            for (int c = 0; c < 5; ++c)
#pragma unroll
                for (int j = 0; j < 4; ++j) { float v = acc[c][j]; v += __shfl_xor(v, 16); v += __shfl_xor(v, 32); acc[c][j] = v; }
            if (lane < 16) {
#pragma unroll
                for (int c = 0; c < 5; ++c) *(LAS f32x4*)(red + (wave * 5 + c) * 64 + c4) = acc[c]; }
            __syncthreads();
            if (tid < 320) { const int c = tid >> 6, l = tid & 63; float s = 0.f;
#pragma unroll
                for (int w = 0; w < 8; ++w) s += red[(w * 5 + c) * 64 + l];
                mod[c * (NMOD * DM) + u * 64 + l] = s + a.in[I_BADA][u * 64 + l]; }
            __syncthreads();
        }
    }
    LAS float* scr = (LAS float*)(lds + wave * 16384);
    constexpr int I_FIN = 16 * 176, I_IN = 16 * 128, I_FOUT = 44 * 32;
    constexpr int NITEMS = I_FIN + I_IN + I_FOUT;
    const bool bal = (G == 256); const int bx = blockIdx.x;
    if (bal && bx < 144) return;
    const int slot0 = bal ? (bx - 144) * 8 + wave : bx * 8 + wave, nslots = bal ? 112 * 8 : G * 8;
    for (int it = slot0; it < NITEMS; it += nslots) {
        int r = it;
        if (r < I_FIN) { tr_item(a.in[I_WFF1IN], 2 * DFF, (bf16_t*)(ws + WS_FF1IN), DM, 1, scr, r, lane); continue; } r -= I_FIN;
        if (r < I_IN) { tr_item(a.in[I_WIN], DIN, (bf16_t*)(ws + WS_WIN), DM, 2, scr, r, lane); continue; } r -= I_IN;
        tr_item(a.in[I_WFF1OUT], DM, (bf16_t*)(ws + WS_FF1OUT), DFF, 0, scr, r, lane);
    }
}

__device__ __forceinline__ void late_copies(const Args& a, LAS unsigned char* lds, int lane, int wave, int wi, int nw) {
    unsigned char* ws = a.ws;
    LAS float* scr = (LAS float*)(lds + wave * 16384);
    constexpr int I_FIN = 16 * 176, I_FOUT = 44 * 32, I_BR = 8 * 32, I_OUT = 16 * 32, I_FOLD = 4 * 8 * 16;
    constexpr int NITEMS = I_FIN + I_FOUT + I_BR + I_OUT + I_FOLD;
    for (int it = wi; it < NITEMS; it += nw) {
        int r = it;
        if (r < I_FIN) { tr_item(a.in[I_WFF2IN], 2 * DFF, (bf16_t*)(ws + WS_FF2IN), DM, 1, scr, r, lane); continue; } r -= I_FIN;
        if (r < I_FOUT) { tr_item(a.in[I_WFF2OUT], DM, (bf16_t*)(ws + WS_FF2OUT), DFF, 0, scr, r, lane); continue; } r -= I_FOUT;
        if (r < I_BR) { tr_item(a.in[I_WBA], DM, (bf16_t*)(ws + WS_WBA), DATT, 0, scr, r, lane); continue; } r -= I_BR;
        if (r < I_OUT) { tr_item(a.in[I_WOUT], DM, (bf16_t*)(ws + WS_WOUT), DM, 0, scr, r, lane); continue; } r -= I_OUT;
        {
            const int g = r >> 7, ib = (r >> 4) & 7, n = (r & 15) * 64 + lane;
            const float* wp = a.in[I_WPOOL] + (size_t)g * 128 * 128 + (size_t)(ib * 16) * 128; const float* ps = a.in[I_PSCALE] + g * 128; const float* wb = a.in[I_WBP] + (size_t)(g * 128) * DM + n;
#pragma unroll
            for (int q = 0; q < 8; ++q) { const int e4 = q * 64 + lane, i = e4 >> 5, j4 = (e4 & 31) * 4; const f32x4 w4 = *(const f32x4*)(wp + i * 128 + j4) * *(const f32x4*)(ps + j4); *(LAS f32x4*)(scr + i * 128 + j4) = w4; }
            asm volatile("s_waitcnt lgkmcnt(0)" ::: "memory");
            float acc[16];
#pragma unroll
            for (int i = 0; i < 16; ++i) acc[i] = 0.f;
#pragma unroll 2
            for (int j = 0; j < 128; j += 4) { const float w0 = __builtin_nontemporal_load(wb + (size_t)j * DM), w1 = __builtin_nontemporal_load(wb + (size_t)(j + 1) * DM), w2 = __builtin_nontemporal_load(wb + (size_t)(j + 2) * DM), w3 = __builtin_nontemporal_load(wb + (size_t)(j + 3) * DM);
#pragma unroll
                for (int i = 0; i < 16; ++i) { const f32x4 p4 = *(const LAS f32x4*)(scr + i * 128 + j); acc[i] += (p4[0] * w0 + p4[1] * w1) + (p4[2] * w2 + p4[3] * w3); } }
            asm volatile("s_waitcnt lgkmcnt(0)" ::: "memory");
            u32x4 o0, o1; o0.x = pk2(acc[0], acc[1]); o0.y = pk2(acc[2], acc[3]); o0.z = pk2(acc[4], acc[5]); o0.w = pk2(acc[6], acc[7]);
            o1.x = pk2(acc[8], acc[9]); o1.y = pk2(acc[10], acc[11]); o1.z = pk2(acc[12], acc[13]); o1.w = pk2(acc[14], acc[15]);
            bf16_t* dst = (bf16_t*)(ws + WS_WBP) + (size_t)n * DATT + g * 128 + ib * 16; *(u32x4*)dst = o0; *(u32x4*)(dst + 8) = o1;
        }
    }
    const int gt = wi * 64 + lane, NGT = nw * 64;
    for (int i = gt; i < 2 * 32 * 16 * 256; i += NGT) {
        const int isv = i >= 32 * 16 * 256, ch = isv ? i - 32 * 16 * 256 : i, ln = ch & 63, q4 = (ch >> 6) & 3, tile = (ch >> 8) & 15, bh = ch >> 12, b = bh >> 3, h = bh & 7, r32 = ln & 31, hh = ln >> 5;
        u32x4 o;
        if (!isv) { const float* src = a.in[I_CK] + ((size_t)(b * 512 + tile * 32 + r32) * 8 + h) * 64 + 16 * q4 + 8 * hh; const f32x4 v0 = __builtin_nontemporal_load((const f32x4*)src), v1 = __builtin_nontemporal_load((const f32x4*)(src + 4));
            o.x = pk2(v0[0], v0[1]); o.y = pk2(v0[2], v0[3]); o.z = pk2(v1[0], v1[1]); o.w = pk2(v1[2], v1[3]);
            *(u32x4*)((bf16_t*)(ws + WS_KC) + (size_t)ch * 8) = o; }
        else { const int t = q4 >> 1, sK = q4 & 1; float v[8];
#pragma unroll
            for (int j = 0; j < 8; ++j) { const int key = 16 * sK + 8 * (j >> 2) + 4 * hh + (j & 3); v[j] = __builtin_nontemporal_load(a.in[I_CV] + ((size_t)(b * 512 + tile * 32 + key) * 8 + h) * 64 + 32 * t + r32); }
            o.x = pk2(v[0], v[1]); o.y = pk2(v[2], v[3]); o.z = pk2(v[4], v[5]); o.w = pk2(v[6], v[7]);
            *(u32x4*)((bf16_t*)(ws + WS_VTC) + (size_t)ch * 8) = o; }
    }
}

__device__ __forceinline__ void norm_phase(const float* src0, const float* src1, const float* gvec, const float* mod, int mi, bf16_t* H, int G, int wave, int lane) {
    for (int rb = blockIdx.x; rb < NTOK / 64; rb += G) {
        const int rbase = rb * 64, cond = rbase < NCTX ? 0 : 1 + ((rbase - NCTX) >> 11);
        const float* sh = mod + (size_t)cond * (NMOD * DM) + mi * DM; const float* scl = sh + DM;
        f32x4 av[4], sv[4];
#pragma unroll
        for (int j = 0; j < 4; ++j) { const int c = 4 * lane + 256 * j; av[j] = *(const f32x4*)(gvec + c) * (*(const f32x4*)(scl + c) + 1.0f); sv[j] = *(const f32x4*)(sh + c); }
        for (int i0 = 0; i0 < 8; i0 += 4) {
            f32x4 v[4][4]; float s[4];
#pragma unroll
            for (int i = 0; i < 4; ++i) {
                const int row = rbase + wave * 8 + i0 + i;
                const float* xr = row < NCTX ? src0 + (size_t)row * DM : src1 + (size_t)(row - NCTX) * DM;
#pragma unroll
                for (int j = 0; j < 4; ++j) v[i][j] = *(const f32x4*)(xr + 4 * lane + 256 * j);
            }
#pragma unroll
            for (int i = 0; i < 4; ++i) { s[i] = 0.f;
#pragma unroll
                for (int j = 0; j < 4; ++j) s[i] += (v[i][j][0] * v[i][j][0] + v[i][j][1] * v[i][j][1]) + (v[i][j][2] * v[i][j][2] + v[i][j][3] * v[i][j][3]); }
#pragma unroll
            for (int o = 1; o < 64; o <<= 1) {
#pragma unroll
                for (int i = 0; i < 4; ++i) s[i] += __shfl_xor(s[i], o); }
#pragma unroll
            for (int i = 0; i < 4; ++i) {
                const int row = rbase + wave * 8 + i0 + i;
                const float rstd = 1.0f / sqrtf(s[i] * (1.0f / DM) + EPS);
#pragma unroll
                for (int j = 0; j < 4; ++j) { const f32x4 o = v[i][j] * rstd * av[j] + sv[j]; u32x2 w; w.x = pkbf(o[0], o[1]); w.y = pkbf(o[2], o[3]); *(u32x2*)(H + (size_t)row * DM + 4 * lane + 256 * j) = w; }
            }
        }
    }
}

__device__ __forceinline__ void bvec_items(const bf16_t* Bt, int N, const float* mod, int mi, float* out, int gw, int NGW, int lane) {
    float sh[5][16];
#pragma unroll
    for (int c = 0; c < 5; ++c)
#pragma unroll
        for (int q = 0; q < 4; ++q) { const f32x4 v = *(const f32x4*)(mod + (size_t)c * (NMOD * DM) + mi * DM + 16 * lane + 4 * q); sh[c][4 * q] = v[0]; sh[c][4 * q + 1] = v[1]; sh[c][4 * q + 2] = v[2]; sh[c][4 * q + 3] = v[3]; }
    for (int n = gw; n < N; n += NGW) {
        const u32x4 w0 = *(const u32x4*)(Bt + (size_t)n * DM + 16 * lane), w1 = *(const u32x4*)(Bt + (size_t)n * DM + 16 * lane + 8);
        const float w[16] = {bflo(w0.x), bfhi(w0.x), bflo(w0.y), bfhi(w0.y), bflo(w0.z), bfhi(w0.z), bflo(w0.w), bfhi(w0.w), bflo(w1.x), bfhi(w1.x), bflo(w1.y), bfhi(w1.y), bflo(w1.z), bfhi(w1.z), bflo(w1.w), bfhi(w1.w)};
        float acc[5];
#pragma unroll
        for (int c = 0; c < 5; ++c) { float a = 0.f;
#pragma unroll
            for (int k = 0; k < 16; ++k) a += sh[c][k] * w[k];
            acc[c] = a; }
#pragma unroll
        for (int o = 1; o < 64; o <<= 1) {
#pragma unroll
            for (int c = 0; c < 5; ++c) acc[c] += __shfl_xor(acc[c], o); }
        if (lane == 0) {
#pragma unroll
            for (int c = 0; c < 5; ++c) out[(size_t)c * N + n] = acc[c]; }
    }
}

__device__ __forceinline__ int crow(int r, int hh) { return (r & 3) + 8 * (r >> 2) + 4 * hh; }
#define MFMA32(a, b, c) __builtin_amdgcn_mfma_f32_32x32x16_bf16((a), (b), (c), 0, 0, 0)
struct KVFrag { bf16x8 k[4]; bf16x8 v[4]; };
__device__ __forceinline__ void kv_load(KVFrag& f, const bf16_t* kt, const bf16_t* vt, int lane) {
#pragma unroll
    for (int i = 0; i < 4; ++i) { f.k[i] = *(const bf16x8*)(kt + i * 512 + lane * 8); f.v[i] = *(const bf16x8*)(vt + i * 512 + lane * 8); }
}
struct AttnState { f32x16 o0, o1; float mrun, lrun; };
template <bool LOCAL, int FAR = 0> __device__ __forceinline__ void attn_tile(AttnState& st, const KVFrag& f, const bf16x8 (&qf)[4], const LAS float* bq, int okb) {
    constexpr float C2 = 0.125f * LOG2E;
    constexpr int R0 = FAR == 2 ? 12 : 0, R1 = FAR == 1 ? 4 : 16;
    f32x16 s;
#pragma unroll
    for (int r = 0; r < 16; ++r) s[r] = 0.f;
#pragma unroll
    for (int d0 = 0; d0 < 4; ++d0) s = MFMA32(f.k[d0], qf[d0], s);
    if (LOCAL) {
#pragma unroll
        for (int r = R0; r < R1; ++r) { const int cr = (r & 3) + 8 * (r >> 2); const bool ok = (unsigned)(okb + cr) < 16u; s[r] = ok ? __builtin_fmaf(s[r], C2, bq[cr]) : -1e30f; }
    }
    float mx = s[R0];
#pragma unroll
    for (int r = R0 + 1; r < R1; ++r) mx = fmaxf(mx, s[r]);
    if (!LOCAL) mx *= C2;
    mx = fmaxf(mx, __shfl_xor(mx, 32));
    const float mnew = fmaxf(st.mrun, mx);
    if (__builtin_amdgcn_ballot_w64(mnew > st.mrun) != 0ull) {
        const float alpha = __builtin_amdgcn_exp2f(st.mrun - mnew);
        st.lrun *= alpha;
#pragma unroll
        for (int r = 0; r < 16; ++r) { st.o0[r] *= alpha; st.o1[r] *= alpha; }
        st.mrun = mnew;
    }
    float ps = 0.f;
#pragma unroll
    for (int r = 0; r < 16; ++r) { if (r >= R0 && r < R1) { s[r] = __builtin_amdgcn_exp2f(LOCAL ? s[r] - mnew : __builtin_fmaf(s[r], C2, -mnew)); ps += s[r]; } else s[r] = 0.f; }
    st.lrun += ps;
    u32x4 p0, p1;
    p0.x = pkbf(s[0], s[1]); p0.y = pkbf(s[2], s[3]); p0.z = pkbf(s[4], s[5]); p0.w = pkbf(s[6], s[7]);
    p1.x = pkbf(s[8], s[9]); p1.y = pkbf(s[10], s[11]); p1.z = pkbf(s[12], s[13]); p1.w = pkbf(s[14], s[15]);
    const bf16x8 pb0 = __builtin_bit_cast(bf16x8, p0), pb1 = __builtin_bit_cast(bf16x8, p1);
    if (FAR != 2) { st.o0 = MFMA32(f.v[0], pb0, st.o0); st.o1 = MFMA32(f.v[2], pb0, st.o1); }
    if (FAR != 1) { st.o0 = MFMA32(f.v[1], pb1, st.o0); st.o1 = MFMA32(f.v[3], pb1, st.o1); }
}
__device__ __forceinline__ void attn_wave(const bf16_t* Qp, bf16_t* Op, int nd, const bf16_t* KFd, const bf16_t* VFd,
                                          int nl, const bf16_t* KFl, const bf16_t* VFl, int rq, int r0, int g, const LAS float* rpbh, int lane) {
    const int r32 = lane & 31, hh = lane >> 5;
    bf16x8 qf[4];
#pragma unroll
    for (int d0 = 0; d0 < 4; ++d0) qf[d0] = *(const bf16x8*)(Qp + (size_t)r32 * DATT + d0 * 16 + 8 * hh);
    AttnState st;
#pragma unroll
    for (int r = 0; r < 16; ++r) { st.o0[r] = 0.f; st.o1[r] = 0.f; }
    st.mrun = -1e30f; st.lrun = 0.f;
    const int nt = nd + nl;
    const int qc = 32 * g + r32; int c0 = qc - 8; c0 = c0 < 0 ? 0 : (c0 > 48 ? 48 : c0);
    KVFrag f0, f1, f2;
#define ATT_LOAD(f, ti) do { const int ti_ = (ti); if (ti_ < nt) { if (ti_ < nd) kv_load(f, KFd + (size_t)ti_ * 2048, VFd + (size_t)ti_ * 2048, lane); \
        else { const int tx_ = 2 * r0 + (ti_ - nd); kv_load(f, KFl + (size_t)tx_ * 2048, VFl + (size_t)tx_ * 2048, lane); } } } while (0)
#define ATT_TILE(f, ti) do { const int ti_ = (ti); if (ti_ < nt) { if (ti_ < nd) attn_tile<false, 0>(st, f, qf, nullptr, 0); \
        else { const int tl_ = ti_ - nd, kb_ = 32 * (tl_ & 1) + 4 * hh; const LAS float* bq_ = rpbh + (r0 + (tl_ >> 1) - rq + 7) * 31 + (kb_ - qc + 15); \
            if ((tl_ & 1) == g) attn_tile<true, 0>(st, f, qf, bq_, kb_ - c0); else if (g == 0) attn_tile<true, 1>(st, f, qf, bq_, kb_ - c0); else attn_tile<true, 2>(st, f, qf, bq_, kb_ - c0); } } } while (0)
    ATT_LOAD(f0, 0); ATT_LOAD(f1, 1);
    for (int ti = 0; ti < nt; ti += 3) {
        ATT_LOAD(f2, ti + 2); ATT_TILE(f0, ti);
        ATT_LOAD(f0, ti + 3); ATT_TILE(f1, ti + 1);
        ATT_LOAD(f1, ti + 4); ATT_TILE(f2, ti + 2);
    }
#undef ATT_LOAD
#undef ATT_TILE
    float lrun = st.lrun; lrun += __shfl_xor(lrun, 32);
    const float inv = 1.0f / lrun;
    bf16_t* op = Op + (size_t)r32 * DATT + 4 * hh;
#pragma unroll
    for (int rg = 0; rg < 4; ++rg) {
        u32x2 w; w.x = pkbf(st.o0[4 * rg] * inv, st.o0[4 * rg + 1] * inv); w.y = pkbf(st.o0[4 * rg + 2] * inv, st.o0[4 * rg + 3] * inv); *(u32x2*)(op + 8 * rg) = w;
        u32x2 x; x.x = pkbf(st.o1[4 * rg] * inv, st.o1[4 * rg + 1] * inv); x.y = pkbf(st.o1[4 * rg + 2] * inv, st.o1[4 * rg + 3] * inv); *(u32x2*)(op + 32 + 8 * rg) = x;
    }
}

template <int HW> __device__ __forceinline__ void dpass_item(const float* ps, bf16_t* ds, int t0, int L) {
    f32x2_t x[32 + 2 * HW];
#pragma unroll
    for (int j = 0; j < 32 + 2 * HW; ++j) { const int t = t0 - HW + j; const bool ok = t >= 0 && t < L; const f32x2_t v = *(const f32x2_t*)(ps + (size_t)(ok ? t : t0) * DATT); x[j] = ok ? v : (f32x2_t){0.f, 0.f}; }
    f32x2_t s = {0.f, 0.f};
#pragma unroll
    for (int j = 0; j < 2 * HW; ++j) s += x[j];
#pragma unroll
    for (int i = 0; i < 32; ++i) {
        const int t = t0 + i; const int lo = t - HW < 0 ? 0 : t - HW, hi = t + HW > L ? L : t + HW;
        const f32x2_t d = s * (1.0f / (float)(hi - lo)) - x[i + HW];
        *(unsigned*)(ds + (size_t)t * DATT) = pkbf(d[0], d[1]);
        if (i < 31) s += x[i + 2 * HW] - x[i];
    }
}

__device__ __forceinline__ void mixer_phase(const Args& a, LAS unsigned char* lds, int tid, int lane, int wave, int G, int what, int vb) {
    unsigned char* ws = a.ws;
    if (what & 1) {
    const bf16_t* Q = (const bf16_t*)(ws + WS_Q); const bf16_t* Kb = (const bf16_t*)(ws + WS_K); const bf16_t* VT = (const bf16_t*)(ws + WS_VT);
    const bf16_t* KC = (const bf16_t*)(ws + WS_KC); const bf16_t* VTC = (const bf16_t*)(ws + WS_VTC);
    bf16_t* ATT = (bf16_t*)(ws + WS_H);
    LAS float* rpbl = (LAS float*)(lds + 1024);
    for (int i = tid; i < 8 * 15 * 31; i += 512) rpbl[i] = a.in[I_RPB][i] * LOG2E;
    __syncthreads();
    for (int u = vb; u < 256; u += G) {
        {
            const int ul = (u & 7) * 32 + (u >> 3), bh = ul >> 3, b = bh >> 3, h = bh & 7, rq = 4 * (ul & 7) + (wave >> 1), g = wave & 1;
            int r0 = rq - 4; r0 = r0 < 0 ? 0 : (r0 > 24 ? 24 : r0);
            const size_t row0 = (size_t)NCTX + (size_t)b * 2048 + rq * 64 + 32 * g;
            attn_wave(Q + row0 * DATT + h * 64, ATT + row0 * DATT + h * 64, 16, KC + (size_t)bh * 16 * 2048, VTC + (size_t)bh * 16 * 2048,
                      16, Kb + KV_LAT + (size_t)bh * 64 * 2048, VT + KV_LAT + (size_t)bh * 64 * 2048, rq, r0, g, rpbl + h * 15 * 31, lane);
        }
        {
            const int b = u >> 3, h = u & 7;
            const size_t row0 = (size_t)b * 256 + 32 * wave;
            attn_wave(Q + row0 * DATT + h * 64, ATT + row0 * DATT + h * 64, 8, Kb + (size_t)u * 8 * 2048, VT + (size_t)u * 8 * 2048,
                      0, Kb, VT, 0, 0, 0, rpbl, lane);
        }
    }
    }
    if (!(what & 2)) return;
    const float* P = (const float*)(ws + WS_P); bf16_t* D = (bf16_t*)(ws + WS_ACT + 64 * MiB);
    const int gw = blockIdx.x * 8 + wave, NGW = G * 8;
    for (int it = gw; it < (NTOK / 32) * 4; it += NGW) {
        const int g = it & 3, row0 = (it >> 2) * 32;
        int t0, L; if (row0 < NCTX) { t0 = row0 & 255; L = 256; } else { t0 = (row0 - NCTX) & 2047; L = 2048; }
        const float* ps = P + (size_t)(row0 - t0) * DATT + g * 128 + 2 * lane; bf16_t* ds = D + (size_t)(row0 - t0) * DATT + g * 128 + 2 * lane;
        if (g == 0) dpass_item<1>(ps, ds, t0, L); else if (g == 1) dpass_item<2>(ps, ds, t0, L); else if (g == 2) dpass_item<4>(ps, ds, t0, L); else dpass_item<8>(ps, ds, t0, L);
    }
}


typedef unsigned v4u __attribute__((ext_vector_type(4)));
#define XB_TMO      128
#define XB_XCNT(j)  (256  + 64 * (j))
#define XB_XSUB(j)  (1280 + 64 * (j))
#define XB_XGEN(j)  (2304 + 64 * (j))
#define XB_TOP      3328
#define XB_TOPGEN   3392
#define XCD_BAR_WORDS 3456
#define XB_SPIN_CAP (1u << 18)

__device__ __forceinline__ unsigned xb_ld(unsigned* p)              { return __hip_atomic_load(p, __ATOMIC_RELAXED, __HIP_MEMORY_SCOPE_AGENT); }
__device__ __forceinline__ unsigned xb_add(unsigned* p, unsigned v) { return __hip_atomic_fetch_add(p, v, __ATOMIC_RELAXED, __HIP_MEMORY_SCOPE_AGENT); }
__device__ __forceinline__ unsigned xb_xcc_id() { return (unsigned)__builtin_amdgcn_s_getreg((3 << 11) | 20) & 0xFu; }
#define XB_SPIN(cond, bar) do { unsigned _sp = 0; while (cond) { __builtin_amdgcn_s_sleep(1); \
    if ((++_sp & 255u) == 0u) { if (xb_ld(&(bar)[XB_TMO])) break; if (_sp > XB_SPIN_CAP) { atomicAdd(&(bar)[XB_TMO], 1u); break; } } } } while (0)

struct XcdBarrier {
    unsigned* bar; unsigned x;
    volatile LAS unsigned* st;
};

__device__ __forceinline__ XcdBarrier xcd_barrier_post(unsigned* bar, volatile LAS unsigned* st) {
    XcdBarrier b; b.bar = bar; b.x = xb_xcc_id(); b.st = st;
    if (threadIdx.x == 0) st[2] = xb_add(&bar[XB_XCNT(b.x)], 1u);
    return b;
}
__device__ __forceinline__ void xcd_barrier_complete(unsigned* bar, unsigned x, unsigned& nloc, unsigned& nx) {
    const unsigned G = gridDim.x * gridDim.y * gridDim.z;
    unsigned sum, cnt, mine, sp = 0u;
    for (;;) {
        sum = 0u; cnt = 0u; mine = 0u;
#pragma unroll
        for (unsigned j = 0; j < 16; ++j) { const unsigned c = xb_ld(&bar[XB_XCNT(j)]); sum += c; cnt += (c > 0u) ? 1u : 0u; mine = (j == x) ? c : mine; }
        if (sum == G) break;
        __builtin_amdgcn_s_sleep(1);
        if ((++sp & 255u) == 0u) { if (xb_ld(&bar[XB_TMO])) break; if (sp > XB_SPIN_CAP) { atomicAdd(&bar[XB_TMO], 1u); break; } }
    }
    nloc = mine > 0u ? mine : 1u; nx = cnt > 0u ? cnt : 1u;
}

__device__ __forceinline__ void xcd_barrier(const XcdBarrier& b) {
    asm volatile("s_waitcnt vmcnt(0)" ::: "memory");
    __syncthreads();
    if (threadIdx.x == 0) {
        unsigned* bar = b.bar;
        __builtin_amdgcn_s_waitcnt(0);
        unsigned nloc = b.st[0], nx = b.st[1];
        if (nloc == 0u) { xcd_barrier_complete(bar, b.x, nloc, nx); b.st[0] = nloc; b.st[1] = nx; }
        const unsigned old = xb_add(&bar[XB_XSUB(b.x)], 1u);
        const unsigned gen = old / nloc;
        if (old + 1u == (gen + 1u) * nloc) {
            __builtin_amdgcn_fence(__ATOMIC_RELEASE, "agent");
            asm volatile("s_waitcnt vmcnt(0)" ::: "memory");
            const unsigned og = xb_add(&bar[XB_TOP], 1u);
            const unsigned tg = og / nx;
            if (og + 1u == (tg + 1u) * nx) xb_add(&bar[XB_TOPGEN], 1u);
            else XB_SPIN(xb_ld(&bar[XB_TOPGEN]) == tg, bar);
            __builtin_amdgcn_fence(__ATOMIC_ACQUIRE, "agent");
            xb_add(&bar[XB_XGEN(b.x)], 1u);
            asm volatile("s_waitcnt vmcnt(0)" ::: "memory");
        } else {
            XB_SPIN(xb_ld(&bar[XB_XGEN(b.x)]) == gen, bar);
            __builtin_amdgcn_fence(__ATOMIC_ACQUIRE, "agent");
            asm volatile("s_waitcnt vmcnt(0)" ::: "memory");
        }
    }
    __syncthreads();
}

#ifndef PROBE_DUP
#define PROBE_DUP -1
#endif
constexpr int LDS_BYTES = 147456;
__global__ void __launch_bounds__(512, 2) mk_fwd(Args args) {
    extern __shared__ __attribute__((aligned(16))) unsigned char lds_raw[];
    LAS unsigned char* lds = (LAS unsigned char*)lds_raw;
    cg::grid_group grid = cg::this_grid();
    const int tid = threadIdx.x, lane = tid & 63, wave = __builtin_amdgcn_readfirstlane(tid >> 6), G = gridDim.x;
    unsigned char* ws = args.ws;
    const int lo = args.ph_lo, hi = args.ph_hi;
    if (tid < 64) ((LAS unsigned*)(lds + 131072))[tid] = 0u;
    __syncthreads();
    XcdBarrier bar = xcd_barrier_post((unsigned*)(ws + WS_CTL), (volatile LAS unsigned*)(lds + 131072 + 64));
    if (hi > 1000) grid.sync();
    const float* mod = (const float*)(ws + WS_MOD);
    float* Y = args.out + OUT_Y;
    bf16_t* H = (bf16_t*)(ws + WS_H); bf16_t* ACT = (bf16_t*)(ws + WS_ACT);
#define IN(k) (lo <= (k) && (k) < hi)
#define SEAM(k) do { if (IN(k) && IN((k) + 1)) xcd_barrier(bar); } while (0)
#define GEMM_PHASE(EPI, e, Aptr, Bptr, N_, K_) do { pg8::Gemm g_{(const bf16_t*)(Aptr), (const bf16_t*)(Bptr), NTOK, (N_), (K_)}; pg8::StaticOrder S_; S_.init(NTOK, (N_), G, vb); \
        pg8::gemm_phase<EPI, pg8::StaticOrder, true, true>(lds, g_, S_, e); } while (0)

    float* SSb = (float*)(ws + WS_SS); float* BVIN = (float*)(ws + WS_BVIN); float* BVFF2 = (float*)(ws + WS_BVFF2);
    const int gwv = blockIdx.x * 8 + wave, NGWv = G * 8;
#define PHASE(k, ...) if (IN(k)) { __VA_ARGS__ if (PROBE_DUP == (k)) { xcd_barrier(bar); __VA_ARGS__ } }
    PHASE(0, { phase0(args, lds, tid, lane, wave, G); }) SEAM(0);
    int vb = blockIdx.x;
    if (IN(0) && IN(1)) {
        volatile LAS unsigned* stw = (volatile LAS unsigned*)(lds + 131072 + 64);
        if (tid == 0) { const unsigned* bw = (const unsigned*)(ws + WS_CTL); bool ok = (G % 8 == 0) && bar.x < 8u;
            for (int j = 0; j < 8; ++j) ok = ok && (xb_ld((unsigned*)&bw[XB_XCNT(j)]) == (unsigned)(G / 8));
            stw[3] = ok ? (stw[2] * 8u + bar.x) : (unsigned)blockIdx.x; }
        __syncthreads();
        vb = (int)stw[3];
    }
    vb = __builtin_amdgcn_readfirstlane(vb);
    PHASE(1, { norm_phase(args.in[I_XP], args.in[I_XS], args.in[I_GFF1], mod, 0, H, G, wave, lane);
               bvec_items((const bf16_t*)(ws + WS_WIN), DIN, mod, 3, BVIN, gwv, NGWv, lane); }) SEAM(1);
    PHASE(2, { EpiSwiGLU<false> e{ws, nullptr, 0}; GEMM_PHASE(EpiSwiGLU<false>, e, H, ws + WS_FF1IN, 2 * DFF, DM);
               if (G == 256) { if (vb >= 128) late_copies(args, lds, lane, wave, (vb - 128) * 8 + wave, 1024); } else late_copies(args, lds, lane, wave, vb * 8 + wave, G * 8); }) SEAM(2);
    PHASE(3, { typedef EpiResid<true, 2, 1, 3> E3; E3 e{args.in[I_XP], (long)(args.in[I_XS] - args.in[I_XP]) - (long)NCTX * DM, Y, ws, args.in[I_GMIX]}; GEMM_PHASE(E3, e, ACT, ws + WS_FF1OUT, DM, DFF); }) SEAM(3);
    PHASE(4, { LAS float* tbl = (LAS float*)(lds + 141824); { pg8::StaticOrder S_; S_.init(NTOK, DIN, G, vb); rstd_table(SSb, S_, tbl, 5, tid); }
               EpiWin e{ws, args.out + OUT_K, args.in[I_QG], args.in[I_KG], lds + 131072 + 512, tbl, 5};
               GEMM_PHASE(EpiWin, e, H, ws + WS_WIN, DIN, DM); }) SEAM(4);
    PHASE(5, { mixer_phase(args, lds, tid, lane, wave, G, 3, vb); bvec_items((const bf16_t*)(ws + WS_FF2IN), 2 * DFF, mod, 6, BVFF2, gwv, NGWv, lane); }) SEAM(5);
    PHASE(6, { { EpiMix<1> e{ws, nullptr}; GEMM_PHASE(EpiMix<1>, e, ws + WS_ACT + 64 * MiB, ws + WS_WBP, DM, DATT); }
               { EpiMix<2> e{ws, nullptr}; GEMM_PHASE(EpiMix<2>, e, H, ws + WS_WBA, DM, DATT); } }) SEAM(6);
    if (IN(7)) { typedef EpiResid<true, 5, 2, 6> E8; E8 e{Y, 0L, Y, ws, args.in[I_GFF2]}; GEMM_PHASE(E8, e, ws + WS_P, ws + WS_WOUT, DM, DM); } SEAM(7);
    PHASE(8, { LAS float* tbl = (LAS float*)(lds + 131072 + 512); { pg8::StaticOrder S_; S_.init(NTOK, 2 * DFF, G, vb); rstd_table(SSb, S_, tbl, 15, tid); }
               EpiSwiGLU<true> e{ws, tbl, 15}; GEMM_PHASE(EpiSwiGLU<true>, e, H, ws + WS_FF2IN, 2 * DFF, DM); }) SEAM(8);
    if (IN(9)) { typedef EpiResid<false, 8, 1, 0> E10; E10 e{Y, 0L, Y, ws, nullptr}; GEMM_PHASE(E10, e, ACT, ws + WS_FF2OUT, DM, DFF); }
}

#ifndef MK_PER_PHASE
#define MK_PER_PHASE 0
#endif
extern "C" void kernel_launch(void* const* d_in, const int* in_sizes, int n_in, void* d_out, int out_size, void* d_ws, size_t ws_size, hipStream_t stream) {
    static int grid = 0;
    if (grid == 0) {
        if (n_in != 24 || ws_size < WS_END) { fprintf(stderr, "kernel_launch: unexpected n_in %d / ws_size %zu (need %zu)\n", n_in, ws_size, (size_t)WS_END); grid = -1; return; }
        int dev = 0, cus = 0, per_cu = 0;
        hipGetDevice(&dev); hipDeviceGetAttribute(&cus, hipDeviceAttributeMultiprocessorCount, dev);
        if (hipFuncSetAttribute((const void*)mk_fwd, hipFuncAttributeMaxDynamicSharedMemorySize, LDS_BYTES) != hipSuccess) { fprintf(stderr, "kernel_launch: hipFuncSetAttribute failed\n"); grid = -1; return; }
        if (hipOccupancyMaxActiveBlocksPerMultiprocessor(&per_cu, (const void*)mk_fwd, 512, LDS_BYTES) != hipSuccess || per_cu < 1) { fprintf(stderr, "kernel_launch: occupancy query says %d\n", per_cu); per_cu = 1; }
        (void)hipGetLastError();
        grid = cus * per_cu;
        fprintf(stderr, "kernel_launch: grid %d (cus %d x %d), ws %zu\n", grid, cus, per_cu, ws_size);
    }
    if (grid < 0) return;
    if (hipMemsetAsync((char*)d_ws + WS_CTL, 0, CTL_BYTES, stream) != hipSuccess) { fprintf(stderr, "kernel_launch: memset failed\n"); return; }
    Args a{};
    for (int i = 0; i < 24; ++i) a.in[i] = (const float*)d_in[i];
    a.out = (float*)d_out; a.ws = (unsigned char*)d_ws;
#if MK_PER_PHASE
    for (int p = 0; p < 10; ++p) { a.ph_lo = p; a.ph_hi = p + 1; hipLaunchKernelGGL(mk_fwd, dim3(grid), dim3(512), LDS_BYTES, stream, a); }
#else
    a.ph_lo = 0; a.ph_hi = 10;
    void* kargs[] = {&a};
    hipError_t e = hipLaunchCooperativeKernel((const void*)mk_fwd, dim3(grid), dim3(512), kargs, LDS_BYTES, stream);
    if (e != hipSuccess) fprintf(stderr, "kernel_launch: cooperative launch failed: %s (grid %d)\n", hipGetErrorString(e), grid);
#endif
}
```

```cpp
#include <hip/hip_runtime.h>
#include <hip/hip_cooperative_groups.h>
#include <cstdio>
#include <cstdint>
namespace cg = cooperative_groups;
namespace pg8 {
#define PG8_LAS __attribute__((address_space(3)))
typedef unsigned short bf16_t;
typedef short bf16x8 __attribute__((ext_vector_type(8)));
typedef float f32x4 __attribute__((ext_vector_type(4)));
typedef unsigned u32x4 __attribute__((ext_vector_type(4)));
constexpr int BM = 256, BK = 64, HALF = 128, HTB = HALF * BK * 2  , STAGE_BYTES = 8 * HTB, NXCD = 8, WGM = 8;

__host__ __device__ __forceinline__ int lds_byte(int r, int c) { const int st = (r >> 4) * 2 + (c >> 5), rr = r & 15, cc = c & 31, ob = rr * 64 + cc * 2; return st * 1024 + (ob ^ (((ob >> 9) & 1) << 5)); }
__host__ __device__ __forceinline__ void stage_rc(int b, int& R, int& C) { const int st = b / 1024, sb = b % 1024, swz = sb ^ (((sb >> 9) & 1) << 5); R = (st >> 1) * 16 + swz / 64; C = (st & 1) * 32 + (swz % 64) / 2; }
__host__ __device__ __forceinline__ int perm32(int rho) { const int n = rho >> 4, i = rho & 15; return 8 * (i >> 2) + 4 * n + (i & 3); }

struct Unit { int pm, pn, ord; };
struct Gemm { const bf16_t* A; const bf16_t* Bt; int M, N, K; };

struct StaticOrder {
    int nM, nN, nwg, G, c;
    __host__ __device__ void init(int M, int N, int G_, int c_) { nM = M / BM; nN = N / BM; nwg = nM * nN; G = G_; c = c_; }
    __host__ __device__ bool next(int i, Unit& u) const {
        const long L = (long)i * G + c; if (L >= nwg) return false;
        int wgid = (int)L; { const int q = nwg / NXCD, r = nwg % NXCD, xcd = wgid % NXCD, off = wgid / NXCD; wgid = (xcd < r ? xcd * (q + 1) : r * (q + 1) + (xcd - r) * q) + off; }
        const int nig = WGM * nN, gid = wgid / nig, fm = gid * WGM, gsz = (nM - fm) < WGM ? (nM - fm) : WGM;
        u.pm = fm + ((wgid % nig) % gsz); u.pn = (wgid % nig) / gsz; u.ord = i; return true;
    }
    __device__ __forceinline__ void a_ready(const Unit&) const {}
    __device__ __forceinline__ void done(const Unit&) const {}
};

__device__ __forceinline__ unsigned cvt_pk_bf16(float lo, float hi) { unsigned r; asm volatile("v_cvt_pk_bf16_f32 %0, %1, %2" : "=v"(r) : "v"(lo), "v"(hi)); return r; }
template <class Epi, class Sched, bool ALIGN_EPI = false, bool SP2 = false>
__device__ __forceinline__ void gemm_phase(PG8_LAS unsigned char* lds, const Gemm g, const Sched S, const Epi E) {
    const int tid = threadIdx.x, wid = __builtin_amdgcn_readfirstlane(tid >> 6), lane = tid & 63, wr = wid >> 2, wc = wid & 3, fr = lane & 15, fq = lane >> 4;
    const int K = g.K, nt = K / BK;
    unsigned voffA[2], voffB[2];
#pragma unroll
    for (int i = 0; i < 2; ++i) { int R, C; stage_rc(tid * 16 + i * 8192, R, C); const int Rb = Epi::PERM ? ((R & ~31) + perm32(R & 31)) : R;
        voffA[i] = (unsigned)(R * K + C) * 2u; voffB[i] = (unsigned)(Rb * K + C) * 2u; }
    const size_t kstep = (size_t)(BK * 2);
    const size_t hstep = (size_t)HALF * K * 2;
    const size_t tstep = 2 * hstep;
    const unsigned ldsw = (unsigned)wid * 1024u;
    const int aoff = lds_byte(wr * 64 + fr, fq * 8), boff = lds_byte(wc * 32 + fr, fq * 8);
#define PG8_SA(b, h) (((b) * 2 + (h)) * HTB)
#define PG8_SB(b, h) ((4 + (b) * 2 + (h)) * HTB)
#define PG8_STAGE(bufoff, gbase, voff) do { _Pragma("unroll") for (int _i = 0; _i < 2; ++_i) \
        __builtin_amdgcn_global_load_lds((const unsigned*)((const char*)(gbase) + (voff)[_i]), (PG8_LAS unsigned*)(lds + (bufoff) + ldsw + _i * 8192), 16, 0, 0); } while (0)
#define PG8_LDA(dst, b, h) do { _Pragma("unroll") for (int m = 0; m < 4; ++m) _Pragma("unroll") for (int k = 0; k < 2; ++k) dst[m][k] = *(const PG8_LAS bf16x8*)(lds + PG8_SA(b, h) + aoff + m * 2048 + k * 1024); } while (0)
#define PG8_LDB(dst, b, h) do { _Pragma("unroll") for (int n = 0; n < 2; ++n) _Pragma("unroll") for (int k = 0; k < 2; ++k) dst[n][k] = *(const PG8_LAS bf16x8*)(lds + PG8_SB(b, h) + boff + n * 2048 + k * 1024); } while (0)
#define PG8_MMA(ai, bj, At, Bt) do { __builtin_amdgcn_s_setprio(1); _Pragma("unroll") for (int m = 0; m < 4; ++m) _Pragma("unroll") for (int n = 0; n < 2; ++n) _Pragma("unroll") for (int k = 0; k < 2; ++k) \
        acc[ai][bj][m][n] = __builtin_amdgcn_mfma_f32_16x16x32_bf16(Bt[n][k], At[m][k], acc[ai][bj][m][n], 0, 0, 0); __builtin_amdgcn_s_setprio(0); } while (0)
#define PG8_WAIT_V(n) asm volatile("s_waitcnt vmcnt(" #n ")" ::: "memory")
#define PG8_WAIT_L(n) asm volatile("s_waitcnt lgkmcnt(" #n ")" ::: "memory")
#define PG8_BAR __builtin_amdgcn_s_barrier()
#define PG8_SCHED __builtin_amdgcn_sched_barrier(0)
    Unit cur, nxt; int ui = 0;
    if (!S.next(0, cur)) return;
    f32x4 acc[2][2][4][2];
#pragma unroll
    for (int a = 0; a < 2; ++a)
#pragma unroll
        for (int b = 0; b < 2; ++b)
#pragma unroll
            for (int m = 0; m < 4; ++m)
#pragma unroll
                for (int n = 0; n < 2; ++n) acc[a][b][m][n] = (f32x4){0.f, 0.f, 0.f, 0.f};
    bf16x8 At[4][2], B0[2][2], B1[2][2];
    const char* cA = (const char*)g.A + (size_t)cur.pm * tstep; const char* cB = (const char*)g.Bt + (size_t)cur.pn * tstep;
    S.a_ready(cur);
    if constexpr (SP2) {
        PG8_STAGE(PG8_SB(0, 0), cB, voffB); PG8_STAGE(PG8_SB(0, 1), cB + hstep, voffB); PG8_STAGE(PG8_SA(0, 0), cA, voffA); PG8_STAGE(PG8_SA(0, 1), cA + hstep, voffA);
        if (wr == 1) PG8_BAR;
        PG8_WAIT_V(2); PG8_BAR;
        PG8_STAGE(PG8_SB(1, 0), cB + kstep, voffB); PG8_STAGE(PG8_SA(1, 0), cA + kstep, voffA); PG8_STAGE(PG8_SB(1, 1), cB + hstep + kstep, voffB);
        PG8_WAIT_V(6); PG8_BAR;
    } else {
        PG8_STAGE(PG8_SB(0, 0), cB, voffB); PG8_STAGE(PG8_SA(0, 0), cA, voffA); PG8_STAGE(PG8_SB(0, 1), cB + hstep, voffB); PG8_STAGE(PG8_SA(0, 1), cA + hstep, voffA);
        if (wr == 1) PG8_BAR;
        PG8_WAIT_V(4); PG8_BAR;
        PG8_STAGE(PG8_SB(1, 0), cB + kstep, voffB); PG8_STAGE(PG8_SA(1, 0), cA + kstep, voffA); PG8_STAGE(PG8_SB(1, 1), cB + hstep + kstep, voffB);
        PG8_WAIT_V(6); PG8_BAR;
    }
    for (;;) {
        const bool has_next = S.next(ui + 1, nxt);
        const char* nA = has_next ? (const char*)g.A + (size_t)nxt.pm * tstep : cA; const char* nB = has_next ? (const char*)g.Bt + (size_t)nxt.pn * tstep : cB;
        for (int t = 0; t < nt; t += 2) {
            const bool last = (t == nt - 2);
            const char* a1 = cA + (size_t)(t + 1) * kstep;
            const char* a2 = last ? nA : cA + (size_t)(t + 2) * kstep; const char* b2 = last ? nB : cB + (size_t)(t + 2) * kstep;
            const char* a3 = a2 + kstep; const char* b3 = b2 + kstep;
            if (last && has_next) S.a_ready(nxt);
            if constexpr (SP2) {
            PG8_LDB(B0, 0, 0); PG8_LDB(B1, 0, 1); PG8_SCHED; PG8_LDA(At, 0, 0); PG8_STAGE(PG8_SA(1, 1), a1 + hstep, voffA);
            PG8_WAIT_V(8); PG8_WAIT_L(0); PG8_BAR; PG8_MMA(0, 0, At, B0); PG8_MMA(0, 1, At, B1); PG8_BAR; PG8_SCHED;
            PG8_LDA(At, 0, 1); PG8_STAGE(PG8_SB(0, 0), b2, voffB); PG8_STAGE(PG8_SB(0, 1), b2 + hstep, voffB); PG8_STAGE(PG8_SA(0, 0), a2, voffA);
            PG8_WAIT_V(8); PG8_WAIT_L(0); PG8_BAR; PG8_MMA(1, 0, At, B0); PG8_MMA(1, 1, At, B1); PG8_BAR; PG8_SCHED;
            PG8_LDB(B0, 1, 0); PG8_LDB(B1, 1, 1); PG8_SCHED; PG8_LDA(At, 1, 0); PG8_STAGE(PG8_SA(0, 1), a2 + hstep, voffA);
            PG8_WAIT_V(8); PG8_WAIT_L(0); PG8_BAR; PG8_MMA(0, 0, At, B0); PG8_MMA(0, 1, At, B1); PG8_BAR; PG8_SCHED;
            PG8_LDA(At, 1, 1); PG8_STAGE(PG8_SB(1, 0), b3, voffB); PG8_STAGE(PG8_SB(1, 1), b3 + hstep, voffB); PG8_STAGE(PG8_SA(1, 0), a3, voffA);
            PG8_WAIT_V(8); PG8_WAIT_L(0); PG8_BAR; PG8_MMA(1, 0, At, B0); PG8_MMA(1, 1, At, B1); PG8_BAR; PG8_SCHED;
            } else {
            PG8_LDB(B0, 0, 0); PG8_SCHED; PG8_LDA(At, 0, 0); PG8_STAGE(PG8_SA(1, 1), a1 + hstep, voffA);
            PG8_WAIT_L(8); PG8_BAR; PG8_WAIT_L(0); PG8_MMA(0, 0, At, B0); PG8_BAR; PG8_SCHED;
            PG8_LDB(B1, 0, 1); PG8_STAGE(PG8_SB(0, 0), b2, voffB);
            PG8_BAR; PG8_WAIT_L(0); PG8_MMA(0, 1, At, B1); PG8_BAR;
            PG8_LDA(At, 0, 1); PG8_STAGE(PG8_SA(0, 0), a2, voffA);
            PG8_BAR; PG8_WAIT_L(0); PG8_MMA(1, 0, At, B0); PG8_BAR; PG8_SCHED;
            PG8_STAGE(PG8_SB(0, 1), b2 + hstep, voffB);
            PG8_WAIT_V(6); PG8_BAR; PG8_MMA(1, 1, At, B1); PG8_BAR;
            PG8_LDB(B0, 1, 0); PG8_SCHED; PG8_LDA(At, 1, 0); PG8_STAGE(PG8_SA(0, 1), a2 + hstep, voffA);
            PG8_WAIT_L(8); PG8_BAR; PG8_WAIT_L(0); PG8_MMA(0, 0, At, B0); PG8_BAR; PG8_SCHED;
            PG8_LDB(B1, 1, 1); PG8_STAGE(PG8_SB(1, 0), b3, voffB);
            PG8_BAR; PG8_WAIT_L(0); PG8_MMA(0, 1, At, B1); PG8_BAR;
            PG8_LDA(At, 1, 1); PG8_STAGE(PG8_SA(1, 0), a3, voffA);
            PG8_BAR; PG8_WAIT_L(0); PG8_MMA(1, 0, At, B0); PG8_BAR; PG8_SCHED;
            PG8_STAGE(PG8_SB(1, 1), b3 + hstep, voffB);
            PG8_WAIT_V(6); PG8_BAR; PG8_MMA(1, 1, At, B1); PG8_BAR;
            }
        }
        if constexpr (ALIGN_EPI) { if (wr == 0) PG8_BAR; }
        if constexpr (!Epi::AFTER_DRAIN) { E(acc, cur, wr, wc, fr, fq); S.done(cur); }
        if (!has_next) break;
#pragma unroll
        for (int a = 0; a < 2; ++a)
#pragma unroll
            for (int b = 0; b < 2; ++b)
#pragma unroll
                for (int m = 0; m < 4; ++m)
#pragma unroll
                    for (int n = 0; n < 2; ++n) acc[a][b][m][n] = (f32x4){0.f, 0.f, 0.f, 0.f};
        cur = nxt; cA = nA; cB = nB; ++ui;
        if constexpr (ALIGN_EPI) { if (wr == 1) PG8_BAR; }
    }
    PG8_WAIT_V(0);
    if constexpr (!ALIGN_EPI) { if (wr == 0) PG8_BAR; }
    PG8_BAR;
    if constexpr (Epi::AFTER_DRAIN) { E.fused(acc, cur, wr, wc, fr, fq, lds, wid, lane); S.done(cur); }
#undef PG8_SA
#undef PG8_SB
#undef PG8_STAGE
#undef PG8_LDA
#undef PG8_LDB
#undef PG8_MMA
#undef PG8_WAIT_V
#undef PG8_WAIT_L
#undef PG8_BAR
#undef PG8_SCHED
}
}

#define LAS __attribute__((address_space(3)))
using pg8::bf16_t; using pg8::bf16x8; using pg8::f32x4; using pg8::u32x4;
typedef float f32x16 __attribute__((ext_vector_type(16)));
typedef float f32x2_t __attribute__((ext_vector_type(2)));
typedef __bf16 bf16x2_t __attribute__((ext_vector_type(2)));
typedef unsigned u32x2 __attribute__((ext_vector_type(2)));

constexpr int DM = 1024, NTOK = 16384, NCTX = 8192, DFF = 2816, DATT = 512, DIN = 4096, NMOD = 9;
constexpr float EPS = 1e-6f, LOG2E = 1.4426950408889634f;
constexpr size_t MiB = 1u << 20;
constexpr size_t WS_FF1IN = 0, WS_FF1OUT = 11 * MiB, WS_FF2IN = 17 * MiB, WS_FF2OUT = 28 * MiB, WS_WIN = 34 * MiB, WS_WBP = 42 * MiB, WS_WBA = 43 * MiB, WS_WOUT = 44 * MiB,
                 WS_WPOOL = 46 * MiB, WS_MOD = 47 * MiB, WS_KC = 48 * MiB, WS_VTC = 50 * MiB;
constexpr size_t WS_H = 52 * MiB;
constexpr size_t WS_ACT = 84 * MiB;
constexpr size_t WS_P = 172 * MiB;
constexpr size_t WS_Q = 204 * MiB;
constexpr size_t WS_K = 220 * MiB;
constexpr size_t WS_VT = 236 * MiB;
constexpr size_t WS_CTL = 252 * MiB, CTL_BYTES = 16384;
constexpr size_t WS_SS = 253 * MiB;
constexpr size_t WS_BVIN = 47 * MiB + 512 * 1024, WS_BVFF2 = WS_BVIN + 128 * 1024;
constexpr size_t WS_END = 254 * MiB;
static_assert(WS_END <= 256 * MiB, "d_ws map");
constexpr size_t KV_LAT = (size_t)32 * 8 * 8 * 2048;
constexpr size_t OUT_Y = 0, OUT_K = (size_t)NTOK * DM, OUT_V = OUT_K + (size_t)NCTX * DATT;

__device__ __forceinline__ unsigned pkbf(float lo, float hi) { f32x2_t v = {lo, hi}; bf16x2_t b = __builtin_convertvector(v, bf16x2_t); return __builtin_bit_cast(unsigned, b); }
__device__ __forceinline__ float bflo(unsigned w) { return __uint_as_float(w << 16); }
__device__ __forceinline__ float bfhi(unsigned w) { return __uint_as_float(w & 0xffff0000u); }
__device__ __forceinline__ float fast_sigmoid(float x) { return __builtin_amdgcn_rcpf(1.0f + __builtin_amdgcn_exp2f(-x * LOG2E)); }
__device__ __forceinline__ float wave_sum(float v) {
#pragma unroll
    for (int o = 1; o < 64; o <<= 1) v += __shfl_xor(v, o);
    return v;
}
__device__ __forceinline__ int cond_of_pm(int pm) { return pm < 32 ? 0 : 1 + ((pm - 32) >> 3); }

__device__ __forceinline__ float row_sumsq(const float* SS, int row, int fq) {
    const f32x4 a = *(const f32x4*)(SS + (size_t)row * 16 + 4 * fq); float s = (a[0] + a[1]) + (a[2] + a[3]);
    s += __shfl_xor(s, 16); s += __shfl_xor(s, 32); return s;
}
__device__ __forceinline__ float rstd_of(float sumsq) { return 1.0f / sqrtf(sumsq * (1.0f / DM) + EPS); }

__device__ __forceinline__ void rstd_table(const float* SS, const pg8::StaticOrder& S, LAS float* tbl, int nmax, int tid) {
    pg8::Unit u;
    for (int i = 0; i < nmax && S.next(i, u); ++i)
        if (tid < 256) { const f32x4* p = (const f32x4*)(SS + (size_t)(u.pm * 256 + tid) * 16); const f32x4 a = (p[0] + p[1]) + (p[2] + p[3]); tbl[i * 256 + tid] = rstd_of(((a[0] + a[1]) + (a[2] + a[3]))); }
    __syncthreads();
}

#define EPI_ROWS(ai, m) (u.pm * 256 + (ai) * 128 + wr * 64 + (m) * 16 + fr)

template <bool NORMED> struct EpiSwiGLU {
    static constexpr bool PERM = true, AFTER_DRAIN = false;
    unsigned char* ws; const LAS float* tbl; int nmax;
    __device__ __forceinline__ void operator()(const f32x4 (&acc)[2][2][4][2], const pg8::Unit& u, int wr, int wc, int fr, int fq) const {
        bf16_t* O = (bf16_t*)(ws + WS_ACT); const float* bvec = (const float*)(ws + WS_BVFF2); const float* SS = (const float*)(ws + WS_SS);
        const int col = u.pn * 128 + wc * 32 + 8 * fq;
        f32x4 bv[2][2];
        if (NORMED) { const float* bp = bvec + (size_t)cond_of_pm(u.pm) * (2 * DFF) + u.pn * 256 + wc * 32 + 8 * fq;
#pragma unroll
            for (int bj = 0; bj < 2; ++bj)
#pragma unroll
                for (int n = 0; n < 2; ++n) bv[bj][n] = *(const f32x4*)(bp + bj * 128 + 4 * n); }
#pragma unroll
        for (int ai = 0; ai < 2; ++ai)
#pragma unroll
            for (int m = 0; m < 4; ++m) {
                const int row = EPI_ROWS(ai, m);
                const float rs = NORMED ? (u.ord < nmax ? tbl[u.ord * 256 + ai * 128 + wr * 64 + m * 16 + fr] : rstd_of(row_sumsq(SS, row, fq))) : 1.f;
                float v[8];
#pragma unroll
                for (int n = 0; n < 2; ++n)
#pragma unroll
                    for (int j = 0; j < 4; ++j) { float g = acc[ai][0][m][n][j], up = acc[ai][1][m][n][j]; if (NORMED) { g = g * rs + bv[0][n][j]; up = up * rs + bv[1][n][j]; } v[4 * n + j] = g * fast_sigmoid(g) * up; }
                u32x4 w; w.x = pkbf(v[0], v[1]); w.y = pkbf(v[2], v[3]); w.z = pkbf(v[4], v[5]); w.w = pkbf(v[6], v[7]);
                *(u32x4*)(O + (size_t)row * DFF + col) = w;
            }
    }
};
template <bool NEXT, int GI, int COEF2, int MNEXT> struct EpiResid {
    static constexpr bool PERM = true, AFTER_DRAIN = false;
    const float* base0; long d1;
    float* out; unsigned char* ws; const float* gnext;
    __device__ __forceinline__ void operator()(const f32x4 (&acc)[2][2][4][2], const pg8::Unit& u, int wr, int wc, int fr, int fq) const {
        constexpr int gi = GI, mnext = MNEXT; constexpr float coef = 0.5f * COEF2;
        bf16_t* XA = (bf16_t*)(ws + WS_H); float* SS = (float*)(ws + WS_SS);
        const float* mc = (const float*)(ws + WS_MOD) + (size_t)cond_of_pm(u.pm) * (NMOD * DM);
        const float* gv = mc + gi * DM;
        const float* base = base0 + (u.pm < 32 ? 0L : d1);
        const int col = u.pn * 256 + wc * 32 + 8 * fq;
        f32x4 g[2][2], an[2][2];
#pragma unroll
        for (int bj = 0; bj < 2; ++bj)
#pragma unroll
            for (int n = 0; n < 2; ++n) { g[bj][n] = *(const f32x4*)(gv + col + bj * 128 + 4 * n) * coef;
                if (NEXT) an[bj][n] = *(const f32x4*)(gnext + col + bj * 128 + 4 * n) * (*(const f32x4*)(mc + (mnext + 1) * DM + col + bj * 128 + 4 * n) + 1.0f); }
#pragma unroll
        for (int ai = 0; ai < 2; ++ai)
#pragma unroll
            for (int m = 0; m < 4; ++m) { const int row = EPI_ROWS(ai, m); const size_t off = (size_t)row * DM + col; float ss = 0.f;
#pragma unroll
                for (int bj = 0; bj < 2; ++bj) { f32x4 o[2];
#pragma unroll
                    for (int n = 0; n < 2; ++n) { const f32x4 b = *(const f32x4*)(base + off + bj * 128 + 4 * n); o[n] = b + g[bj][n] * acc[ai][bj][m][n]; if (NEXT) *(f32x4*)(out + off + bj * 128 + 4 * n) = o[n]; else __builtin_nontemporal_store(o[n], (f32x4*)(out + off + bj * 128 + 4 * n));
                        if (NEXT) ss += (o[n][0] * o[n][0] + o[n][1] * o[n][1]) + (o[n][2] * o[n][2] + o[n][3] * o[n][3]); }
                    if (NEXT) { const f32x4 xa = o[0] * an[bj][0], xb = o[1] * an[bj][1]; u32x4 w; w.x = pkbf(xa[0], xa[1]); w.y = pkbf(xa[2], xa[3]); w.z = pkbf(xb[0], xb[1]); w.w = pkbf(xb[2], xb[3]);
                        *(u32x4*)(XA + off + bj * 128) = w; }
                }
                if (NEXT) { ss += __shfl_xor(ss, 16); ss += __shfl_xor(ss, 32); if (fq == 0) SS[(size_t)row * 16 + u.pn * 4 + wc] = ss; }
            }
    }
};
struct EpiWin {
    static constexpr bool PERM = true, AFTER_DRAIN = false;
    unsigned char* ws; float* outk; const float* qgain; const float* kgain; LAS unsigned char* scr; const LAS float* tbl; int nmax;
    __device__ __forceinline__ void operator()(const f32x4 (&accr)[2][2][4][2], const pg8::Unit& u, int wr, int wc, int fr, int fq) const {
        const int pn = u.pn;
        float* P = (float*)(ws + WS_P); bf16_t* Q = (bf16_t*)(ws + WS_Q); bf16_t* Kb = (bf16_t*)(ws + WS_K); bf16_t* VT = (bf16_t*)(ws + WS_VT); bf16_t* Gt = (bf16_t*)(ws + WS_ACT);
        float* outv = outk + (size_t)NCTX * DATT; const float* bvec = (const float*)(ws + WS_BVIN);
        f32x4 (&acc)[2][2][4][2] = const_cast<f32x4 (&)[2][2][4][2]>(accr);
        { const float* bp = bvec + (size_t)cond_of_pm(u.pm) * DIN + pn * 256 + wc * 32 + 8 * fq; f32x4 bv[2][2];
#pragma unroll
            for (int bj = 0; bj < 2; ++bj)
#pragma unroll
                for (int n = 0; n < 2; ++n) bv[bj][n] = *(const f32x4*)(bp + bj * 128 + 4 * n);
#pragma unroll
            for (int ai = 0; ai < 2; ++ai)
#pragma unroll
                for (int m = 0; m < 4; ++m) { const float rs = u.ord < nmax ? tbl[u.ord * 256 + ai * 128 + wr * 64 + m * 16 + fr] : rstd_of(row_sumsq((const float*)(ws + WS_SS), EPI_ROWS(ai, m), fq));
#pragma unroll
                    for (int bj = 0; bj < 2; ++bj)
#pragma unroll
                        for (int n = 0; n < 2; ++n) acc[ai][bj][m][n] = accr[ai][bj][m][n] * rs + bv[bj][n]; } }

        if (pn < 2) {
            const int col = pn * 256 + wc * 32 + 8 * fq;
#pragma unroll
            for (int ai = 0; ai < 2; ++ai)
#pragma unroll
                for (int m = 0; m < 4; ++m) { float* rp = P + (size_t)EPI_ROWS(ai, m) * DATT + col;
#pragma unroll
                    for (int bj = 0; bj < 2; ++bj)
#pragma unroll
                        for (int n = 0; n < 2; ++n) *(f32x4*)(rp + bj * 128 + 4 * n) = acc[ai][bj][m][n]; }
        } else if (pn < 6) {
            const bool isk = pn >= 4;
            const float* gain = isk ? kgain : qgain;
            const int head = 4 * (pn & 1) + wc;
            f32x4 gn[2][2];
#pragma unroll
            for (int bj = 0; bj < 2; ++bj)
#pragma unroll
                for (int n = 0; n < 2; ++n) gn[bj][n] = *(const f32x4*)(gain + 32 * bj + 8 * fq + 4 * n);
#pragma unroll
            for (int ai = 0; ai < 2; ++ai)
#pragma unroll
                for (int m = 0; m < 4; ++m) {
                    float ss = 0.f;
#pragma unroll
                    for (int bj = 0; bj < 2; ++bj)
#pragma unroll
                        for (int n = 0; n < 2; ++n) { const f32x4 x = acc[ai][bj][m][n]; ss += (x[0] * x[0] + x[1] * x[1]) + (x[2] * x[2] + x[3] * x[3]); }
                    ss += __shfl_xor(ss, 16); ss += __shfl_xor(ss, 32);
                    const float rstd = 1.0f / sqrtf(ss * (1.0f / 64.0f) + EPS);
                    const int row = EPI_ROWS(ai, m);
#pragma unroll
                    for (int bj = 0; bj < 2; ++bj) {
                        const f32x4 a = acc[ai][bj][m][0] * rstd * gn[bj][0], b = acc[ai][bj][m][1] * rstd * gn[bj][1];
                        const int c = head * 64 + 32 * bj + 8 * fq;
                        u32x4 w; w.x = pkbf(a[0], a[1]); w.y = pkbf(a[2], a[3]); w.z = pkbf(b[0], b[1]); w.w = pkbf(b[2], b[3]);
                        if (!isk) *(u32x4*)(Q + (size_t)row * DATT + c) = w;
                        else {
                            const bool ctx = u.pm < 32; const int rl = row - u.pm * 256, tok = ctx ? rl : ((u.pm - 32) & 7) * 256 + rl;
                            const size_t tile = ctx ? (size_t)(u.pm * 8 + head) * 8 + (tok >> 5) : KV_LAT / 2048 + (size_t)(((u.pm - 32) >> 3) * 8 + head) * 64 + (tok >> 5);
                            *(u32x4*)(Kb + tile * 2048 + (2 * bj + (fq >> 1)) * 512 + (32 * (fq & 1) + (tok & 31)) * 8) = w; }
                        if (isk && u.pm < 32) { __builtin_nontemporal_store(a, (f32x4*)(outk + (size_t)row * DATT + c)); __builtin_nontemporal_store(b, (f32x4*)(outk + (size_t)row * DATT + c + 4)); }
                    }
                }
        } else if (pn < 8) {
            const bool ctx = u.pm < 32;
            LAS unsigned char* pad = scr + (wr * 4 + wc) * 1280;
            const int lane_ = fq * 16 + fr, d_ = lane_ & 31, hh_ = lane_ >> 5;
#pragma unroll
            for (int ai = 0; ai < 2; ++ai)
#pragma unroll
                for (int m = 0; m < 4; ++m) {
                    const int rl0 = ai * 128 + wr * 64 + m * 16, row = u.pm * 256 + rl0 + fr, tok0 = ctx ? rl0 : ((u.pm - 32) & 7) * 256 + rl0;
#pragma unroll
                    for (int bj = 0; bj < 2; ++bj) {
                        const int c = (pn - 6) * 256 + bj * 128 + wc * 32 + 8 * fq, head = c >> 6;
                        const f32x4 a = acc[ai][bj][m][0], b = acc[ai][bj][m][1];
                        u32x4 w; w.x = pkbf(a[0], a[1]); w.y = pkbf(a[2], a[3]); w.z = pkbf(b[0], b[1]); w.w = pkbf(b[2], b[3]);
                        *(LAS u32x4*)(pad + fr * 80 + fq * 16) = w;
                        if (ctx) { __builtin_nontemporal_store(a, (f32x4*)(outv + (size_t)row * DATT + c)); __builtin_nontemporal_store(b, (f32x4*)(outv + (size_t)row * DATT + c + 4)); }
                        unsigned short e[8];
#pragma unroll
                        for (int j = 0; j < 8; ++j) e[j] = *(const LAS unsigned short*)(pad + (8 * (j >> 2) + 4 * hh_ + (j & 3)) * 80 + d_ * 2);
                        u32x4 o; o.x = e[0] | ((unsigned)e[1] << 16); o.y = e[2] | ((unsigned)e[3] << 16); o.z = e[4] | ((unsigned)e[5] << 16); o.w = e[6] | ((unsigned)e[7] << 16);
                        const size_t tile = ctx ? (size_t)(u.pm * 8 + head) * 8 + (tok0 >> 5) : KV_LAT / 2048 + (size_t)(((u.pm - 32) >> 3) * 8 + head) * 64 + (tok0 >> 5);
                        *(u32x4*)(VT + tile * 2048 + ((wc & 1) * 2 + ((tok0 >> 4) & 1)) * 512 + lane_ * 8) = o;
                    }
                }
        } else {
            const int col = (pn - 8) * 256 + wc * 32 + 8 * fq;
#pragma unroll
            for (int ai = 0; ai < 2; ++ai)
#pragma unroll
                for (int m = 0; m < 4; ++m) { bf16_t* rp = Gt + (size_t)EPI_ROWS(ai, m) * 2048 + col;
#pragma unroll
                    for (int bj = 0; bj < 2; ++bj) { const f32x4 a = acc[ai][bj][m][0], b = acc[ai][bj][m][1];
                        u32x4 w; w.x = pkbf(fast_sigmoid(a[0]), fast_sigmoid(a[1])); w.y = pkbf(fast_sigmoid(a[2]), fast_sigmoid(a[3]));
                        w.z = pkbf(fast_sigmoid(b[0]), fast_sigmoid(b[1])); w.w = pkbf(fast_sigmoid(b[2]), fast_sigmoid(b[3]));
                        *(u32x4*)(rp + bj * 128) = w; }
                }
        }
    }
};
template <int MODE> struct EpiMix {
    static constexpr bool PERM = true, AFTER_DRAIN = false;
    unsigned char* ws; const float* vec;
    __device__ __forceinline__ void operator()(const f32x4 (&acc)[2][2][4][2], const pg8::Unit& u, int wr, int wc, int fr, int fq) const {
        bf16_t* O = (bf16_t*)(ws + (MODE == 0 ? WS_H + 16 * MiB : MODE == 1 ? WS_K : WS_P)); constexpr int ldo = MODE == 0 ? DATT : DM;
        const bf16_t* Gt = (const bf16_t*)(ws + WS_ACT); const bf16_t* T1 = (const bf16_t*)(ws + WS_K);
        const int col = u.pn * 256 + wc * 32 + 8 * fq;
        f32x4 sv[2][2];
        if (MODE == 0) {
#pragma unroll
            for (int bj = 0; bj < 2; ++bj)
#pragma unroll
                for (int n = 0; n < 2; ++n) sv[bj][n] = *(const f32x4*)(vec + col + bj * 128 + 4 * n);
        }
#pragma unroll
        for (int ai = 0; ai < 2; ++ai)
#pragma unroll
            for (int m = 0; m < 4; ++m) { const int row = EPI_ROWS(ai, m);
#pragma unroll
                for (int bj = 0; bj < 2; ++bj) {
                    f32x4 a = acc[ai][bj][m][0], b = acc[ai][bj][m][1];
                    const int c = col + bj * 128;
                    if (MODE == 0) { a = a * sv[bj][0]; b = b * sv[bj][1]; }
                    else {
                        const u32x4 gw = *(const u32x4*)(Gt + (size_t)row * 2048 + (MODE == 2 ? 1024 : 0) + c);
                        const f32x4 ga = {bflo(gw.x), bfhi(gw.x), bflo(gw.y), bfhi(gw.y)}, gb = {bflo(gw.z), bfhi(gw.z), bflo(gw.w), bfhi(gw.w)};
                        a = a * ga; b = b * gb;
                        if (MODE == 2) { const u32x4 tw = *(const u32x4*)(T1 + (size_t)row * DM + c);
                            a = a + (f32x4){bflo(tw.x), bfhi(tw.x), bflo(tw.y), bfhi(tw.y)}; b = b + (f32x4){bflo(tw.z), bfhi(tw.z), bflo(tw.w), bfhi(tw.w)}; }
                    }
                    u32x4 w; w.x = pkbf(a[0], a[1]); w.y = pkbf(a[2], a[3]); w.z = pkbf(b[0], b[1]); w.w = pkbf(b[2], b[3]);
                    *(u32x4*)(O + (size_t)row * ldo + c) = w;
                }
            }
    }
};

__device__ __forceinline__ unsigned f2bf(float f) { unsigned u = __builtin_bit_cast(unsigned, f); return (u + 0x7fffu + ((u >> 16) & 1u)) >> 16; }
__device__ __forceinline__ unsigned pk2(float lo, float hi) { return f2bf(lo) | (f2bf(hi) << 16); }
__device__ __forceinline__ int dest_row(int mode, int n) {
    if (mode == 1) { const int up = n >= DFF, j = up ? n - DFF : n; return 256 * (j >> 7) + (up ? 128 : 0) + (j & 127); }
    if (mode == 2) { if (n >= 512 && n < 1536) { const int tb = n & ~255, cc = n & 255, hh = cc >> 6, d = cc & 63; return tb + 128 * (d >> 5) + 32 * hh + (d & 31); } return n; }
    return n;
}
__device__ __forceinline__ void tr_item(const float* W, int N, bf16_t* WT, int ldt, int mode, LAS float* scr, int item, int lane) {
    const int nblk = N / 32, kb = item / nblk, nb = item % nblk, k0 = 64 * kb, n0 = 32 * nb;
#pragma unroll
    for (int i = 0; i < 32; ++i) { const int kk = 2 * i + (lane >> 5); scr[kk * 33 + (lane & 31)] = __builtin_nontemporal_load(W + (size_t)(k0 + kk) * N + n0 + (lane & 31)); }
    asm volatile("s_waitcnt lgkmcnt(0)" ::: "memory");
    const int c = lane & 7;
#pragma unroll
    for (int j = 0; j < 4; ++j) { const int n = (lane >> 3) + 8 * j; const LAS float* s = scr + (8 * c) * 33 + n;
        u32x4 o; o.x = pk2(s[0 * 33], s[1 * 33]); o.y = pk2(s[2 * 33], s[3 * 33]); o.z = pk2(s[4 * 33], s[5 * 33]); o.w = pk2(s[6 * 33], s[7 * 33]);
        *(u32x4*)(WT + (size_t)dest_row(mode, n0 + n) * ldt + k0 + 8 * c) = o; }
    asm volatile("s_waitcnt lgkmcnt(0)" ::: "memory");
}

struct Args { const float* in[24]; float* out; unsigned char* ws; int ph_lo, ph_hi; };
enum { I_XP = 0, I_XS, I_CK, I_CV, I_C, I_CCTX, I_WADA, I_BADA, I_GFF1, I_WFF1IN, I_WFF1OUT, I_GMIX, I_WIN, I_QG, I_KG, I_WPOOL, I_PSCALE, I_RPB, I_WBP, I_WBA, I_WOUT, I_GFF2, I_WFF2IN, I_WFF2OUT };

__device__ __forceinline__ void phase0(const Args& a, LAS unsigned char* lds, int tid, int lane, int wave, int G) {
    unsigned char* ws = a.ws;
    if ((int)blockIdx.x < 144) {
        LAS float* sc = (LAS float*)lds; LAS float* red = sc + 5 * 1024;
        for (int i = tid; i < 5 * 1024; i += 512) { const float v = i < 1024 ? a.in[I_CCTX][i] : a.in[I_C][i - 1024]; sc[i] = v * fast_sigmoid(v); }
        __syncthreads();
        float* mod = (float*)(ws + WS_MOD);
        for (int u = blockIdx.x; u < 144; u += G) {
            const int rsub = lane >> 4, c4 = (lane & 15) * 4;
            f32x4 acc[5];
#pragma unroll
            for (int c = 0; c < 5; ++c) acc[c] = (f32x4){0.f, 0.f, 0.f, 0.f};
            const float* wp = a.in[I_WADA] + (size_t)(wave * 128 + rsub) * (NMOD * DM) + u * 64 + c4;
            const LAS float* scw = sc + wave * 128 + rsub;
#pragma unroll 8
            for (int i = 0; i < 32; ++i) {
                const f32x4 wv = __builtin_nontemporal_load((const f32x4*)(wp + (size_t)(4 * i) * (NMOD * DM)));
#pragma unroll
                for (int c = 0; c < 5; ++c) acc[c] += wv * scw[c * 1024 + 4 * i];
            }
#pragma unroll
            for (int c = 0; c < 5; ++c)
#pragma unroll
                for (int j = 0; j < 4; ++j) { float v = acc[c][j]; v += __shfl_xor(v, 16); v += __shfl_xor(v, 32); acc[c][j] = v; }
            if (lane < 16) {
#pragma unroll
                for (int c = 0; c < 5; ++c) *(LAS f32x4*)(red + (wave * 5 + c) * 64 + c4) = acc[c]; }
            __syncthreads();
            if (tid < 320) { const int c = tid >> 6, l = tid & 63; float s = 0.f;
#pragma unroll
                for (int w = 0; w < 8; ++w) s += red[(w * 5 + c) * 64 + l];
                mod[c * (NMOD * DM) + u * 64 + l] = s + a.in[I_BADA][u * 64 + l]; }
            __syncthreads();
        }
    }
    LAS float* scr = (LAS float*)(lds + wave * 16384);
    constexpr int I_FIN = 16 * 176, I_IN = 16 * 128, I_FOUT = 44 * 32;
    constexpr int NITEMS = I_FIN + I_IN + I_FOUT;
    const bool bal = (G == 256); const int bx = blockIdx.x;
    if (bal && bx < 144) return;
    const int slot0 = bal ? (bx - 144) * 8 + wave : bx * 8 + wave, nslots = bal ? 112 * 8 : G * 8;
    for (int it = slot0; it < NITEMS; it += nslots) {
        int r = it;
        if (r < I_FIN) { tr_item(a.in[I_WFF1IN], 2 * DFF, (bf16_t*)(ws + WS_FF1IN), DM, 1, scr, r, lane); continue; } r -= I_FIN;
        if (r < I_IN) { tr_item(a.in[I_WIN], DIN, (bf16_t*)(ws + WS_WIN), DM, 2, scr, r, lane); continue; } r -= I_IN;
        tr_item(a.in[I_WFF1OUT], DM, (bf16_t*)(ws + WS_FF1OUT), DFF, 0, scr, r, lane);
    }
}

__device__ __forceinline__ void late_copies(const Args& a, LAS unsigned char* lds, int lane, int wave, int wi, int nw) {
    unsigned char* ws = a.ws;
    LAS float* scr = (LAS float*)(lds + wave * 16384);
    constexpr int I_FIN = 16 * 176, I_FOUT = 44 * 32, I_BR = 8 * 32, I_OUT = 16 * 32, I_FOLD = 4 * 8 * 16;
    constexpr int NITEMS = I_FIN + I_FOUT + I_BR + I_OUT + I_FOLD;
    for (int it = wi; it < NITEMS; it += nw) {
        int r = it;
        if (r < I_FIN) { tr_item(a.in[I_WFF2IN], 2 * DFF, (bf16_t*)(ws + WS_FF2IN), DM, 1, scr, r, lane); continue; } r -= I_FIN;
        if (r < I_FOUT) { tr_item(a.in[I_WFF2OUT], DM, (bf16_t*)(ws + WS_FF2OUT), DFF, 0, scr, r, lane); continue; } r -= I_FOUT;
        if (r < I_BR) { tr_item(a.in[I_WBA], DM, (bf16_t*)(ws + WS_WBA), DATT, 0, scr, r, lane); continue; } r -= I_BR;
        if (r < I_OUT) { tr_item(a.in[I_WOUT], DM, (bf16_t*)(ws + WS_WOUT), DM, 0, scr, r, lane); continue; } r -= I_OUT;
        {
            const int g = r >> 7, ib = (r >> 4) & 7, n = (r & 15) * 64 + lane;
            const float* wp = a.in[I_WPOOL] + (size_t)g * 128 * 128 + (size_t)(ib * 16) * 128; const float* ps = a.in[I_PSCALE] + g * 128; const float* wb = a.in[I_WBP] + (size_t)(g * 128) * DM + n;
#pragma unroll
            for (int q = 0; q < 8; ++q) { const int e4 = q * 64 + lane, i = e4 >> 5, j4 = (e4 & 31) * 4; const f32x4 w4 = *(const f32x4*)(wp + i * 128 + j4) * *(const f32x4*)(ps + j4); *(LAS f32x4*)(scr + i * 128 + j4) = w4; }
            asm volatile("s_waitcnt lgkmcnt(0)" ::: "memory");
            float acc[16];
#pragma unroll
            for (int i = 0; i < 16; ++i) acc[i] = 0.f;
#pragma unroll 2
            for (int j = 0; j < 128; j += 4) { const float w0 = __builtin_nontemporal_load(wb + (size_t)j * DM), w1 = __builtin_nontemporal_load(wb + (size_t)(j + 1) * DM), w2 = __builtin_nontemporal_load(wb + (size_t)(j + 2) * DM), w3 = __builtin_nontemporal_load(wb + (size_t)(j + 3) * DM);
#pragma unroll
                for (int i = 0; i < 16; ++i) { const f32x4 p4 = *(const LAS f32x4*)(scr + i * 128 + j); acc[i] += (p4[0] * w0 + p4[1] * w1) + (p4[2] * w2 + p4[3] * w3); } }
            asm volatile("s_waitcnt lgkmcnt(0)" ::: "memory");
            u32x4 o0, o1; o0.x = pk2(acc[0], acc[1]); o0.y = pk2(acc[2], acc[3]); o0.z = pk2(acc[4], acc[5]); o0.w = pk2(acc[6], acc[7]);
            o1.x = pk2(acc[8], acc[9]); o1.y = pk2(acc[10], acc[11]); o1.z = pk2(acc[12], acc[13]); o1.w = pk2(acc[14], acc[15]);
            bf16_t* dst = (bf16_t*)(ws + WS_WBP) + (size_t)n * DATT + g * 128 + ib * 16; *(u32x4*)dst = o0; *(u32x4*)(dst + 8) = o1;
        }
    }
    const int gt = wi * 64 + lane, NGT = nw * 64;
    for (int i = gt; i < 2 * 32 * 16 * 256; i += NGT) {
        const int isv = i >= 32 * 16 * 256, ch = isv ? i - 32 * 16 * 256 : i, ln = ch & 63, q4 = (ch >> 6) & 3, tile = (ch >> 8) & 15, bh = ch >> 12, b = bh >> 3, h = bh & 7, r32 = ln & 31, hh = ln >> 5;
        u32x4 o;
        if (!isv) { const float* src = a.in[I_CK] + ((size_t)(b * 512 + tile * 32 + r32) * 8 + h) * 64 + 16 * q4 + 8 * hh; const f32x4 v0 = __builtin_nontemporal_load((const f32x4*)src), v1 = __builtin_nontemporal_load((const f32x4*)(src + 4));
            o.x = pk2(v0[0], v0[1]); o.y = pk2(v0[2], v0[3]); o.z = pk2(v1[0], v1[1]); o.w = pk2(v1[2], v1[3]);
            *(u32x4*)((bf16_t*)(ws + WS_KC) + (size_t)ch * 8) = o; }
        else { const int t = q4 >> 1, sK = q4 & 1; float v[8];
#pragma unroll
            for (int j = 0; j < 8; ++j) { const int key = 16 * sK + 8 * (j >> 2) + 4 * hh + (j & 3); v[j] = __builtin_nontemporal_load(a.in[I_CV] + ((size_t)(b * 512 + tile * 32 + key) * 8 + h) * 64 + 32 * t + r32); }
            o.x = pk2(v[0], v[1]); o.y = pk2(v[2], v[3]); o.z = pk2(v[4], v[5]); o.w = pk2(v[6], v[7]);
            *(u32x4*)((bf16_t*)(ws + WS_VTC) + (size_t)ch * 8) = o; }
    }
}

__device__ __forceinline__ void norm_phase(const float* src0, const float* src1, const float* gvec, const float* mod, int mi, bf16_t* H, int G, int wave, int lane) {
    for (int rb = blockIdx.x; rb < NTOK / 64; rb += G) {
        const int rbase = rb * 64, cond = rbase < NCTX ? 0 : 1 + ((rbase - NCTX) >> 11);
        const float* sh = mod + (size_t)cond * (NMOD * DM) + mi * DM; const float* scl = sh + DM;
        f32x4 av[4], sv[4];
#pragma unroll
        for (int j = 0; j < 4; ++j) { const int c = 4 * lane + 256 * j; av[j] = *(const f32x4*)(gvec + c) * (*(const f32x4*)(scl + c) + 1.0f); sv[j] = *(const f32x4*)(sh + c); }
        for (int i0 = 0; i0 < 8; i0 += 4) {
            f32x4 v[4][4]; float s[4];
#pragma unroll
            for (int i = 0; i < 4; ++i) {
                const int row = rbase + wave * 8 + i0 + i;
                const float* xr = row < NCTX ? src0 + (size_t)row * DM : src1 + (size_t)(row - NCTX) * DM;
#pragma unroll
                for (int j = 0; j < 4; ++j) v[i][j] = __builtin_nontemporal_load((const f32x4*)(xr + 4 * lane + 256 * j));
            }
#pragma unroll
            for (int i = 0; i < 4; ++i) { s[i] = 0.f;
#pragma unroll
                for (int j = 0; j < 4; ++j) s[i] += (v[i][j][0] * v[i][j][0] + v[i][j][1] * v[i][j][1]) + (v[i][j][2] * v[i][j][2] + v[i][j][3] * v[i][j][3]); }
#pragma unroll
            for (int o = 1; o < 64; o <<= 1) {
#pragma unroll
                for (int i = 0; i < 4; ++i) s[i] += __shfl_xor(s[i], o); }
#pragma unroll
            for (int i = 0; i < 4; ++i) {
                const int row = rbase + wave * 8 + i0 + i;
                const float rstd = 1.0f / sqrtf(s[i] * (1.0f / DM) + EPS);
#pragma unroll
                for (int j = 0; j < 4; ++j) { const f32x4 o = v[i][j] * rstd * av[j] + sv[j]; u32x2 w; w.x = pkbf(o[0], o[1]); w.y = pkbf(o[2], o[3]); *(u32x2*)(H + (size_t)row * DM + 4 * lane + 256 * j) = w; }
            }
        }
    }
}

__device__ __forceinline__ void bvec_items(const bf16_t* Bt, int N, const float* mod, int mi, float* out, int gw, int NGW, int lane) {
    float sh[5][16];
#pragma unroll
    for (int c = 0; c < 5; ++c)
#pragma unroll
        for (int q = 0; q < 4; ++q) { const f32x4 v = *(const f32x4*)(mod + (size_t)c * (NMOD * DM) + mi * DM + 16 * lane + 4 * q); sh[c][4 * q] = v[0]; sh[c][4 * q + 1] = v[1]; sh[c][4 * q + 2] = v[2]; sh[c][4 * q + 3] = v[3]; }
    for (int n = gw; n < N; n += NGW) {
        const u32x4 w0 = *(const u32x4*)(Bt + (size_t)n * DM + 16 * lane), w1 = *(const u32x4*)(Bt + (size_t)n * DM + 16 * lane + 8);
        const float w[16] = {bflo(w0.x), bfhi(w0.x), bflo(w0.y), bfhi(w0.y), bflo(w0.z), bfhi(w0.z), bflo(w0.w), bfhi(w0.w), bflo(w1.x), bfhi(w1.x), bflo(w1.y), bfhi(w1.y), bflo(w1.z), bfhi(w1.z), bflo(w1.w), bfhi(w1.w)};
        float acc[5];
#pragma unroll
        for (int c = 0; c < 5; ++c) { float a = 0.f;
#pragma unroll
            for (int k = 0; k < 16; ++k) a += sh[c][k] * w[k];
            acc[c] = a; }
#pragma unroll
        for (int o = 1; o < 64; o <<= 1) {
#pragma unroll
            for (int c = 0; c < 5; ++c) acc[c] += __shfl_xor(acc[c], o); }
        if (lane == 0) {
#pragma unroll
            for (int c = 0; c < 5; ++c) out[(size_t)c * N + n] = acc[c]; }
    }
}

__device__ __forceinline__ int crow(int r, int hh) { return (r & 3) + 8 * (r >> 2) + 4 * hh; }
#define MFMA32(a, b, c) __builtin_amdgcn_mfma_f32_32x32x16_bf16((a), (b), (c), 0, 0, 0)
struct KVFrag { bf16x8 k[4]; bf16x8 v[4]; };
__device__ __forceinline__ void kv_load(KVFrag& f, const bf16_t* kt, const bf16_t* vt, int lane) {
#pragma unroll
    for (int i = 0; i < 4; ++i) { f.k[i] = *(const bf16x8*)(kt + i * 512 + lane * 8); f.v[i] = *(const bf16x8*)(vt + i * 512 + lane * 8); }
}
struct AttnState { f32x16 o0, o1; float mrun, lrun; };
template <bool LOCAL, int FAR = 0> __device__ __forceinline__ void attn_tile(AttnState& st, const KVFrag& f, const bf16x8 (&qf)[4], const LAS float* bq, int okb) {
    constexpr float C2 = 0.125f * LOG2E;
    constexpr int R0 = FAR == 2 ? 12 : 0, R1 = FAR == 1 ? 4 : 16;
    f32x16 s;
#pragma unroll
    for (int r = 0; r < 16; ++r) s[r] = 0.f;
#pragma unroll
    for (int d0 = 0; d0 < 4; ++d0) s = MFMA32(f.k[d0], qf[d0], s);
    if (LOCAL) {
#pragma unroll
        for (int r = R0; r < R1; ++r) { const int cr = (r & 3) + 8 * (r >> 2); const bool ok = (unsigned)(okb + cr) < 16u; s[r] = ok ? __builtin_fmaf(s[r], C2, bq[cr]) : -1e30f; }
    }
    float mx = s[R0];
#pragma unroll
    for (int r = R0 + 1; r < R1; ++r) mx = fmaxf(mx, s[r]);
    if (!LOCAL) mx *= C2;
    mx = fmaxf(mx, __shfl_xor(mx, 32));
    const float mnew = fmaxf(st.mrun, mx);
    if (__builtin_amdgcn_ballot_w64(mnew > st.mrun) != 0ull) {
        const float alpha = __builtin_amdgcn_exp2f(st.mrun - mnew);
        st.lrun *= alpha;
#pragma unroll
        for (int r = 0; r < 16; ++r) { st.o0[r] *= alpha; st.o1[r] *= alpha; }
        st.mrun = mnew;
    }
    float ps = 0.f;
#pragma unroll
    for (int r = 0; r < 16; ++r) { if (r >= R0 && r < R1) { s[r] = __builtin_amdgcn_exp2f(LOCAL ? s[r] - mnew : __builtin_fmaf(s[r], C2, -mnew)); ps += s[r]; } else s[r] = 0.f; }
    st.lrun += ps;
    u32x4 p0, p1;
    p0.x = pkbf(s[0], s[1]); p0.y = pkbf(s[2], s[3]); p0.z = pkbf(s[4], s[5]); p0.w = pkbf(s[6], s[7]);
    p1.x = pkbf(s[8], s[9]); p1.y = pkbf(s[10], s[11]); p1.z = pkbf(s[12], s[13]); p1.w = pkbf(s[14], s[15]);
    const bf16x8 pb0 = __builtin_bit_cast(bf16x8, p0), pb1 = __builtin_bit_cast(bf16x8, p1);
    if (FAR != 2) { st.o0 = MFMA32(f.v[0], pb0, st.o0); st.o1 = MFMA32(f.v[2], pb0, st.o1); }
    if (FAR != 1) { st.o0 = MFMA32(f.v[1], pb1, st.o0); st.o1 = MFMA32(f.v[3], pb1, st.o1); }
}
__device__ __forceinline__ void attn_wave(const bf16_t* Qp, bf16_t* Op, int nd, const bf16_t* KFd, const bf16_t* VFd,
                                          int nl, const bf16_t* KFl, const bf16_t* VFl, int rq, int r0, int g, const LAS float* rpbh, int lane) {
    const int r32 = lane & 31, hh = lane >> 5;
    bf16x8 qf[4];
#pragma unroll
    for (int d0 = 0; d0 < 4; ++d0) qf[d0] = *(const bf16x8*)(Qp + (size_t)r32 * DATT + d0 * 16 + 8 * hh);
    AttnState st;
#pragma unroll
    for (int r = 0; r < 16; ++r) { st.o0[r] = 0.f; st.o1[r] = 0.f; }
    st.mrun = -1e30f; st.lrun = 0.f;
    const int nt = nd + nl;
    const int qc = 32 * g + r32; int c0 = qc - 8; c0 = c0 < 0 ? 0 : (c0 > 48 ? 48 : c0);
    KVFrag f0, f1, f2;
#define ATT_LOAD(f, ti) do { const int ti_ = (ti); if (ti_ < nt) { if (ti_ < nd) kv_load(f, KFd + (size_t)ti_ * 2048, VFd + (size_t)ti_ * 2048, lane); \
        else { const int tx_ = 2 * r0 + (ti_ - nd); kv_load(f, KFl + (size_t)tx_ * 2048, VFl + (size_t)tx_ * 2048, lane); } } } while (0)
#define ATT_TILE(f, ti) do { const int ti_ = (ti); if (ti_ < nt) { if (ti_ < nd) attn_tile<false, 0>(st, f, qf, nullptr, 0); \
        else { const int tl_ = ti_ - nd, kb_ = 32 * (tl_ & 1) + 4 * hh; const LAS float* bq_ = rpbh + (r0 + (tl_ >> 1) - rq + 7) * 31 + (kb_ - qc + 15); \
            if ((tl_ & 1) == g) attn_tile<true, 0>(st, f, qf, bq_, kb_ - c0); else if (g == 0) attn_tile<true, 1>(st, f, qf, bq_, kb_ - c0); else attn_tile<true, 2>(st, f, qf, bq_, kb_ - c0); } } } while (0)
    ATT_LOAD(f0, 0); ATT_LOAD(f1, 1);
    for (int ti = 0; ti < nt; ti += 3) {
        ATT_LOAD(f2, ti + 2); ATT_TILE(f0, ti);
        ATT_LOAD(f0, ti + 3); ATT_TILE(f1, ti + 1);
        ATT_LOAD(f1, ti + 4); ATT_TILE(f2, ti + 2);
    }
#undef ATT_LOAD
#undef ATT_TILE
    float lrun = st.lrun; lrun += __shfl_xor(lrun, 32);
    const float inv = 1.0f / lrun;
    bf16_t* op = Op + (size_t)r32 * DATT + 4 * hh;
#pragma unroll
    for (int rg = 0; rg < 4; ++rg) {
        u32x2 w; w.x = pkbf(st.o0[4 * rg] * inv, st.o0[4 * rg + 1] * inv); w.y = pkbf(st.o0[4 * rg + 2] * inv, st.o0[4 * rg + 3] * inv); *(u32x2*)(op + 8 * rg) = w;
        u32x2 x; x.x = pkbf(st.o1[4 * rg] * inv, st.o1[4 * rg + 1] * inv); x.y = pkbf(st.o1[4 * rg + 2] * inv, st.o1[4 * rg + 3] * inv); *(u32x2*)(op + 32 + 8 * rg) = x;
    }
}

template <int HW> __device__ __forceinline__ void dpass_item(const float* ps, bf16_t* ds, int t0, int L) {
    f32x2_t x[32 + 2 * HW];
#pragma unroll
    for (int j = 0; j < 32 + 2 * HW; ++j) { const int t = t0 - HW + j; const bool ok = t >= 0 && t < L; const f32x2_t v = *(const f32x2_t*)(ps + (size_t)(ok ? t : t0) * DATT); x[j] = ok ? v : (f32x2_t){0.f, 0.f}; }
    f32x2_t s = {0.f, 0.f};
#pragma unroll
    for (int j = 0; j < 2 * HW; ++j) s += x[j];
#pragma unroll
    for (int i = 0; i < 32; ++i) {
        const int t = t0 + i; const int lo = t - HW < 0 ? 0 : t - HW, hi = t + HW > L ? L : t + HW;
        const f32x2_t d = s * (1.0f / (float)(hi - lo)) - x[i + HW];
        *(unsigned*)(ds + (size_t)t * DATT) = pkbf(d[0], d[1]);
        if (i < 31) s += x[i + 2 * HW] - x[i];
    }
}

__device__ __forceinline__ void mixer_phase(const Args& a, LAS unsigned char* lds, int tid, int lane, int wave, int G, int what, int vb) {
    unsigned char* ws = a.ws;
    if (what & 1) {
    const bf16_t* Q = (const bf16_t*)(ws + WS_Q); const bf16_t* Kb = (const bf16_t*)(ws + WS_K); const bf16_t* VT = (const bf16_t*)(ws + WS_VT);
    const bf16_t* KC = (const bf16_t*)(ws + WS_KC); const bf16_t* VTC = (const bf16_t*)(ws + WS_VTC);
    bf16_t* ATT = (bf16_t*)(ws + WS_H);
    LAS float* rpbl = (LAS float*)(lds + 1024);
    for (int i = tid; i < 8 * 15 * 31; i += 512) rpbl[i] = a.in[I_RPB][i] * LOG2E;
    __syncthreads();
    for (int u = vb; u < 256; u += G) {
        {
            const int ul = (u & 7) * 32 + (u >> 3), bh = ul >> 3, b = bh >> 3, h = bh & 7, rq = 4 * (ul & 7) + (wave >> 1), g = wave & 1;
            int r0 = rq - 4; r0 = r0 < 0 ? 0 : (r0 > 24 ? 24 : r0);
            const size_t row0 = (size_t)NCTX + (size_t)b * 2048 + rq * 64 + 32 * g;
            attn_wave(Q + row0 * DATT + h * 64, ATT + row0 * DATT + h * 64, 16, KC + (size_t)bh * 16 * 2048, VTC + (size_t)bh * 16 * 2048,
                      16, Kb + KV_LAT + (size_t)bh * 64 * 2048, VT + KV_LAT + (size_t)bh * 64 * 2048, rq, r0, g, rpbl + h * 15 * 31, lane);
        }
        {
            const int b = u >> 3, h = u & 7;
            const size_t row0 = (size_t)b * 256 + 32 * wave;
            attn_wave(Q + row0 * DATT + h * 64, ATT + row0 * DATT + h * 64, 8, Kb + (size_t)u * 8 * 2048, VT + (size_t)u * 8 * 2048,
                      0, Kb, VT, 0, 0, 0, rpbl, lane);
        }
    }
    }
    if (!(what & 2)) return;
    const float* P = (const float*)(ws + WS_P); bf16_t* D = (bf16_t*)(ws + WS_ACT + 64 * MiB);
    const int gw = blockIdx.x * 8 + wave, NGW = G * 8;
    for (int it = gw; it < (NTOK / 32) * 4; it += NGW) {
        const int g = it & 3, row0 = (it >> 2) * 32;
        int t0, L; if (row0 < NCTX) { t0 = row0 & 255; L = 256; } else { t0 = (row0 - NCTX) & 2047; L = 2048; }
        const float* ps = P + (size_t)(row0 - t0) * DATT + g * 128 + 2 * lane; bf16_t* ds = D + (size_t)(row0 - t0) * DATT + g * 128 + 2 * lane;
        if (g == 0) dpass_item<1>(ps, ds, t0, L); else if (g == 1) dpass_item<2>(ps, ds, t0, L); else if (g == 2) dpass_item<4>(ps, ds, t0, L); else dpass_item<8>(ps, ds, t0, L);
    }
}


typedef unsigned v4u __attribute__((ext_vector_type(4)));
#define XB_TMO      128
#define XB_XCNT(j)  (256  + 64 * (j))
#define XB_XSUB(j)  (1280 + 64 * (j))
#define XB_XGEN(j)  (2304 + 64 * (j))
#define XB_TOP      3328
#define XB_TOPGEN   3392
#define XCD_BAR_WORDS 3456
#define XB_SPIN_CAP (1u << 18)

__device__ __forceinline__ unsigned xb_ld(unsigned* p)              { return __hip_atomic_load(p, __ATOMIC_RELAXED, __HIP_MEMORY_SCOPE_AGENT); }
__device__ __forceinline__ unsigned xb_add(unsigned* p, unsigned v) { return __hip_atomic_fetch_add(p, v, __ATOMIC_RELAXED, __HIP_MEMORY_SCOPE_AGENT); }
__device__ __forceinline__ unsigned xb_xcc_id() { return (unsigned)__builtin_amdgcn_s_getreg((3 << 11) | 20) & 0xFu; }
#define XB_SPIN(cond, bar) do { unsigned _sp = 0; while (cond) { __builtin_amdgcn_s_sleep(1); \
    if ((++_sp & 255u) == 0u) { if (xb_ld(&(bar)[XB_TMO])) break; if (_sp > XB_SPIN_CAP) { atomicAdd(&(bar)[XB_TMO], 1u); break; } } } } while (0)

struct XcdBarrier {
    unsigned* bar; unsigned x;
    volatile LAS unsigned* st;
};

__device__ __forceinline__ XcdBarrier xcd_barrier_post(unsigned* bar, volatile LAS unsigned* st) {
    XcdBarrier b; b.bar = bar; b.x = xb_xcc_id(); b.st = st;
    if (threadIdx.x == 0) st[2] = xb_add(&bar[XB_XCNT(b.x)], 1u);
    return b;
}
__device__ __forceinline__ void xcd_barrier_complete(unsigned* bar, unsigned x, unsigned& nloc, unsigned& nx) {
    const unsigned G = gridDim.x * gridDim.y * gridDim.z;
    unsigned sum, cnt, mine, sp = 0u;
    for (;;) {
        sum = 0u; cnt = 0u; mine = 0u;
#pragma unroll
        for (unsigned j = 0; j < 16; ++j) { const unsigned c = xb_ld(&bar[XB_XCNT(j)]); sum += c; cnt += (c > 0u) ? 1u : 0u; mine = (j == x) ? c : mine; }
        if (sum == G) break;
        __builtin_amdgcn_s_sleep(1);
        if ((++sp & 255u) == 0u) { if (xb_ld(&bar[XB_TMO])) break; if (sp > XB_SPIN_CAP) { atomicAdd(&bar[XB_TMO], 1u); break; } }
    }
    nloc = mine > 0u ? mine : 1u; nx = cnt > 0u ? cnt : 1u;
}

__device__ __forceinline__ void xcd_barrier(const XcdBarrier& b) {
    asm volatile("s_waitcnt vmcnt(0)" ::: "memory");
    __syncthreads();
    if (threadIdx.x == 0) {
        unsigned* bar = b.bar;
        __builtin_amdgcn_s_waitcnt(0);
        unsigned nloc = b.st[0], nx = b.st[1];
        if (nloc == 0u) { xcd_barrier_complete(bar, b.x, nloc, nx); b.st[0] = nloc; b.st[1] = nx; }
        const unsigned old = xb_add(&bar[XB_XSUB(b.x)], 1u);
        const unsigned gen = old / nloc;
        if (old + 1u == (gen + 1u) * nloc) {
            __builtin_amdgcn_fence(__ATOMIC_RELEASE, "agent");
            asm volatile("s_waitcnt vmcnt(0)" ::: "memory");
            const unsigned og = xb_add(&bar[XB_TOP], 1u);
            const unsigned tg = og / nx;
            if (og + 1u == (tg + 1u) * nx) xb_add(&bar[XB_TOPGEN], 1u);
            else XB_SPIN(xb_ld(&bar[XB_TOPGEN]) == tg, bar);
            __builtin_amdgcn_fence(__ATOMIC_ACQUIRE, "agent");
            xb_add(&bar[XB_XGEN(b.x)], 1u);
            asm volatile("s_waitcnt vmcnt(0)" ::: "memory");
        } else {
            XB_SPIN(xb_ld(&bar[XB_XGEN(b.x)]) == gen, bar);
            __builtin_amdgcn_fence(__ATOMIC_ACQUIRE, "agent");
            asm volatile("s_waitcnt vmcnt(0)" ::: "memory");
        }
    }
    __syncthreads();
}

#ifndef PROBE_DUP
#define PROBE_DUP -1
#endif
constexpr int LDS_BYTES = 147456;
__global__ void __launch_bounds__(512, 2) mk_fwd(Args args) {
    extern __shared__ __attribute__((aligned(16))) unsigned char lds_raw[];
    LAS unsigned char* lds = (LAS unsigned char*)lds_raw;
    cg::grid_group grid = cg::this_grid();
    const int tid = threadIdx.x, lane = tid & 63, wave = __builtin_amdgcn_readfirstlane(tid >> 6), G = gridDim.x;
    unsigned char* ws = args.ws;
    const int lo = args.ph_lo, hi = args.ph_hi;
    if (tid < 64) ((LAS unsigned*)(lds + 131072))[tid] = 0u;
    __syncthreads();
    XcdBarrier bar = xcd_barrier_post((unsigned*)(ws + WS_CTL), (volatile LAS unsigned*)(lds + 131072 + 64));
    if (hi > 1000) grid.sync();
    const float* mod = (const float*)(ws + WS_MOD);
    float* Y = args.out + OUT_Y;
    bf16_t* H = (bf16_t*)(ws + WS_H); bf16_t* ACT = (bf16_t*)(ws + WS_ACT);
#define IN(k) (lo <= (k) && (k) < hi)
#define SEAM(k) do { if (IN(k) && IN((k) + 1)) xcd_barrier(bar); } while (0)
#define GEMM_PHASE(EPI, e, Aptr, Bptr, N_, K_) do { pg8::Gemm g_{(const bf16_t*)(Aptr), (const bf16_t*)(Bptr), NTOK, (N_), (K_)}; pg8::StaticOrder S_; S_.init(NTOK, (N_), G, vb); \
        pg8::gemm_phase<EPI, pg8::StaticOrder, true, true>(lds, g_, S_, e); } while (0)

    float* SSb = (float*)(ws + WS_SS); float* BVIN = (float*)(ws + WS_BVIN); float* BVFF2 = (float*)(ws + WS_BVFF2);
    const int gwv = blockIdx.x * 8 + wave, NGWv = G * 8;
#define PHASE(k, ...) if (IN(k)) { __VA_ARGS__ if (PROBE_DUP == (k)) { xcd_barrier(bar); __VA_ARGS__ } }
    PHASE(0, { phase0(args, lds, tid, lane, wave, G); }) SEAM(0);
    int vb = blockIdx.x;
    if (IN(0) && IN(1)) {
        volatile LAS unsigned* stw = (volatile LAS unsigned*)(lds + 131072 + 64);
        if (tid == 0) { const unsigned* bw = (const unsigned*)(ws + WS_CTL); bool ok = (G % 8 == 0) && bar.x < 8u;
            for (int j = 0; j < 8; ++j) ok = ok && (xb_ld((unsigned*)&bw[XB_XCNT(j)]) == (unsigned)(G / 8));
            stw[3] = ok ? (stw[2] * 8u + bar.x) : (unsigned)blockIdx.x; }
        __syncthreads();
        vb = (int)stw[3];
    }
    vb = __builtin_amdgcn_readfirstlane(vb);
    PHASE(1, { norm_phase(args.in[I_XP], args.in[I_XS], args.in[I_GFF1], mod, 0, H, G, wave, lane);
               bvec_items((const bf16_t*)(ws + WS_WIN), DIN, mod, 3, BVIN, gwv, NGWv, lane); }) SEAM(1);
    PHASE(2, { EpiSwiGLU<false> e{ws, nullptr, 0}; GEMM_PHASE(EpiSwiGLU<false>, e, H, ws + WS_FF1IN, 2 * DFF, DM);
               if (G == 256) { if (vb >= 128) late_copies(args, lds, lane, wave, (vb - 128) * 8 + wave, 1024); } else late_copies(args, lds, lane, wave, vb * 8 + wave, G * 8); }) SEAM(2);
    PHASE(3, { typedef EpiResid<true, 2, 1, 3> E3; E3 e{args.in[I_XP], (long)(args.in[I_XS] - args.in[I_XP]) - (long)NCTX * DM, Y, ws, args.in[I_GMIX]}; GEMM_PHASE(E3, e, ACT, ws + WS_FF1OUT, DM, DFF); }) SEAM(3);
    PHASE(4, { LAS float* tbl = (LAS float*)(lds + 141824); { pg8::StaticOrder S_; S_.init(NTOK, DIN, G, vb); rstd_table(SSb, S_, tbl, 5, tid); }
               EpiWin e{ws, args.out + OUT_K, args.in[I_QG], args.in[I_KG], lds + 131072 + 512, tbl, 5};
               GEMM_PHASE(EpiWin, e, H, ws + WS_WIN, DIN, DM); }) SEAM(4);
    PHASE(5, { mixer_phase(args, lds, tid, lane, wave, G, 3, vb); bvec_items((const bf16_t*)(ws + WS_FF2IN), 2 * DFF, mod, 6, BVFF2, gwv, NGWv, lane); }) SEAM(5);
    PHASE(6, { { EpiMix<1> e{ws, nullptr}; GEMM_PHASE(EpiMix<1>, e, ws + WS_ACT + 64 * MiB, ws + WS_WBP, DM, DATT); }
               { EpiMix<2> e{ws, nullptr}; GEMM_PHASE(EpiMix<2>, e, H, ws + WS_WBA, DM, DATT); } }) SEAM(6);
    if (IN(7)) { typedef EpiResid<true, 5, 2, 6> E8; E8 e{Y, 0L, Y, ws, args.in[I_GFF2]}; GEMM_PHASE(E8, e, ws + WS_P, ws + WS_WOUT, DM, DM); } SEAM(7);
    PHASE(8, { LAS float* tbl = (LAS float*)(lds + 131072 + 512); { pg8::StaticOrder S_; S_.init(NTOK, 2 * DFF, G, vb); rstd_table(SSb, S_, tbl, 15, tid); }
               EpiSwiGLU<true> e{ws, tbl, 15}; GEMM_PHASE(EpiSwiGLU<true>, e, H, ws + WS_FF2IN, 2 * DFF, DM); }) SEAM(8);
    if (IN(9)) { typedef EpiResid<false, 8, 1, 0> E10; E10 e{Y, 0L, Y, ws, nullptr}; GEMM_PHASE(E10, e, ACT, ws + WS_FF2OUT, DM, DFF); }
}

#ifndef MK_PER_PHASE
#define MK_PER_PHASE 0
#endif
extern "C" void kernel_launch(void* const* d_in, const int* in_sizes, int n_in, void* d_out, int out_size, void* d_ws, size_t ws_size, hipStream_t stream) {
    static int grid = 0;
    if (grid == 0) {
        if (n_in != 24 || ws_size < WS_END) { fprintf(stderr, "kernel_launch: unexpected n_in %d / ws_size %zu (need %zu)\n", n_in, ws_size, (size_t)WS_END); grid = -1; return; }
        int dev = 0, cus = 0, per_cu = 0;
        hipGetDevice(&dev); hipDeviceGetAttribute(&cus, hipDeviceAttributeMultiprocessorCount, dev);
        if (hipFuncSetAttribute((const void*)mk_fwd, hipFuncAttributeMaxDynamicSharedMemorySize, LDS_BYTES) != hipSuccess) { fprintf(stderr, "kernel_launch: hipFuncSetAttribute failed\n"); grid = -1; return; }
        if (hipOccupancyMaxActiveBlocksPerMultiprocessor(&per_cu, (const void*)mk_fwd, 512, LDS_BYTES) != hipSuccess || per_cu < 1) { fprintf(stderr, "kernel_launch: occupancy query says %d\n", per_cu); per_cu = 1; }
        (void)hipGetLastError();
        grid = cus * per_cu;
        fprintf(stderr, "kernel_launch: grid %d (cus %d x %d), ws %zu\n", grid, cus, per_cu, ws_size);
    }
    if (grid < 0) return;
    if (hipMemsetAsync((char*)d_ws + WS_CTL, 0, CTL_BYTES, stream) != hipSuccess) { fprintf(stderr, "kernel_launch: memset failed\n"); return; }
    Args a{};
    for (int i = 0; i < 24; ++i) a.in[i] = (const float*)d_in[i];
    a.out = (float*)d_out; a.ws = (unsigned char*)d_ws;
#if MK_PER_PHASE
    for (int p = 0; p < 10; ++p) { a.ph_lo = p; a.ph_hi = p + 1; hipLaunchKernelGGL(mk_fwd, dim3(grid), dim3(512), LDS_BYTES, stream, a); }
#else
    a.ph_lo = 0; a.ph_hi = 10;
    void* kargs[] = {&a};
    hipError_t e = hipLaunchCooperativeKernel((const void*)mk_fwd, dim3(grid), dim3(512), kargs, LDS_BYTES, stream);
    if (e != hipSuccess) fprintf(stderr, "kernel_launch: cooperative launch failed: %s (grid %d)\n", hipGetErrorString(e), grid);
#endif
}
```

```cpp
#include <hip/hip_runtime.h>
#include <hip/hip_cooperative_groups.h>
#include <cstdio>
#include <cstdint>
namespace cg = cooperative_groups;
namespace pg8 {
#define PG8_LAS __attribute__((address_space(3)))
typedef unsigned short bf16_t;
typedef short bf16x8 __attribute__((ext_vector_type(8)));
typedef float f32x4 __attribute__((ext_vector_type(4)));
typedef unsigned u32x4 __attribute__((ext_vector_type(4)));
constexpr int BM = 256, BK = 64, HALF = 128, HTB = HALF * BK * 2  , STAGE_BYTES = 8 * HTB, NXCD = 8, WGM = 8;

__host__ __device__ __forceinline__ int lds_byte(int r, int c) { const int st = (r >> 4) * 2 + (c >> 5), rr = r & 15, cc = c & 31, ob = rr * 64 + cc * 2; return st * 1024 + (ob ^ (((ob >> 9) & 1) << 5)); }
__host__ __device__ __forceinline__ void stage_rc(int b, int& R, int& C) { const int st = b / 1024, sb = b % 1024, swz = sb ^ (((sb >> 9) & 1) << 5); R = (st >> 1) * 16 + swz / 64; C = (st & 1) * 32 + (swz % 64) / 2; }
__host__ __device__ __forceinline__ int perm32(int rho) { const int n = rho >> 4, i = rho & 15; return 8 * (i >> 2) + 4 * n + (i & 3); }

struct Unit { int pm, pn, ord; };
struct Gemm { const bf16_t* A; const bf16_t* Bt; int M, N, K; };

struct StaticOrder {
    int nM, nN, nwg, G, c;
    __host__ __device__ void init(int M, int N, int G_, int c_) { nM = M / BM; nN = N / BM; nwg = nM * nN; G = G_; c = c_; }
    __host__ __device__ bool next(int i, Unit& u) const {
        const long L = (long)i * G + c; if (L >= nwg) return false;
        int wgid = (int)L; { const int q = nwg / NXCD, r = nwg % NXCD, xcd = wgid % NXCD, off = wgid / NXCD; wgid = (xcd < r ? xcd * (q + 1) : r * (q + 1) + (xcd - r) * q) + off; }
        const int nig = WGM * nN, gid = wgid / nig, fm = gid * WGM, gsz = (nM - fm) < WGM ? (nM - fm) : WGM;
        u.pm = fm + ((wgid % nig) % gsz); u.pn = (wgid % nig) / gsz; u.ord = i; return true;
    }
    __device__ __forceinline__ void a_ready(const Unit&) const {}
    __device__ __forceinline__ void done(const Unit&) const {}
};

__device__ __forceinline__ unsigned cvt_pk_bf16(float lo, float hi) { unsigned r; asm volatile("v_cvt_pk_bf16_f32 %0, %1, %2" : "=v"(r) : "v"(lo), "v"(hi)); return r; }
template <class Epi, class Sched, bool ALIGN_EPI = false, bool SP2 = false>
__device__ __forceinline__ void gemm_phase(PG8_LAS unsigned char* lds, const Gemm g, const Sched S, const Epi E) {
    const int tid = threadIdx.x, wid = __builtin_amdgcn_readfirstlane(tid >> 6), lane = tid & 63, wr = wid >> 2, wc = wid & 3, fr = lane & 15, fq = lane >> 4;
    const int K = g.K, nt = K / BK;
    unsigned voffA[2], voffB[2];
#pragma unroll
    for (int i = 0; i < 2; ++i) { int R, C; stage_rc(tid * 16 + i * 8192, R, C); const int Rb = Epi::PERM ? ((R & ~31) + perm32(R & 31)) : R;
        voffA[i] = (unsigned)(R * K + C) * 2u; voffB[i] = (unsigned)(Rb * K + C) * 2u; }
    const size_t kstep = (size_t)(BK * 2);
    const size_t hstep = (size_t)HALF * K * 2;
    const size_t tstep = 2 * hstep;
    const unsigned ldsw = (unsigned)wid * 1024u;
    const int aoff = lds_byte(wr * 64 + fr, fq * 8), boff = lds_byte(wc * 32 + fr, fq * 8);
#define PG8_SA(b, h) (((b) * 2 + (h)) * HTB)
#define PG8_SB(b, h) ((4 + (b) * 2 + (h)) * HTB)
#define PG8_STAGE(bufoff, gbase, voff) do { _Pragma("unroll") for (int _i = 0; _i < 2; ++_i) \
        __builtin_amdgcn_global_load_lds((const unsigned*)((const char*)(gbase) + (voff)[_i]), (PG8_LAS unsigned*)(lds + (bufoff) + ldsw + _i * 8192), 16, 0, 0); } while (0)
#define PG8_LDA(dst, b, h) do { _Pragma("unroll") for (int m = 0; m < 4; ++m) _Pragma("unroll") for (int k = 0; k < 2; ++k) dst[m][k] = *(const PG8_LAS bf16x8*)(lds + PG8_SA(b, h) + aoff + m * 2048 + k * 1024); } while (0)
#define PG8_LDB(dst, b, h) do { _Pragma("unroll") for (int n = 0; n < 2; ++n) _Pragma("unroll") for (int k = 0; k < 2; ++k) dst[n][k] = *(const PG8_LAS bf16x8*)(lds + PG8_SB(b, h) + boff + n * 2048 + k * 1024); } while (0)
#define PG8_MMA(ai, bj, At, Bt) do { __builtin_amdgcn_s_setprio(1); _Pragma("unroll") for (int m = 0; m < 4; ++m) _Pragma("unroll") for (int n = 0; n < 2; ++n) _Pragma("unroll") for (int k = 0; k < 2; ++k) \
        acc[ai][bj][m][n] = __builtin_amdgcn_mfma_f32_16x16x32_bf16(Bt[n][k], At[m][k], acc[ai][bj][m][n], 0, 0, 0); __builtin_amdgcn_s_setprio(0); } while (0)
#define PG8_WAIT_V(n) asm volatile("s_waitcnt vmcnt(" #n ")" ::: "memory")
#define PG8_WAIT_L(n) asm volatile("s_waitcnt lgkmcnt(" #n ")" ::: "memory")
#define PG8_BAR __builtin_amdgcn_s_barrier()
#define PG8_SCHED __builtin_amdgcn_sched_barrier(0)
    Unit cur, nxt; int ui = 0;
    if (!S.next(0, cur)) return;
    f32x4 acc[2][2][4][2];
#pragma unroll
    for (int a = 0; a < 2; ++a)
#pragma unroll
        for (int b = 0; b < 2; ++b)
#pragma unroll
            for (int m = 0; m < 4; ++m)
#pragma unroll
                for (int n = 0; n < 2; ++n) acc[a][b][m][n] = (f32x4){0.f, 0.f, 0.f, 0.f};
    bf16x8 At[4][2], B0[2][2], B1[2][2];
    const char* cA = (const char*)g.A + (size_t)cur.pm * tstep; const char* cB = (const char*)g.Bt + (size_t)cur.pn * tstep;
    S.a_ready(cur);
    if constexpr (SP2) {
        PG8_STAGE(PG8_SB(0, 0), cB, voffB); PG8_STAGE(PG8_SB(0, 1), cB + hstep, voffB); PG8_STAGE(PG8_SA(0, 0), cA, voffA); PG8_STAGE(PG8_SA(0, 1), cA + hstep, voffA);
        if (wr == 1) PG8_BAR;
        PG8_WAIT_V(2); PG8_BAR;
        PG8_STAGE(PG8_SB(1, 0), cB + kstep, voffB); PG8_STAGE(PG8_SA(1, 0), cA + kstep, voffA); PG8_STAGE(PG8_SB(1, 1), cB + hstep + kstep, voffB);
        PG8_WAIT_V(6); PG8_BAR;
    } else {
        PG8_STAGE(PG8_SB(0, 0), cB, voffB); PG8_STAGE(PG8_SA(0, 0), cA, voffA); PG8_STAGE(PG8_SB(0, 1), cB + hstep, voffB); PG8_STAGE(PG8_SA(0, 1), cA + hstep, voffA);
        if (wr == 1) PG8_BAR;
        PG8_WAIT_V(4); PG8_BAR;
        PG8_STAGE(PG8_SB(1, 0), cB + kstep, voffB); PG8_STAGE(PG8_SA(1, 0), cA + kstep, voffA); PG8_STAGE(PG8_SB(1, 1), cB + hstep + kstep, voffB);
        PG8_WAIT_V(6); PG8_BAR;
    }
    for (;;) {
        const bool has_next = S.next(ui + 1, nxt);
        const char* nA = has_next ? (const char*)g.A + (size_t)nxt.pm * tstep : cA; const char* nB = has_next ? (const char*)g.Bt + (size_t)nxt.pn * tstep : cB;
        for (int t = 0; t < nt; t += 2) {
            const bool last = (t == nt - 2);
            const char* a1 = cA + (size_t)(t + 1) * kstep;
            const char* a2 = last ? nA : cA + (size_t)(t + 2) * kstep; const char* b2 = last ? nB : cB + (size_t)(t + 2) * kstep;
            const char* a3 = a2 + kstep; const char* b3 = b2 + kstep;
            if (last && has_next) S.a_ready(nxt);
            if constexpr (SP2) {
            PG8_LDB(B0, 0, 0); PG8_LDB(B1, 0, 1); PG8_SCHED; PG8_LDA(At, 0, 0); PG8_STAGE(PG8_SA(1, 1), a1 + hstep, voffA);
            PG8_WAIT_V(8); PG8_WAIT_L(0); PG8_BAR; PG8_MMA(0, 0, At, B0); PG8_MMA(0, 1, At, B1); PG8_BAR; PG8_SCHED;
            PG8_LDA(At, 0, 1); PG8_STAGE(PG8_SB(0, 0), b2, voffB); PG8_STAGE(PG8_SB(0, 1), b2 + hstep, voffB); PG8_STAGE(PG8_SA(0, 0), a2, voffA);
            PG8_WAIT_V(8); PG8_WAIT_L(0); PG8_BAR; PG8_MMA(1, 0, At, B0); PG8_MMA(1, 1, At, B1); PG8_BAR; PG8_SCHED;
            PG8_LDB(B0, 1, 0); PG8_LDB(B1, 1, 1); PG8_SCHED; PG8_LDA(At, 1, 0); PG8_STAGE(PG8_SA(0, 1), a2 + hstep, voffA);
            PG8_WAIT_V(8); PG8_WAIT_L(0); PG8_BAR; PG8_MMA(0, 0, At, B0); PG8_MMA(0, 1, At, B1); PG8_BAR; PG8_SCHED;
            PG8_LDA(At, 1, 1); PG8_STAGE(PG8_SB(1, 0), b3, voffB); PG8_STAGE(PG8_SB(1, 1), b3 + hstep, voffB); PG8_STAGE(PG8_SA(1, 0), a3, voffA);
            PG8_WAIT_V(8); PG8_WAIT_L(0); PG8_BAR; PG8_MMA(1, 0, At, B0); PG8_MMA(1, 1, At, B1); PG8_BAR; PG8_SCHED;
            } else {
            PG8_LDB(B0, 0, 0); PG8_SCHED; PG8_LDA(At, 0, 0); PG8_STAGE(PG8_SA(1, 1), a1 + hstep, voffA);
            PG8_WAIT_L(8); PG8_BAR; PG8_WAIT_L(0); PG8_MMA(0, 0, At, B0); PG8_BAR; PG8_SCHED;
            PG8_LDB(B1, 0, 1); PG8_STAGE(PG8_SB(0, 0), b2, voffB);
            PG8_BAR; PG8_WAIT_L(0); PG8_MMA(0, 1, At, B1); PG8_BAR;
            PG8_LDA(At, 0, 1); PG8_STAGE(PG8_SA(0, 0), a2, voffA);
            PG8_BAR; PG8_WAIT_L(0); PG8_MMA(1, 0, At, B0); PG8_BAR; PG8_SCHED;
            PG8_STAGE(PG8_SB(0, 1), b2 + hstep, voffB);
            PG8_WAIT_V(6); PG8_BAR; PG8_MMA(1, 1, At, B1); PG8_BAR;
            PG8_LDB(B0, 1, 0); PG8_SCHED; PG8_LDA(At, 1, 0); PG8_STAGE(PG8_SA(0, 1), a2 + hstep, voffA);
            PG8_WAIT_L(8); PG8_BAR; PG8_WAIT_L(0); PG8_MMA(0, 0, At, B0); PG8_BAR; PG8_SCHED;
            PG8_LDB(B1, 1, 1); PG8_STAGE(PG8_SB(1, 0), b3, voffB);
            PG8_BAR; PG8_WAIT_L(0); PG8_MMA(0, 1, At, B1); PG8_BAR;
            PG8_LDA(At, 1, 1); PG8_STAGE(PG8_SA(1, 0), a3, voffA);
            PG8_BAR; PG8_WAIT_L(0); PG8_MMA(1, 0, At, B0); PG8_BAR; PG8_SCHED;
            PG8_STAGE(PG8_SB(1, 1), b3 + hstep, voffB);
            PG8_WAIT_V(6); PG8_BAR; PG8_MMA(1, 1, At, B1); PG8_BAR;
            }
        }
        if constexpr (ALIGN_EPI) { if (wr == 0) PG8_BAR; }
        if constexpr (!Epi::AFTER_DRAIN) { E(acc, cur, wr, wc, fr, fq); S.done(cur); }
        if (!has_next) break;
#pragma unroll
        for (int a = 0; a < 2; ++a)
#pragma unroll
            for (int b = 0; b < 2; ++b)
#pragma unroll
                for (int m = 0; m < 4; ++m)
#pragma unroll
                    for (int n = 0; n < 2; ++n) acc[a][b][m][n] = (f32x4){0.f, 0.f, 0.f, 0.f};
        cur = nxt; cA = nA; cB = nB; ++ui;
        if constexpr (ALIGN_EPI) { if (wr == 1) PG8_BAR; }
    }
    PG8_WAIT_V(0);
    if constexpr (!ALIGN_EPI) { if (wr == 0) PG8_BAR; }
    PG8_BAR;
    if constexpr (Epi::AFTER_DRAIN) { E.fused(acc, cur, wr, wc, fr, fq, lds, wid, lane); S.done(cur); }
#undef PG8_SA
#undef PG8_SB
#undef PG8_STAGE
#undef PG8_LDA
#undef PG8_LDB
#undef PG8_MMA
#undef PG8_WAIT_V
#undef PG8_WAIT_L
#undef PG8_BAR
#undef PG8_SCHED
}
}

#define LAS __attribute__((address_space(3)))
using pg8::bf16_t; using pg8::bf16x8; using pg8::f32x4; using pg8::u32x4;
typedef float f32x16 __attribute__((ext_vector_type(16)));
typedef float f32x2_t __attribute__((ext_vector_type(2)));
typedef __bf16 bf16x2_t __attribute__((ext_vector_type(2)));
typedef unsigned u32x2 __attribute__((ext_vector_type(2)));

constexpr int DM = 1024, NTOK = 16384, NCTX = 8192, DFF = 2816, DATT = 512, DIN = 4096, NMOD = 9;
constexpr float EPS = 1e-6f, LOG2E = 1.4426950408889634f;
constexpr size_t MiB = 1u << 20;
constexpr size_t WS_FF1IN = 0, WS_FF1OUT = 11 * MiB, WS_FF2IN = 17 * MiB, WS_FF2OUT = 28 * MiB, WS_WIN = 34 * MiB, WS_WBP = 42 * MiB, WS_WBA = 43 * MiB, WS_WOUT = 44 * MiB,
                 WS_WPOOL = 46 * MiB, WS_MOD = 47 * MiB, WS_KC = 48 * MiB, WS_VTC = 50 * MiB;
constexpr size_t WS_H = 52 * MiB;
constexpr size_t WS_ACT = 84 * MiB;
constexpr size_t WS_P = 172 * MiB;
constexpr size_t WS_Q = 204 * MiB;
constexpr size_t WS_K = 220 * MiB;
constexpr size_t WS_VT = 236 * MiB;
constexpr size_t WS_CTL = 252 * MiB, CTL_BYTES = 16384;
constexpr size_t WS_SS = 253 * MiB;
constexpr size_t WS_BVIN = 47 * MiB + 512 * 1024, WS_BVFF2 = WS_BVIN + 128 * 1024;
constexpr size_t WS_END = 254 * MiB;
static_assert(WS_END <= 256 * MiB, "d_ws map");
constexpr size_t KV_LAT = (size_t)32 * 8 * 8 * 2048;
constexpr size_t OUT_Y = 0, OUT_K = (size_t)NTOK * DM, OUT_V = OUT_K + (size_t)NCTX * DATT;

__device__ __forceinline__ unsigned pkbf(float lo, float hi) { f32x2_t v = {lo, hi}; bf16x2_t b = __builtin_convertvector(v, bf16x2_t); return __builtin_bit_cast(unsigned, b); }
__device__ __forceinline__ float bflo(unsigned w) { return __uint_as_float(w << 16); }
__device__ __forceinline__ float bfhi(unsigned w) { return __uint_as_float(w & 0xffff0000u); }
__device__ __forceinline__ float fast_sigmoid(float x) { return __builtin_amdgcn_rcpf(1.0f + __builtin_amdgcn_exp2f(-x * LOG2E)); }
__device__ __forceinline__ float wave_sum(float v) {
#pragma unroll
    for (int o = 1; o < 64; o <<= 1) v += __shfl_xor(v, o);
    return v;
}
__device__ __forceinline__ int cond_of_pm(int pm) { return pm < 32 ? 0 : 1 + ((pm - 32) >> 3); }

__device__ __forceinline__ float row_sumsq(const float* SS, int row, int fq) {
    const f32x4 a = *(const f32x4*)(SS + (size_t)row * 16 + 4 * fq); float s = (a[0] + a[1]) + (a[2] + a[3]);
    s += __shfl_xor(s, 16); s += __shfl_xor(s, 32); return s;
}
__device__ __forceinline__ float rstd_of(float sumsq) { return 1.0f / sqrtf(sumsq * (1.0f / DM) + EPS); }

__device__ __forceinline__ void rstd_table(const float* SS, const pg8::StaticOrder& S, LAS float* tbl, int nmax, int tid) {
    pg8::Unit u;
    for (int i = 0; i < nmax && S.next(i, u); ++i)
        if (tid < 256) { const f32x4* p = (const f32x4*)(SS + (size_t)(u.pm * 256 + tid) * 16); const f32x4 a = (p[0] + p[1]) + (p[2] + p[3]); tbl[i * 256 + tid] = rstd_of(((a[0] + a[1]) + (a[2] + a[3]))); }
    __syncthreads();
}

#define EPI_ROWS(ai, m) (u.pm * 256 + (ai) * 128 + wr * 64 + (m) * 16 + fr)

template <bool NORMED> struct EpiSwiGLU {
    static constexpr bool PERM = true, AFTER_DRAIN = false;
    unsigned char* ws; const LAS float* tbl; int nmax;
    __device__ __forceinline__ void operator()(const f32x4 (&acc)[2][2][4][2], const pg8::Unit& u, int wr, int wc, int fr, int fq) const {
        bf16_t* O = (bf16_t*)(ws + WS_ACT); const float* bvec = (const float*)(ws + WS_BVFF2); const float* SS = (const float*)(ws + WS_SS);
        const int col = u.pn * 128 + wc * 32 + 8 * fq;
        f32x4 bv[2][2];
        if (NORMED) { const float* bp = bvec + (size_t)cond_of_pm(u.pm) * (2 * DFF) + u.pn * 256 + wc * 32 + 8 * fq;
#pragma unroll
            for (int bj = 0; bj < 2; ++bj)
#pragma unroll
                for (int n = 0; n < 2; ++n) bv[bj][n] = *(const f32x4*)(bp + bj * 128 + 4 * n); }
#pragma unroll
        for (int ai = 0; ai < 2; ++ai)
#pragma unroll
            for (int m = 0; m < 4; ++m) {
                const int row = EPI_ROWS(ai, m);
                const float rs = NORMED ? (u.ord < nmax ? tbl[u.ord * 256 + ai * 128 + wr * 64 + m * 16 + fr] : rstd_of(row_sumsq(SS, row, fq))) : 1.f;
                float v[8];
#pragma unroll
                for (int n = 0; n < 2; ++n)
#pragma unroll
                    for (int j = 0; j < 4; ++j) { float g = acc[ai][0][m][n][j], up = acc[ai][1][m][n][j]; if (NORMED) { g = g * rs + bv[0][n][j]; up = up * rs + bv[1][n][j]; } v[4 * n + j] = g * fast_sigmoid(g) * up; }
                u32x4 w; w.x = pkbf(v[0], v[1]); w.y = pkbf(v[2], v[3]); w.z = pkbf(v[4], v[5]); w.w = pkbf(v[6], v[7]);
                *(u32x4*)(O + (size_t)row * DFF + col) = w;
            }
    }
};
template <bool NEXT, int GI, int COEF2, int MNEXT> struct EpiResid {
    static constexpr bool PERM = true, AFTER_DRAIN = false;
    const float* base0; long d1;
    float* out; unsigned char* ws; const float* gnext;
    __device__ __forceinline__ void operator()(const f32x4 (&acc)[2][2][4][2], const pg8::Unit& u, int wr, int wc, int fr, int fq) const {
        constexpr int gi = GI, mnext = MNEXT; constexpr float coef = 0.5f * COEF2;
        bf16_t* XA = (bf16_t*)(ws + WS_H); float* SS = (float*)(ws + WS_SS);
        const float* mc = (const float*)(ws + WS_MOD) + (size_t)cond_of_pm(u.pm) * (NMOD * DM);
        const float* gv = mc + gi * DM;
        const float* base = base0 + (u.pm < 32 ? 0L : d1);
        const int col = u.pn * 256 + wc * 32 + 8 * fq;
        f32x4 g[2][2], an[2][2];
#pragma unroll
        for (int bj = 0; bj < 2; ++bj)
#pragma unroll
            for (int n = 0; n < 2; ++n) { g[bj][n] = *(const f32x4*)(gv + col + bj * 128 + 4 * n) * coef;
                if (NEXT) an[bj][n] = *(const f32x4*)(gnext + col + bj * 128 + 4 * n) * (*(const f32x4*)(mc + (mnext + 1) * DM + col + bj * 128 + 4 * n) + 1.0f); }
#pragma unroll
        for (int ai = 0; ai < 2; ++ai)
#pragma unroll
            for (int m = 0; m < 4; ++m) { const int row = EPI_ROWS(ai, m); const size_t off = (size_t)row * DM + col; float ss = 0.f;
#pragma unroll
                for (int bj = 0; bj < 2; ++bj) { f32x4 o[2];
#pragma unroll
                    for (int n = 0; n < 2; ++n) { const f32x4 b = *(const f32x4*)(base + off + bj * 128 + 4 * n); o[n] = b + g[bj][n] * acc[ai][bj][m][n]; if (NEXT) *(f32x4*)(out + off + bj * 128 + 4 * n) = o[n]; else __builtin_nontemporal_store(o[n], (f32x4*)(out + off + bj * 128 + 4 * n));
                        if (NEXT) ss += (o[n][0] * o[n][0] + o[n][1] * o[n][1]) + (o[n][2] * o[n][2] + o[n][3] * o[n][3]); }
                    if (NEXT) { const f32x4 xa = o[0] * an[bj][0], xb = o[1] * an[bj][1]; u32x4 w; w.x = pkbf(xa[0], xa[1]); w.y = pkbf(xa[2], xa[3]); w.z = pkbf(xb[0], xb[1]); w.w = pkbf(xb[2], xb[3]);
                        *(u32x4*)(XA + off + bj * 128) = w; }
                }
                if (NEXT) { ss += __shfl_xor(ss, 16); ss += __shfl_xor(ss, 32); if (fq == 0) SS[(size_t)row * 16 + u.pn * 4 + wc] = ss; }
            }
    }
};
struct EpiWin {
    static constexpr bool PERM = true, AFTER_DRAIN = false;
    unsigned char* ws; float* outk; const float* qgain; const float* kgain; LAS unsigned char* scr; const LAS float* tbl; int nmax;
    __device__ __forceinline__ void operator()(const f32x4 (&accr)[2][2][4][2], const pg8::Unit& u, int wr, int wc, int fr, int fq) const {
        const int pn = u.pn;
        float* P = (float*)(ws + WS_P); bf16_t* Q = (bf16_t*)(ws + WS_Q); bf16_t* Kb = (bf16_t*)(ws + WS_K); bf16_t* VT = (bf16_t*)(ws + WS_VT); bf16_t* Gt = (bf16_t*)(ws + WS_ACT);
        float* outv = outk + (size_t)NCTX * DATT; const float* bvec = (const float*)(ws + WS_BVIN);
        f32x4 (&acc)[2][2][4][2] = const_cast<f32x4 (&)[2][2][4][2]>(accr);
        { const float* bp = bvec + (size_t)cond_of_pm(u.pm) * DIN + pn * 256 + wc * 32 + 8 * fq; f32x4 bv[2][2];
#pragma unroll
            for (int bj = 0; bj < 2; ++bj)
#pragma unroll
                for (int n = 0; n < 2; ++n) bv[bj][n] = *(const f32x4*)(bp + bj * 128 + 4 * n);
#pragma unroll
            for (int ai = 0; ai < 2; ++ai)
#pragma unroll
                for (int m = 0; m < 4; ++m) { const float rs = u.ord < nmax ? tbl[u.ord * 256 + ai * 128 + wr * 64 + m * 16 + fr] : rstd_of(row_sumsq((const float*)(ws + WS_SS), EPI_ROWS(ai, m), fq));
#pragma unroll
                    for (int bj = 0; bj < 2; ++bj)
#pragma unroll
                        for (int n = 0; n < 2; ++n) acc[ai][bj][m][n] = accr[ai][bj][m][n] * rs + bv[bj][n]; } }

        if (pn < 2) {
            const int col = pn * 256 + wc * 32 + 8 * fq;
#pragma unroll
            for (int ai = 0; ai < 2; ++ai)
#pragma unroll
                for (int m = 0; m < 4; ++m) { float* rp = P + (size_t)EPI_ROWS(ai, m) * DATT + col;
#pragma unroll
                    for (int bj = 0; bj < 2; ++bj)
#pragma unroll
                        for (int n = 0; n < 2; ++n) *(f32x4*)(rp + bj * 128 + 4 * n) = acc[ai][bj][m][n]; }
        } else if (pn < 6) {
            const bool isk = pn >= 4;
            const float* gain = isk ? kgain : qgain;
            const int head = 4 * (pn & 1) + wc;
            f32x4 gn[2][2];
#pragma unroll
            for (int bj = 0; bj < 2; ++bj)
#pragma unroll
                for (int n = 0; n < 2; ++n) gn[bj][n] = *(const f32x4*)(gain + 32 * bj + 8 * fq + 4 * n);
#pragma unroll
            for (int ai = 0; ai < 2; ++ai)
#pragma unroll
                for (int m = 0; m < 4; ++m) {
                    float ss = 0.f;
#pragma unroll
                    for (int bj = 0; bj < 2; ++bj)
#pragma unroll
                        for (int n = 0; n < 2; ++n) { const f32x4 x = acc[ai][bj][m][n]; ss += (x[0] * x[0] + x[1] * x[1]) + (x[2] * x[2] + x[3] * x[3]); }
                    ss += __shfl_xor(ss, 16); ss += __shfl_xor(ss, 32);
                    const float rstd = 1.0f / sqrtf(ss * (1.0f / 64.0f) + EPS);
                    const int row = EPI_ROWS(ai, m);
#pragma unroll
                    for (int bj = 0; bj < 2; ++bj) {
                        const f32x4 a = acc[ai][bj][m][0] * rstd * gn[bj][0], b = acc[ai][bj][m][1] * rstd * gn[bj][1];
                        const int c = head * 64 + 32 * bj + 8 * fq;
                        u32x4 w; w.x = pkbf(a[0], a[1]); w.y = pkbf(a[2], a[3]); w.z = pkbf(b[0], b[1]); w.w = pkbf(b[2], b[3]);
                        if (!isk) *(u32x4*)(Q + (size_t)row * DATT + c) = w;
                        else {
                            const bool ctx = u.pm < 32; const int rl = row - u.pm * 256, tok = ctx ? rl : ((u.pm - 32) & 7) * 256 + rl;
                            const size_t tile = ctx ? (size_t)(u.pm * 8 + head) * 8 + (tok >> 5) : KV_LAT / 2048 + (size_t)(((u.pm - 32) >> 3) * 8 + head) * 64 + (tok >> 5);
                            *(u32x4*)(Kb + tile * 2048 + (2 * bj + (fq >> 1)) * 512 + (32 * (fq & 1) + (tok & 31)) * 8) = w; }
                        if (isk && u.pm < 32) { __builtin_nontemporal_store(a, (f32x4*)(outk + (size_t)row * DATT + c)); __builtin_nontemporal_store(b, (f32x4*)(outk + (size_t)row * DATT + c + 4)); }
                    }
                }
        } else if (pn < 8) {
            const bool ctx = u.pm < 32;
            LAS unsigned char* pad = scr + (wr * 4 + wc) * 1280;
            const int lane_ = fq * 16 + fr, d_ = lane_ & 31, hh_ = lane_ >> 5;
#pragma unroll
            for (int ai = 0; ai < 2; ++ai)
#pragma unroll
                for (int m = 0; m < 4; ++m) {
                    const int rl0 = ai * 128 + wr * 64 + m * 16, row = u.pm * 256 + rl0 + fr, tok0 = ctx ? rl0 : ((u.pm - 32) & 7) * 256 + rl0;
#pragma unroll
                    for (int bj = 0; bj < 2; ++bj) {
                        const int c = (pn - 6) * 256 + bj * 128 + wc * 32 + 8 * fq, head = c >> 6;
                        const f32x4 a = acc[ai][bj][m][0], b = acc[ai][bj][m][1];
                        u32x4 w; w.x = pkbf(a[0], a[1]); w.y = pkbf(a[2], a[3]); w.z = pkbf(b[0], b[1]); w.w = pkbf(b[2], b[3]);
                        *(LAS u32x4*)(pad + fr * 80 + fq * 16) = w;
                        if (ctx) { __builtin_nontemporal_store(a, (f32x4*)(outv + (size_t)row * DATT + c)); __builtin_nontemporal_store(b, (f32x4*)(outv + (size_t)row * DATT + c + 4)); }
                        unsigned short e[8];
#pragma unroll
                        for (int j = 0; j < 8; ++j) e[j] = *(const LAS unsigned short*)(pad + (8 * (j >> 2) + 4 * hh_ + (j & 3)) * 80 + d_ * 2);
                        u32x4 o; o.x = e[0] | ((unsigned)e[1] << 16); o.y = e[2] | ((unsigned)e[3] << 16); o.z = e[4] | ((unsigned)e[5] << 16); o.w = e[6] | ((unsigned)e[7] << 16);
                        const size_t tile = ctx ? (size_t)(u.pm * 8 + head) * 8 + (tok0 >> 5) : KV_LAT / 2048 + (size_t)(((u.pm - 32) >> 3) * 8 + head) * 64 + (tok0 >> 5);
                        *(u32x4*)(VT + tile * 2048 + ((wc & 1) * 2 + ((tok0 >> 4) & 1)) * 512 + lane_ * 8) = o;
                    }
                }
        } else {
            const int col = (pn - 8) * 256 + wc * 32 + 8 * fq;
#pragma unroll
            for (int ai = 0; ai < 2; ++ai)
#pragma unroll
                for (int m = 0; m < 4; ++m) { bf16_t* rp = Gt + (size_t)EPI_ROWS(ai, m) * 2048 + col;
#pragma unroll
                    for (int bj = 0; bj < 2; ++bj) { const f32x4 a = acc[ai][bj][m][0], b = acc[ai][bj][m][1];
                        u32x4 w; w.x = pkbf(fast_sigmoid(a[0]), fast_sigmoid(a[1])); w.y = pkbf(fast_sigmoid(a[2]), fast_sigmoid(a[3]));
                        w.z = pkbf(fast_sigmoid(b[0]), fast_sigmoid(b[1])); w.w = pkbf(fast_sigmoid(b[2]), fast_sigmoid(b[3]));
                        *(u32x4*)(rp + bj * 128) = w; }
                }
        }
    }
};
template <int MODE> struct EpiMix {
    static constexpr bool PERM = true, AFTER_DRAIN = false;
    unsigned char* ws; const float* vec;
    __device__ __forceinline__ void operator()(const f32x4 (&acc)[2][2][4][2], const pg8::Unit& u, int wr, int wc, int fr, int fq) const {
        bf16_t* O = (bf16_t*)(ws + (MODE == 0 ? WS_H + 16 * MiB : MODE == 1 ? WS_K : WS_P)); constexpr int ldo = MODE == 0 ? DATT : DM;
        const bf16_t* Gt = (const bf16_t*)(ws + WS_ACT); const bf16_t* T1 = (const bf16_t*)(ws + WS_K);
        const int col = u.pn * 256 + wc * 32 + 8 * fq;
        f32x4 sv[2][2];
        if (MODE == 0) {
#pragma unroll
            for (int bj = 0; bj < 2; ++bj)
#pragma unroll
                for (int n = 0; n < 2; ++n) sv[bj][n] = *(const f32x4*)(vec + col + bj * 128 + 4 * n);
        }
#pragma unroll
        for (int ai = 0; ai < 2; ++ai)
#pragma unroll
            for (int m = 0; m < 4; ++m) { const int row = EPI_ROWS(ai, m);
#pragma unroll
                for (int bj = 0; bj < 2; ++bj) {
                    f32x4 a = acc[ai][bj][m][0], b = acc[ai][bj][m][1];
                    const int c = col + bj * 128;
                    if (MODE == 0) { a = a * sv[bj][0]; b = b * sv[bj][1]; }
                    else {
                        const u32x4 gw = *(const u32x4*)(Gt + (size_t)row * 2048 + (MODE == 2 ? 1024 : 0) + c);
                        const f32x4 ga = {bflo(gw.x), bfhi(gw.x), bflo(gw.y), bfhi(gw.y)}, gb = {bflo(gw.z), bfhi(gw.z), bflo(gw.w), bfhi(gw.w)};
                        a = a * ga; b = b * gb;
                        if (MODE == 2) { const u32x4 tw = *(const u32x4*)(T1 + (size_t)row * DM + c);
                            a = a + (f32x4){bflo(tw.x), bfhi(tw.x), bflo(tw.y), bfhi(tw.y)}; b = b + (f32x4){bflo(tw.z), bfhi(tw.z), bflo(tw.w), bfhi(tw.w)}; }
                    }
                    u32x4 w; w.x = pkbf(a[0], a[1]); w.y = pkbf(a[2], a[3]); w.z = pkbf(b[0], b[1]); w.w = pkbf(b[2], b[3]);
                    *(u32x4*)(O + (size_t)row * ldo + c) = w;
                }
            }
    }
};

__device__ __forceinline__ unsigned f2bf(float f) { unsigned u = __builtin_bit_cast(unsigned, f); return (u + 0x7fffu + ((u >> 16) & 1u)) >> 16; }
__device__ __forceinline__ unsigned pk2(float lo, float hi) { return f2bf(lo) | (f2bf(hi) << 16); }
__device__ __forceinline__ int dest_row(int mode, int n) {
    if (mode == 1) { const int up = n >= DFF, j = up ? n - DFF : n; return 256 * (j >> 7) + (up ? 128 : 0) + (j & 127); }
    if (mode == 2) { if (n >= 512 && n < 1536) { const int tb = n & ~255, cc = n & 255, hh = cc >> 6, d = cc & 63; return tb + 128 * (d >> 5) + 32 * hh + (d & 31); } return n; }
    return n;
}
__device__ __forceinline__ void tr_item(const float* W, int N, bf16_t* WT, int ldt, int mode, LAS float* scr, int item, int lane, bool nts = false) {
    const int nblk = N / 32, kb = item / nblk, nb = item % nblk, k0 = 64 * kb, n0 = 32 * nb;
#pragma unroll
    for (int i = 0; i < 32; ++i) { const int kk = 2 * i + (lane >> 5); scr[kk * 33 + (lane & 31)] = __builtin_nontemporal_load(W + (size_t)(k0 + kk) * N + n0 + (lane & 31)); }
    asm volatile("s_waitcnt lgkmcnt(0)" ::: "memory");
    const int c = lane & 7;
#pragma unroll
    for (int j = 0; j < 4; ++j) { const int n = (lane >> 3) + 8 * j; const LAS float* s = scr + (8 * c) * 33 + n;
        u32x4 o; o.x = pk2(s[0 * 33], s[1 * 33]); o.y = pk2(s[2 * 33], s[3 * 33]); o.z = pk2(s[4 * 33], s[5 * 33]); o.w = pk2(s[6 * 33], s[7 * 33]);
        if (nts) __builtin_nontemporal_store(o, (u32x4*)(WT + (size_t)dest_row(mode, n0 + n) * ldt + k0 + 8 * c)); else *(u32x4*)(WT + (size_t)dest_row(mode, n0 + n) * ldt + k0 + 8 * c) = o; }
    asm volatile("s_waitcnt lgkmcnt(0)" ::: "memory");
}

struct Args { const float* in[24]; float* out; unsigned char* ws; int ph_lo, ph_hi; };
enum { I_XP = 0, I_XS, I_CK, I_CV, I_C, I_CCTX, I_WADA, I_BADA, I_GFF1, I_WFF1IN, I_WFF1OUT, I_GMIX, I_WIN, I_QG, I_KG, I_WPOOL, I_PSCALE, I_RPB, I_WBP, I_WBA, I_WOUT, I_GFF2, I_WFF2IN, I_WFF2OUT };

__device__ __forceinline__ void phase0(const Args& a, LAS unsigned char* lds, int tid, int lane, int wave, int G) {
    unsigned char* ws = a.ws;
    if ((int)blockIdx.x < 144) {
        LAS float* sc = (LAS float*)lds; LAS float* red = sc + 5 * 1024;
        for (int i = tid; i < 5 * 1024; i += 512) { const float v = i < 1024 ? a.in[I_CCTX][i] : a.in[I_C][i - 1024]; sc[i] = v * fast_sigmoid(v); }
        __syncthreads();
        float* mod = (float*)(ws + WS_MOD);
        for (int u = blockIdx.x; u < 144; u += G) {
            const int rsub = lane >> 4, c4 = (lane & 15) * 4;
            f32x4 acc[5];
#pragma unroll
            for (int c = 0; c < 5; ++c) acc[c] = (f32x4){0.f, 0.f, 0.f, 0.f};
            const float* wp = a.in[I_WADA] + (size_t)(wave * 128 + rsub) * (NMOD * DM) + u * 64 + c4;
            const LAS float* scw = sc + wave * 128 + rsub;
#pragma unroll 8
            for (int i = 0; i < 32; ++i) {
                const f32x4 wv = __builtin_nontemporal_load((const f32x4*)(wp + (size_t)(4 * i) * (NMOD * DM)));
#pragma unroll
                for (int c = 0; c < 5; ++c) acc[c] += wv * scw[c * 1024 + 4 * i];
            }
#pragma unroll
            for (int c = 0; c < 5; ++c)
#pragma unroll
                for (int j = 0; j < 4; ++j) { float v = acc[c][j]; v += __shfl_xor(v, 16); v += __shfl_xor(v, 32); acc[c][j] = v; }
            if (lane < 16) {
#pragma unroll
                for (int c = 0; c < 5; ++c) *(LAS f32x4*)(red + (wave * 5 + c) * 64 + c4) = acc[c]; }
            __syncthreads();
            if (tid < 320) { const int c = tid >> 6, l = tid & 63; float s = 0.f;
#pragma unroll
                for (int w = 0; w < 8; ++w) s += red[(w * 5 + c) * 64 + l];
                mod[c * (NMOD * DM) + u * 64 + l] = s + a.in[I_BADA][u * 64 + l]; }
            __syncthreads();
        }
    }
    LAS float* scr = (LAS float*)(lds + wave * 16384);
    constexpr int I_FIN = 16 * 176, I_IN = 16 * 128, I_FOUT = 44 * 32;
    constexpr int NITEMS = I_FIN + I_IN + I_FOUT;
    const bool bal = (G == 256); const int bx = blockIdx.x;
    if (bal && bx < 144) return;
    const int slot0 = bal ? (bx - 144) * 8 + wave : bx * 8 + wave, nslots = bal ? 112 * 8 : G * 8;
    for (int it = slot0; it < NITEMS; it += nslots) {
        int r = it;
        if (r < I_FIN) { tr_item(a.in[I_WFF1IN], 2 * DFF, (bf16_t*)(ws + WS_FF1IN), DM, 1, scr, r, lane); continue; } r -= I_FIN;
        if (r < I_IN) { tr_item(a.in[I_WIN], DIN, (bf16_t*)(ws + WS_WIN), DM, 2, scr, r, lane); continue; } r -= I_IN;
        tr_item(a.in[I_WFF1OUT], DM, (bf16_t*)(ws + WS_FF1OUT), DFF, 0, scr, r, lane);
    }
}

__device__ __forceinline__ void late_copies(const Args& a, LAS unsigned char* lds, int lane, int wave, int wi, int nw) {
    unsigned char* ws = a.ws;
    LAS float* scr = (LAS float*)(lds + wave * 16384);
    constexpr int I_FIN = 16 * 176, I_FOUT = 44 * 32, I_BR = 8 * 32, I_OUT = 16 * 32, I_FOLD = 4 * 8 * 16;
    constexpr int NITEMS = I_FIN + I_FOUT + I_BR + I_OUT + I_FOLD;
    for (int it = wi; it < NITEMS; it += nw) {
        int r = it;
        if (r < I_FIN) { tr_item(a.in[I_WFF2IN], 2 * DFF, (bf16_t*)(ws + WS_FF2IN), DM, 1, scr, r, lane, true); continue; } r -= I_FIN;
        if (r < I_FOUT) { tr_item(a.in[I_WFF2OUT], DM, (bf16_t*)(ws + WS_FF2OUT), DFF, 0, scr, r, lane, true); continue; } r -= I_FOUT;
        if (r < I_BR) { tr_item(a.in[I_WBA], DM, (bf16_t*)(ws + WS_WBA), DATT, 0, scr, r, lane); continue; } r -= I_BR;
        if (r < I_OUT) { tr_item(a.in[I_WOUT], DM, (bf16_t*)(ws + WS_WOUT), DM, 0, scr, r, lane); continue; } r -= I_OUT;
        {
            const int g = r >> 7, ib = (r >> 4) & 7, n = (r & 15) * 64 + lane;
            const float* wp = a.in[I_WPOOL] + (size_t)g * 128 * 128 + (size_t)(ib * 16) * 128; const float* ps = a.in[I_PSCALE] + g * 128; const float* wb = a.in[I_WBP] + (size_t)(g * 128) * DM + n;
#pragma unroll
            for (int q = 0; q < 8; ++q) { const int e4 = q * 64 + lane, i = e4 >> 5, j4 = (e4 & 31) * 4; const f32x4 w4 = *(const f32x4*)(wp + i * 128 + j4) * *(const f32x4*)(ps + j4); *(LAS f32x4*)(scr + i * 128 + j4) = w4; }
            asm volatile("s_waitcnt lgkmcnt(0)" ::: "memory");
            float acc[16];
#pragma unroll
            for (int i = 0; i < 16; ++i) acc[i] = 0.f;
#pragma unroll 2
            for (int j = 0; j < 128; j += 4) { const float w0 = __builtin_nontemporal_load(wb + (size_t)j * DM), w1 = __builtin_nontemporal_load(wb + (size_t)(j + 1) * DM), w2 = __builtin_nontemporal_load(wb + (size_t)(j + 2) * DM), w3 = __builtin_nontemporal_load(wb + (size_t)(j + 3) * DM);
#pragma unroll
                for (int i = 0; i < 16; ++i) { const f32x4 p4 = *(const LAS f32x4*)(scr + i * 128 + j); acc[i] += (p4[0] * w0 + p4[1] * w1) + (p4[2] * w2 + p4[3] * w3); } }
            asm volatile("s_waitcnt lgkmcnt(0)" ::: "memory");
            u32x4 o0, o1; o0.x = pk2(acc[0], acc[1]); o0.y = pk2(acc[2], acc[3]); o0.z = pk2(acc[4], acc[5]); o0.w = pk2(acc[6], acc[7]);
            o1.x = pk2(acc[8], acc[9]); o1.y = pk2(acc[10], acc[11]); o1.z = pk2(acc[12], acc[13]); o1.w = pk2(acc[14], acc[15]);
            bf16_t* dst = (bf16_t*)(ws + WS_WBP) + (size_t)n * DATT + g * 128 + ib * 16; *(u32x4*)dst = o0; *(u32x4*)(dst + 8) = o1;
        }
    }
    const int gt = wi * 64 + lane, NGT = nw * 64;
    for (int i = gt; i < 2 * 32 * 16 * 256; i += NGT) {
        const int isv = i >= 32 * 16 * 256, ch = isv ? i - 32 * 16 * 256 : i, ln = ch & 63, q4 = (ch >> 6) & 3, tile = (ch >> 8) & 15, bh = ch >> 12, b = bh >> 3, h = bh & 7, r32 = ln & 31, hh = ln >> 5;
        u32x4 o;
        if (!isv) { const float* src = a.in[I_CK] + ((size_t)(b * 512 + tile * 32 + r32) * 8 + h) * 64 + 16 * q4 + 8 * hh; const f32x4 v0 = __builtin_nontemporal_load((const f32x4*)src), v1 = __builtin_nontemporal_load((const f32x4*)(src + 4));
            o.x = pk2(v0[0], v0[1]); o.y = pk2(v0[2], v0[3]); o.z = pk2(v1[0], v1[1]); o.w = pk2(v1[2], v1[3]);
            *(u32x4*)((bf16_t*)(ws + WS_KC) + (size_t)ch * 8) = o; }
        else { const int t = q4 >> 1, sK = q4 & 1; float v[8];
#pragma unroll
            for (int j = 0; j < 8; ++j) { const int key = 16 * sK + 8 * (j >> 2) + 4 * hh + (j & 3); v[j] = __builtin_nontemporal_load(a.in[I_CV] + ((size_t)(b * 512 + tile * 32 + key) * 8 + h) * 64 + 32 * t + r32); }
            o.x = pk2(v[0], v[1]); o.y = pk2(v[2], v[3]); o.z = pk2(v[4], v[5]); o.w = pk2(v[6], v[7]);
            *(u32x4*)((bf16_t*)(ws + WS_VTC) + (size_t)ch * 8) = o; }
    }
}

__device__ __forceinline__ void norm_phase(const float* src0, const float* src1, const float* gvec, const float* mod, int mi, bf16_t* H, int G, int wave, int lane) {
    for (int rb = blockIdx.x; rb < NTOK / 64; rb += G) {
        const int rbase = rb * 64, cond = rbase < NCTX ? 0 : 1 + ((rbase - NCTX) >> 11);
        const float* sh = mod + (size_t)cond * (NMOD * DM) + mi * DM; const float* scl = sh + DM;
        f32x4 av[4], sv[4];
#pragma unroll
        for (int j = 0; j < 4; ++j) { const int c = 4 * lane + 256 * j; av[j] = *(const f32x4*)(gvec + c) * (*(const f32x4*)(scl + c) + 1.0f); sv[j] = *(const f32x4*)(sh + c); }
        for (int i0 = 0; i0 < 8; i0 += 4) {
            f32x4 v[4][4]; float s[4];
#pragma unroll
            for (int i = 0; i < 4; ++i) {
                const int row = rbase + wave * 8 + i0 + i;
                const float* xr = row < NCTX ? src0 + (size_t)row * DM : src1 + (size_t)(row - NCTX) * DM;
#pragma unroll
                for (int j = 0; j < 4; ++j) v[i][j] = __builtin_nontemporal_load((const f32x4*)(xr + 4 * lane + 256 * j));
            }
#pragma unroll
            for (int i = 0; i < 4; ++i) { s[i] = 0.f;
#pragma unroll
                for (int j = 0; j < 4; ++j) s[i] += (v[i][j][0] * v[i][j][0] + v[i][j][1] * v[i][j][1]) + (v[i][j][2] * v[i][j][2] + v[i][j][3] * v[i][j][3]); }
#pragma unroll
            for (int o = 1; o < 64; o <<= 1) {
#pragma unroll
                for (int i = 0; i < 4; ++i) s[i] += __shfl_xor(s[i], o); }
#pragma unroll
            for (int i = 0; i < 4; ++i) {
                const int row = rbase + wave * 8 + i0 + i;
                const float rstd = 1.0f / sqrtf(s[i] * (1.0f / DM) + EPS);
#pragma unroll
                for (int j = 0; j < 4; ++j) { const f32x4 o = v[i][j] * rstd * av[j] + sv[j]; u32x2 w; w.x = pkbf(o[0], o[1]); w.y = pkbf(o[2], o[3]); *(u32x2*)(H + (size_t)row * DM + 4 * lane + 256 * j) = w; }
            }
        }
    }
}

__device__ __forceinline__ void bvec_items(const bf16_t* Bt, int N, const float* mod, int mi, float* out, int gw, int NGW, int lane) {
    float sh[5][16];
#pragma unroll
    for (int c = 0; c < 5; ++c)
#pragma unroll
        for (int q = 0; q < 4; ++q) { const f32x4 v = *(const f32x4*)(mod + (size_t)c * (NMOD * DM) + mi * DM + 16 * lane + 4 * q); sh[c][4 * q] = v[0]; sh[c][4 * q + 1] = v[1]; sh[c][4 * q + 2] = v[2]; sh[c][4 * q + 3] = v[3]; }
    for (int n = gw; n < N; n += NGW) {
        const u32x4 w0 = *(const u32x4*)(Bt + (size_t)n * DM + 16 * lane), w1 = *(const u32x4*)(Bt + (size_t)n * DM + 16 * lane + 8);
        const float w[16] = {bflo(w0.x), bfhi(w0.x), bflo(w0.y), bfhi(w0.y), bflo(w0.z), bfhi(w0.z), bflo(w0.w), bfhi(w0.w), bflo(w1.x), bfhi(w1.x), bflo(w1.y), bfhi(w1.y), bflo(w1.z), bfhi(w1.z), bflo(w1.w), bfhi(w1.w)};
        float acc[5];
#pragma unroll
        for (int c = 0; c < 5; ++c) { float a = 0.f;
#pragma unroll
            for (int k = 0; k < 16; ++k) a += sh[c][k] * w[k];
            acc[c] = a; }
#pragma unroll
        for (int o = 1; o < 64; o <<= 1) {
#pragma unroll
            for (int c = 0; c < 5; ++c) acc[c] += __shfl_xor(acc[c], o); }
        if (lane == 0) {
#pragma unroll
            for (int c = 0; c < 5; ++c) out[(size_t)c * N + n] = acc[c]; }
    }
}

__device__ __forceinline__ int crow(int r, int hh) { return (r & 3) + 8 * (r >> 2) + 4 * hh; }
#define MFMA32(a, b, c) __builtin_amdgcn_mfma_f32_32x32x16_bf16((a), (b), (c), 0, 0, 0)
struct KVFrag { bf16x8 k[4]; bf16x8 v[4]; };
__device__ __forceinline__ void kv_load(KVFrag& f, const bf16_t* kt, const bf16_t* vt, int lane) {
#pragma unroll
    for (int i = 0; i < 4; ++i) { f.k[i] = *(const bf16x8*)(kt + i * 512 + lane * 8); f.v[i] = *(const bf16x8*)(vt + i * 512 + lane * 8); }
}
struct AttnState { f32x16 o0, o1; float mrun, lrun; };
template <bool LOCAL, int FAR = 0> __device__ __forceinline__ void attn_tile(AttnState& st, const KVFrag& f, const bf16x8 (&qf)[4], const LAS float* bq, int okb) {
    constexpr float C2 = 0.125f * LOG2E;
    constexpr int R0 = FAR == 2 ? 12 : 0, R1 = FAR == 1 ? 4 : 16;
    f32x16 s;
#pragma unroll
    for (int r = 0; r < 16; ++r) s[r] = 0.f;
#pragma unroll
    for (int d0 = 0; d0 < 4; ++d0) s = MFMA32(f.k[d0], qf[d0], s);
    if (LOCAL) {
#pragma unroll
        for (int r = R0; r < R1; ++r) { const int cr = (r & 3) + 8 * (r >> 2); const bool ok = (unsigned)(okb + cr) < 16u; s[r] = ok ? __builtin_fmaf(s[r], C2, bq[cr]) : -1e30f; }
    }
    float mx = s[R0];
#pragma unroll
    for (int r = R0 + 1; r < R1; ++r) mx = fmaxf(mx, s[r]);
    if (!LOCAL) mx *= C2;
    mx = fmaxf(mx, __shfl_xor(mx, 32));
    const float mnew = fmaxf(st.mrun, mx);
    if (__builtin_amdgcn_ballot_w64(mnew > st.mrun) != 0ull) {
        const float alpha = __builtin_amdgcn_exp2f(st.mrun - mnew);
        st.lrun *= alpha;
#pragma unroll
        for (int r = 0; r < 16; ++r) { st.o0[r] *= alpha; st.o1[r] *= alpha; }
        st.mrun = mnew;
    }
    float ps = 0.f;
#pragma unroll
    for (int r = 0; r < 16; ++r) { if (r >= R0 && r < R1) { s[r] = __builtin_amdgcn_exp2f(LOCAL ? s[r] - mnew : __builtin_fmaf(s[r], C2, -mnew)); ps += s[r]; } else s[r] = 0.f; }
    st.lrun += ps;
    u32x4 p0, p1;
    p0.x = pkbf(s[0], s[1]); p0.y = pkbf(s[2], s[3]); p0.z = pkbf(s[4], s[5]); p0.w = pkbf(s[6], s[7]);
    p1.x = pkbf(s[8], s[9]); p1.y = pkbf(s[10], s[11]); p1.z = pkbf(s[12], s[13]); p1.w = pkbf(s[14], s[15]);
    const bf16x8 pb0 = __builtin_bit_cast(bf16x8, p0), pb1 = __builtin_bit_cast(bf16x8, p1);
    if (FAR != 2) { st.o0 = MFMA32(f.v[0], pb0, st.o0); st.o1 = MFMA32(f.v[2], pb0, st.o1); }
    if (FAR != 1) { st.o0 = MFMA32(f.v[1], pb1, st.o0); st.o1 = MFMA32(f.v[3], pb1, st.o1); }
}
__device__ __forceinline__ void attn_wave(const bf16_t* Qp, bf16_t* Op, int nd, const bf16_t* KFd, const bf16_t* VFd,
                                          int nl, const bf16_t* KFl, const bf16_t* VFl, int rq, int r0, int g, const LAS float* rpbh, int lane) {
    const int r32 = lane & 31, hh = lane >> 5;
    bf16x8 qf[4];
#pragma unroll
    for (int d0 = 0; d0 < 4; ++d0) qf[d0] = *(const bf16x8*)(Qp + (size_t)r32 * DATT + d0 * 16 + 8 * hh);
    AttnState st;
#pragma unroll
    for (int r = 0; r < 16; ++r) { st.o0[r] = 0.f; st.o1[r] = 0.f; }
    st.mrun = -1e30f; st.lrun = 0.f;
    const int nt = nd + nl;
    const int qc = 32 * g + r32; int c0 = qc - 8; c0 = c0 < 0 ? 0 : (c0 > 48 ? 48 : c0);
    KVFrag f0, f1, f2;
#define ATT_LOAD(f, ti) do { const int ti_ = (ti); if (ti_ < nt) { if (ti_ < nd) kv_load(f, KFd + (size_t)ti_ * 2048, VFd + (size_t)ti_ * 2048, lane); \
        else { const int tx_ = 2 * r0 + (ti_ - nd); kv_load(f, KFl + (size_t)tx_ * 2048, VFl + (size_t)tx_ * 2048, lane); } } } while (0)
#define ATT_TILE(f, ti) do { const int ti_ = (ti); if (ti_ < nt) { if (ti_ < nd) attn_tile<false, 0>(st, f, qf, nullptr, 0); \
        else { const int tl_ = ti_ - nd, kb_ = 32 * (tl_ & 1) + 4 * hh; const LAS float* bq_ = rpbh + (r0 + (tl_ >> 1) - rq + 7) * 31 + (kb_ - qc + 15); \
            if ((tl_ & 1) == g) attn_tile<true, 0>(st, f, qf, bq_, kb_ - c0); else if (g == 0) attn_tile<true, 1>(st, f, qf, bq_, kb_ - c0); else attn_tile<true, 2>(st, f, qf, bq_, kb_ - c0); } } } while (0)
    ATT_LOAD(f0, 0); ATT_LOAD(f1, 1);
    for (int ti = 0; ti < nt; ti += 3) {
        ATT_LOAD(f2, ti + 2); ATT_TILE(f0, ti);
        ATT_LOAD(f0, ti + 3); ATT_TILE(f1, ti + 1);
        ATT_LOAD(f1, ti + 4); ATT_TILE(f2, ti + 2);
    }
#undef ATT_LOAD
#undef ATT_TILE
    float lrun = st.lrun; lrun += __shfl_xor(lrun, 32);
    const float inv = 1.0f / lrun;
    bf16_t* op = Op + (size_t)r32 * DATT + 4 * hh;
#pragma unroll
    for (int rg = 0; rg < 4; ++rg) {
        u32x2 w; w.x = pkbf(st.o0[4 * rg] * inv, st.o0[4 * rg + 1] * inv); w.y = pkbf(st.o0[4 * rg + 2] * inv, st.o0[4 * rg + 3] * inv); *(u32x2*)(op + 8 * rg) = w;
        u32x2 x; x.x = pkbf(st.o1[4 * rg] * inv, st.o1[4 * rg + 1] * inv); x.y = pkbf(st.o1[4 * rg + 2] * inv, st.o1[4 * rg + 3] * inv); *(u32x2*)(op + 32 + 8 * rg) = x;
    }
}

template <int HW> __device__ __forceinline__ void dpass_item(const float* ps, bf16_t* ds, int t0, int L) {
    f32x2_t x[32 + 2 * HW];
#pragma unroll
    for (int j = 0; j < 32 + 2 * HW; ++j) { const int t = t0 - HW + j; const bool ok = t >= 0 && t < L; const f32x2_t v = *(const f32x2_t*)(ps + (size_t)(ok ? t : t0) * DATT); x[j] = ok ? v : (f32x2_t){0.f, 0.f}; }
    f32x2_t s = {0.f, 0.f};
#pragma unroll
    for (int j = 0; j < 2 * HW; ++j) s += x[j];
#pragma unroll
    for (int i = 0; i < 32; ++i) {
        const int t = t0 + i; const int lo = t - HW < 0 ? 0 : t - HW, hi = t + HW > L ? L : t + HW;
        const f32x2_t d = s * (1.0f / (float)(hi - lo)) - x[i + HW];
        *(unsigned*)(ds + (size_t)t * DATT) = pkbf(d[0], d[1]);
        if (i < 31) s += x[i + 2 * HW] - x[i];
    }
}

__device__ __forceinline__ void mixer_phase(const Args& a, LAS unsigned char* lds, int tid, int lane, int wave, int G, int what, int vb) {
    unsigned char* ws = a.ws;
    if (what & 1) {
    const bf16_t* Q = (const bf16_t*)(ws + WS_Q); const bf16_t* Kb = (const bf16_t*)(ws + WS_K); const bf16_t* VT = (const bf16_t*)(ws + WS_VT);
    const bf16_t* KC = (const bf16_t*)(ws + WS_KC); const bf16_t* VTC = (const bf16_t*)(ws + WS_VTC);
    bf16_t* ATT = (bf16_t*)(ws + WS_H);
    LAS float* rpbl = (LAS float*)(lds + 1024);
    for (int i = tid; i < 8 * 15 * 31; i += 512) rpbl[i] = a.in[I_RPB][i] * LOG2E;
    __syncthreads();
    for (int u = vb; u < 256; u += G) {
        {
            const int ul = (u & 7) * 32 + (u >> 3), bh = ul >> 3, b = bh >> 3, h = bh & 7, rq = 4 * (ul & 7) + (wave >> 1), g = wave & 1;
            int r0 = rq - 4; r0 = r0 < 0 ? 0 : (r0 > 24 ? 24 : r0);
            const size_t row0 = (size_t)NCTX + (size_t)b * 2048 + rq * 64 + 32 * g;
            attn_wave(Q + row0 * DATT + h * 64, ATT + row0 * DATT + h * 64, 16, KC + (size_t)bh * 16 * 2048, VTC + (size_t)bh * 16 * 2048,
                      16, Kb + KV_LAT + (size_t)bh * 64 * 2048, VT + KV_LAT + (size_t)bh * 64 * 2048, rq, r0, g, rpbl + h * 15 * 31, lane);
        }
        {
            const int b = u >> 3, h = u & 7;
            const size_t row0 = (size_t)b * 256 + 32 * wave;
            attn_wave(Q + row0 * DATT + h * 64, ATT + row0 * DATT + h * 64, 8, Kb + (size_t)u * 8 * 2048, VT + (size_t)u * 8 * 2048,
                      0, Kb, VT, 0, 0, 0, rpbl, lane);
        }
    }
    }
    if (!(what & 2)) return;
    const float* P = (const float*)(ws + WS_P); bf16_t* D = (bf16_t*)(ws + WS_ACT + 64 * MiB);
    const int gw = blockIdx.x * 8 + wave, NGW = G * 8;
    for (int it = gw; it < (NTOK / 32) * 4; it += NGW) {
        const int g = it & 3, row0 = (it >> 2) * 32;
        int t0, L; if (row0 < NCTX) { t0 = row0 & 255; L = 256; } else { t0 = (row0 - NCTX) & 2047; L = 2048; }
        const float* ps = P + (size_t)(row0 - t0) * DATT + g * 128 + 2 * lane; bf16_t* ds = D + (size_t)(row0 - t0) * DATT + g * 128 + 2 * lane;
        if (g == 0) dpass_item<1>(ps, ds, t0, L); else if (g == 1) dpass_item<2>(ps, ds, t0, L); else if (g == 2) dpass_item<4>(ps, ds, t0, L); else dpass_item<8>(ps, ds, t0, L);
    }
}


typedef unsigned v4u __attribute__((ext_vector_type(4)));
#define XB_TMO      128
#define XB_XCNT(j)  (256  + 64 * (j))
#define XB_XSUB(j)  (1280 + 64 * (j))
#define XB_XGEN(j)  (2304 + 64 * (j))
#define XB_TOP      3328
#define XB_TOPGEN   3392
#define XCD_BAR_WORDS 3456
#define XB_SPIN_CAP (1u << 18)

__device__ __forceinline__ unsigned xb_ld(unsigned* p)              { return __hip_atomic_load(p, __ATOMIC_RELAXED, __HIP_MEMORY_SCOPE_AGENT); }
__device__ __forceinline__ unsigned xb_add(unsigned* p, unsigned v) { return __hip_atomic_fetch_add(p, v, __ATOMIC_RELAXED, __HIP_MEMORY_SCOPE_AGENT); }
__device__ __forceinline__ unsigned xb_xcc_id() { return (unsigned)__builtin_amdgcn_s_getreg((3 << 11) | 20) & 0xFu; }
#define XB_SPIN(cond, bar) do { unsigned _sp = 0; while (cond) { __builtin_amdgcn_s_sleep(1); \
    if ((++_sp & 255u) == 0u) { if (xb_ld(&(bar)[XB_TMO])) break; if (_sp > XB_SPIN_CAP) { atomicAdd(&(bar)[XB_TMO], 1u); break; } } } } while (0)

struct XcdBarrier {
    unsigned* bar; unsigned x;
    volatile LAS unsigned* st;
};

__device__ __forceinline__ XcdBarrier xcd_barrier_post(unsigned* bar, volatile LAS unsigned* st) {
    XcdBarrier b; b.bar = bar; b.x = xb_xcc_id(); b.st = st;
    if (threadIdx.x == 0) st[2] = xb_add(&bar[XB_XCNT(b.x)], 1u);
    return b;
}
__device__ __forceinline__ void xcd_barrier_complete(unsigned* bar, unsigned x, unsigned& nloc, unsigned& nx) {
    const unsigned G = gridDim.x * gridDim.y * gridDim.z;
    unsigned sum, cnt, mine, sp = 0u;
    for (;;) {
        sum = 0u; cnt = 0u; mine = 0u;
#pragma unroll
        for (unsigned j = 0; j < 16; ++j) { const unsigned c = xb_ld(&bar[XB_XCNT(j)]); sum += c; cnt += (c > 0u) ? 1u : 0u; mine = (j == x) ? c : mine; }
        if (sum == G) break;
        __builtin_amdgcn_s_sleep(1);
        if ((++sp & 255u) == 0u) { if (xb_ld(&bar[XB_TMO])) break; if (sp > XB_SPIN_CAP) { atomicAdd(&bar[XB_TMO], 1u); break; } }
    }
    nloc = mine > 0u ? mine : 1u; nx = cnt > 0u ? cnt : 1u;
}

__device__ __forceinline__ void xcd_barrier(const XcdBarrier& b) {
    asm volatile("s_waitcnt vmcnt(0)" ::: "memory");
    __syncthreads();
    if (threadIdx.x == 0) {
        unsigned* bar = b.bar;
        __builtin_amdgcn_s_waitcnt(0);
        unsigned nloc = b.st[0], nx = b.st[1];
        if (nloc == 0u) { xcd_barrier_complete(bar, b.x, nloc, nx); b.st[0] = nloc; b.st[1] = nx; }
        const unsigned old = xb_add(&bar[XB_XSUB(b.x)], 1u);
        const unsigned gen = old / nloc;
        if (old + 1u == (gen + 1u) * nloc) {
            __builtin_amdgcn_fence(__ATOMIC_RELEASE, "agent");
            asm volatile("s_waitcnt vmcnt(0)" ::: "memory");
            const unsigned og = xb_add(&bar[XB_TOP], 1u);
            const unsigned tg = og / nx;
            if (og + 1u == (tg + 1u) * nx) xb_add(&bar[XB_TOPGEN], 1u);
            else XB_SPIN(xb_ld(&bar[XB_TOPGEN]) == tg, bar);
            __builtin_amdgcn_fence(__ATOMIC_ACQUIRE, "agent");
            xb_add(&bar[XB_XGEN(b.x)], 1u);
            asm volatile("s_waitcnt vmcnt(0)" ::: "memory");
        } else {
            XB_SPIN(xb_ld(&bar[XB_XGEN(b.x)]) == gen, bar);
            __builtin_amdgcn_fence(__ATOMIC_ACQUIRE, "agent");
            asm volatile("s_waitcnt vmcnt(0)" ::: "memory");
        }
    }
    __syncthreads();
}

#ifndef PROBE_DUP
#define PROBE_DUP -1
#endif
constexpr int LDS_BYTES = 147456;
__global__ void __launch_bounds__(512, 2) mk_fwd(Args args) {
    extern __shared__ __attribute__((aligned(16))) unsigned char lds_raw[];
    LAS unsigned char* lds = (LAS unsigned char*)lds_raw;
    cg::grid_group grid = cg::this_grid();
    const int tid = threadIdx.x, lane = tid & 63, wave = __builtin_amdgcn_readfirstlane(tid >> 6), G = gridDim.x;
    unsigned char* ws = args.ws;
    const int lo = args.ph_lo, hi = args.ph_hi;
    if (tid < 64) ((LAS unsigned*)(lds + 131072))[tid] = 0u;
    __syncthreads();
    XcdBarrier bar = xcd_barrier_post((unsigned*)(ws + WS_CTL), (volatile LAS unsigned*)(lds + 131072 + 64));
    if (hi > 1000) grid.sync();
    const float* mod = (const float*)(ws + WS_MOD);
    float* Y = args.out + OUT_Y;
    bf16_t* H = (bf16_t*)(ws + WS_H); bf16_t* ACT = (bf16_t*)(ws + WS_ACT);
#define IN(k) (lo <= (k) && (k) < hi)
#define SEAM(k) do { if (IN(k) && IN((k) + 1)) xcd_barrier(bar); } while (0)
#define GEMM_PHASE(EPI, e, Aptr, Bptr, N_, K_) do { pg8::Gemm g_{(const bf16_t*)(Aptr), (const bf16_t*)(Bptr), NTOK, (N_), (K_)}; pg8::StaticOrder S_; S_.init(NTOK, (N_), G, vb); \
        pg8::gemm_phase<EPI, pg8::StaticOrder, true, true>(lds, g_, S_, e); } while (0)

    float* SSb = (float*)(ws + WS_SS); float* BVIN = (float*)(ws + WS_BVIN); float* BVFF2 = (float*)(ws + WS_BVFF2);
    const int gwv = blockIdx.x * 8 + wave, NGWv = G * 8;
#define PHASE(k, ...) if (IN(k)) { __VA_ARGS__ if (PROBE_DUP == (k)) { xcd_barrier(bar); __VA_ARGS__ } }
    PHASE(0, { phase0(args, lds, tid, lane, wave, G); }) SEAM(0);
    int vb = blockIdx.x;
    if (IN(0) && IN(1)) {
        volatile LAS unsigned* stw = (volatile LAS unsigned*)(lds + 131072 + 64);
        if (tid == 0) { const unsigned* bw = (const unsigned*)(ws + WS_CTL); bool ok = (G % 8 == 0) && bar.x < 8u;
            for (int j = 0; j < 8; ++j) ok = ok && (xb_ld((unsigned*)&bw[XB_XCNT(j)]) == (unsigned)(G / 8));
            stw[3] = ok ? (stw[2] * 8u + bar.x) : (unsigned)blockIdx.x; }
        __syncthreads();
        vb = (int)stw[3];
    }
    vb = __builtin_amdgcn_readfirstlane(vb);
    PHASE(1, { norm_phase(args.in[I_XP], args.in[I_XS], args.in[I_GFF1], mod, 0, H, G, wave, lane);
               bvec_items((const bf16_t*)(ws + WS_WIN), DIN, mod, 3, BVIN, gwv, NGWv, lane); }) SEAM(1);
    PHASE(2, { EpiSwiGLU<false> e{ws, nullptr, 0}; GEMM_PHASE(EpiSwiGLU<false>, e, H, ws + WS_FF1IN, 2 * DFF, DM);
               if (G == 256) { if (vb >= 128) late_copies(args, lds, lane, wave, (vb - 128) * 8 + wave, 1024); } else late_copies(args, lds, lane, wave, vb * 8 + wave, G * 8); }) SEAM(2);
    PHASE(3, { typedef EpiResid<true, 2, 1, 3> E3; E3 e{args.in[I_XP], (long)(args.in[I_XS] - args.in[I_XP]) - (long)NCTX * DM, Y, ws, args.in[I_GMIX]}; GEMM_PHASE(E3, e, ACT, ws + WS_FF1OUT, DM, DFF); }) SEAM(3);
    PHASE(4, { LAS float* tbl = (LAS float*)(lds + 141824); { pg8::StaticOrder S_; S_.init(NTOK, DIN, G, vb); rstd_table(SSb, S_, tbl, 5, tid); }
               EpiWin e{ws, args.out + OUT_K, args.in[I_QG], args.in[I_KG], lds + 131072 + 512, tbl, 5};
               GEMM_PHASE(EpiWin, e, H, ws + WS_WIN, DIN, DM); }) SEAM(4);
    PHASE(5, { mixer_phase(args, lds, tid, lane, wave, G, 3, vb); bvec_items((const bf16_t*)(ws + WS_FF2IN), 2 * DFF, mod, 6, BVFF2, gwv, NGWv, lane); }) SEAM(5);
    PHASE(6, { { EpiMix<1> e{ws, nullptr}; GEMM_PHASE(EpiMix<1>, e, ws + WS_ACT + 64 * MiB, ws + WS_WBP, DM, DATT); }
               { EpiMix<2> e{ws, nullptr}; GEMM_PHASE(EpiMix<2>, e, H, ws + WS_WBA, DM, DATT); } }) SEAM(6);
    if (IN(7)) { typedef EpiResid<true, 5, 2, 6> E8; E8 e{Y, 0L, Y, ws, args.in[I_GFF2]}; GEMM_PHASE(E8, e, ws + WS_P, ws + WS_WOUT, DM, DM); } SEAM(7);
    PHASE(8, { LAS float* tbl = (LAS float*)(lds + 131072 + 512); { pg8::StaticOrder S_; S_.init(NTOK, 2 * DFF, G, vb); rstd_table(SSb, S_, tbl, 15, tid); }
               EpiSwiGLU<true> e{ws, tbl, 15}; GEMM_PHASE(EpiSwiGLU<true>, e, H, ws + WS_FF2IN, 2 * DFF, DM); }) SEAM(8);
    if (IN(9)) { typedef EpiResid<false, 8, 1, 0> E10; E10 e{Y, 0L, Y, ws, nullptr}; GEMM_PHASE(E10, e, ACT, ws + WS_FF2OUT, DM, DFF); }
}

#ifndef MK_PER_PHASE
#define MK_PER_PHASE 0
#endif
extern "C" void kernel_launch(void* const* d_in, const int* in_sizes, int n_in, void* d_out, int out_size, void* d_ws, size_t ws_size, hipStream_t stream) {
    static int grid = 0;
    if (grid == 0) {
        if (n_in != 24 || ws_size < WS_END) { fprintf(stderr, "kernel_launch: unexpected n_in %d / ws_size %zu (need %zu)\n", n_in, ws_size, (size_t)WS_END); grid = -1; return; }
        int dev = 0, cus = 0, per_cu = 0;
        hipGetDevice(&dev); hipDeviceGetAttribute(&cus, hipDeviceAttributeMultiprocessorCount, dev);
        if (hipFuncSetAttribute((const void*)mk_fwd, hipFuncAttributeMaxDynamicSharedMemorySize, LDS_BYTES) != hipSuccess) { fprintf(stderr, "kernel_launch: hipFuncSetAttribute failed\n"); grid = -1; return; }
        if (hipOccupancyMaxActiveBlocksPerMultiprocessor(&per_cu, (const void*)mk_fwd, 512, LDS_BYTES) != hipSuccess || per_cu < 1) { fprintf(stderr, "kernel_launch: occupancy query says %d\n", per_cu); per_cu = 1; }
        (void)hipGetLastError();
        grid = cus * per_cu;
        fprintf(stderr, "kernel_launch: grid %d (cus %d x %d), ws %zu\n", grid, cus, per_cu, ws_size);
    }
    if (grid < 0) return;
    if (hipMemsetAsync((char*)d_ws + WS_CTL, 0, CTL_BYTES, stream) != hipSuccess) { fprintf(stderr, "kernel_launch: memset failed\n"); return; }
    Args a{};
    for (int i = 0; i < 24; ++i) a.in[i] = (const float*)d_in[i];
    a.out = (float*)d_out; a.ws = (unsigned char*)d_ws;
#if MK_PER_PHASE
    for (int p = 0; p < 10; ++p) { a.ph_lo = p; a.ph_hi = p + 1; hipLaunchKernelGGL(mk_fwd, dim3(grid), dim3(512), LDS_BYTES, stream, a); }
#else
    a.ph_lo = 0; a.ph_hi = 10;
    void* kargs[] = {&a};
    hipError_t e = hipLaunchCooperativeKernel((const void*)mk_fwd, dim3(grid), dim3(512), kargs, LDS_BYTES, stream);
    if (e != hipSuccess) fprintf(stderr, "kernel_launch: cooperative launch failed: %s (grid %d)\n", hipGetErrorString(e), grid);
#endif
}
```

```cpp
#include <hip/hip_runtime.h>
#include <hip/hip_cooperative_groups.h>
#include <cstdio>
#include <cstdint>
namespace cg = cooperative_groups;
namespace pg8 {
#define PG8_LAS __attribute__((address_space(3)))
typedef unsigned short bf16_t;
typedef short bf16x8 __attribute__((ext_vector_type(8)));
typedef float f32x4 __attribute__((ext_vector_type(4)));
typedef unsigned u32x4 __attribute__((ext_vector_type(4)));
constexpr int BM = 256, BK = 64, HALF = 128, HTB = HALF * BK * 2  , STAGE_BYTES = 8 * HTB, NXCD = 8, WGM = 8;

__host__ __device__ __forceinline__ int lds_byte(int r, int c) { const int st = (r >> 4) * 2 + (c >> 5), rr = r & 15, cc = c & 31, ob = rr * 64 + cc * 2; return st * 1024 + (ob ^ (((ob >> 9) & 1) << 5)); }
__host__ __device__ __forceinline__ void stage_rc(int b, int& R, int& C) { const int st = b / 1024, sb = b % 1024, swz = sb ^ (((sb >> 9) & 1) << 5); R = (st >> 1) * 16 + swz / 64; C = (st & 1) * 32 + (swz % 64) / 2; }
__host__ __device__ __forceinline__ int perm32(int rho) { const int n = rho >> 4, i = rho & 15; return 8 * (i >> 2) + 4 * n + (i & 3); }

struct Unit { int pm, pn, ord; };
struct Gemm { const bf16_t* A; const bf16_t* Bt; int M, N, K; };

struct StaticOrder {
    int nM, nN, nwg, G, c;
    __host__ __device__ __forceinline__ void init(int M, int N, int G_, int c_) { nM = M / BM; nN = N / BM; nwg = nM * nN; G = G_; c = c_; }
    __host__ __device__ __forceinline__ bool next(int i, Unit& u) const {
        const long L = (long)i * G + c; if (L >= nwg) return false;
        int wgid = (int)L; { const int q = nwg / NXCD, r = nwg % NXCD, xcd = wgid % NXCD, off = wgid / NXCD; wgid = (xcd < r ? xcd * (q + 1) : r * (q + 1) + (xcd - r) * q) + off; }
        const int nig = WGM * nN, gid = wgid / nig, fm = gid * WGM, gsz = (nM - fm) < WGM ? (nM - fm) : WGM;
        u.pm = fm + ((wgid % nig) % gsz); u.pn = (wgid % nig) / gsz; u.ord = i; return true;
    }
    __device__ __forceinline__ void a_ready(const Unit&) const {}
    __device__ __forceinline__ void done(const Unit&) const {}
};

__device__ __forceinline__ unsigned cvt_pk_bf16(float lo, float hi) { unsigned r; asm volatile("v_cvt_pk_bf16_f32 %0, %1, %2" : "=v"(r) : "v"(lo), "v"(hi)); return r; }
template <class Epi, class Sched, bool ALIGN_EPI = false, bool SP2 = false, bool PRE = false>
__device__ __forceinline__ void gemm_phase(PG8_LAS unsigned char* lds, const Gemm g, const Sched S, const Epi E) {
    const int tid = threadIdx.x, wid = __builtin_amdgcn_readfirstlane(tid >> 6), lane = tid & 63, wr = wid >> 2, wc = wid & 3, fr = lane & 15, fq = lane >> 4;
    const int K = g.K, nt = K / BK;
    unsigned voffA[2], voffB[2];
#pragma unroll
    for (int i = 0; i < 2; ++i) { int R, C; stage_rc(tid * 16 + i * 8192, R, C); const int Rb = Epi::PERM ? ((R & ~31) + perm32(R & 31)) : R;
        voffA[i] = (unsigned)(R * K + C) * 2u; voffB[i] = (unsigned)(Rb * K + C) * 2u; }
    const size_t kstep = (size_t)(BK * 2);
    const size_t hstep = (size_t)HALF * K * 2;
    const size_t tstep = 2 * hstep;
    const unsigned ldsw = (unsigned)wid * 1024u;
    const int aoff = lds_byte(wr * 64 + fr, fq * 8), boff = lds_byte(wc * 32 + fr, fq * 8);
#define PG8_SA(b, h) (((b) * 2 + (h)) * HTB)
#define PG8_SB(b, h) ((4 + (b) * 2 + (h)) * HTB)
#define PG8_STAGE(bufoff, gbase, voff) do { _Pragma("unroll") for (int _i = 0; _i < 2; ++_i) \
        __builtin_amdgcn_global_load_lds((const unsigned*)((const char*)(gbase) + (voff)[_i]), (PG8_LAS unsigned*)(lds + (bufoff) + ldsw + _i * 8192), 16, 0, 0); } while (0)
#define PG8_LDA(dst, b, h) do { _Pragma("unroll") for (int m = 0; m < 4; ++m) _Pragma("unroll") for (int k = 0; k < 2; ++k) dst[m][k] = *(const PG8_LAS bf16x8*)(lds + PG8_SA(b, h) + aoff + m * 2048 + k * 1024); } while (0)
#define PG8_LDB(dst, b, h) do { _Pragma("unroll") for (int n = 0; n < 2; ++n) _Pragma("unroll") for (int k = 0; k < 2; ++k) dst[n][k] = *(const PG8_LAS bf16x8*)(lds + PG8_SB(b, h) + boff + n * 2048 + k * 1024); } while (0)
#define PG8_MMA(ai, bj, At, Bt) do { __builtin_amdgcn_s_setprio(1); _Pragma("unroll") for (int m = 0; m < 4; ++m) _Pragma("unroll") for (int n = 0; n < 2; ++n) _Pragma("unroll") for (int k = 0; k < 2; ++k) \
        acc[ai][bj][m][n] = __builtin_amdgcn_mfma_f32_16x16x32_bf16(Bt[n][k], At[m][k], acc[ai][bj][m][n], 0, 0, 0); __builtin_amdgcn_s_setprio(0); } while (0)
#define PG8_WAIT_V(n) asm volatile("s_waitcnt vmcnt(" #n ")" ::: "memory")
#define PG8_WAIT_L(n) asm volatile("s_waitcnt lgkmcnt(" #n ")" ::: "memory")
#define PG8_BAR __builtin_amdgcn_s_barrier()
#define PG8_SCHED __builtin_amdgcn_sched_barrier(0)
    Unit cur, nxt; int ui = 0;
    if (!S.next(0, cur)) return;
    f32x4 acc[2][2][4][2];
#pragma unroll
    for (int a = 0; a < 2; ++a)
#pragma unroll
        for (int b = 0; b < 2; ++b)
#pragma unroll
            for (int m = 0; m < 4; ++m)
#pragma unroll
                for (int n = 0; n < 2; ++n) acc[a][b][m][n] = (f32x4){0.f, 0.f, 0.f, 0.f};
    bf16x8 At[4][2], B0[2][2], B1[2][2];
    const char* cA = (const char*)g.A + (size_t)cur.pm * tstep; const char* cB = (const char*)g.Bt + (size_t)cur.pn * tstep;
    S.a_ready(cur);
    if constexpr (SP2) {
        if (!(PRE && wid != 0)) { PG8_STAGE(PG8_SB(0, 0), cB, voffB); PG8_STAGE(PG8_SB(0, 1), cB + hstep, voffB); }
        PG8_STAGE(PG8_SA(0, 0), cA, voffA); PG8_STAGE(PG8_SA(0, 1), cA + hstep, voffA);
        if (wr == 1) PG8_BAR;
        PG8_WAIT_V(2); PG8_BAR;
        PG8_STAGE(PG8_SB(1, 0), cB + kstep, voffB); PG8_STAGE(PG8_SA(1, 0), cA + kstep, voffA); PG8_STAGE(PG8_SB(1, 1), cB + hstep + kstep, voffB);
        PG8_WAIT_V(6); PG8_BAR;
    } else {
        PG8_STAGE(PG8_SB(0, 0), cB, voffB); PG8_STAGE(PG8_SA(0, 0), cA, voffA); PG8_STAGE(PG8_SB(0, 1), cB + hstep, voffB); PG8_STAGE(PG8_SA(0, 1), cA + hstep, voffA);
        if (wr == 1) PG8_BAR;
        PG8_WAIT_V(4); PG8_BAR;
        PG8_STAGE(PG8_SB(1, 0), cB + kstep, voffB); PG8_STAGE(PG8_SA(1, 0), cA + kstep, voffA); PG8_STAGE(PG8_SB(1, 1), cB + hstep + kstep, voffB);
        PG8_WAIT_V(6); PG8_BAR;
    }
    for (;;) {
        const bool has_next = S.next(ui + 1, nxt);
        const char* nA = has_next ? (const char*)g.A + (size_t)nxt.pm * tstep : cA; const char* nB = has_next ? (const char*)g.Bt + (size_t)nxt.pn * tstep : cB;
        for (int t = 0; t < nt; t += 2) {
            const bool last = (t == nt - 2);
            const char* a1 = cA + (size_t)(t + 1) * kstep;
            const char* a2 = last ? nA : cA + (size_t)(t + 2) * kstep; const char* b2 = last ? nB : cB + (size_t)(t + 2) * kstep;
            const char* a3 = a2 + kstep; const char* b3 = b2 + kstep;
            if (last && has_next) S.a_ready(nxt);
            if constexpr (SP2) {
            PG8_LDB(B0, 0, 0); PG8_LDB(B1, 0, 1); PG8_SCHED; PG8_LDA(At, 0, 0); PG8_STAGE(PG8_SA(1, 1), a1 + hstep, voffA);
            PG8_WAIT_V(8); PG8_WAIT_L(0); PG8_BAR; PG8_MMA(0, 0, At, B0); PG8_MMA(0, 1, At, B1); PG8_BAR; PG8_SCHED;
            PG8_LDA(At, 0, 1); PG8_STAGE(PG8_SB(0, 0), b2, voffB); PG8_STAGE(PG8_SB(0, 1), b2 + hstep, voffB); PG8_STAGE(PG8_SA(0, 0), a2, voffA);
            PG8_WAIT_V(8); PG8_WAIT_L(0); PG8_BAR; PG8_MMA(1, 0, At, B0); PG8_MMA(1, 1, At, B1); PG8_BAR; PG8_SCHED;
            PG8_LDB(B0, 1, 0); PG8_LDB(B1, 1, 1); PG8_SCHED; PG8_LDA(At, 1, 0); PG8_STAGE(PG8_SA(0, 1), a2 + hstep, voffA);
            PG8_WAIT_V(8); PG8_WAIT_L(0); PG8_BAR; PG8_MMA(0, 0, At, B0); PG8_MMA(0, 1, At, B1); PG8_BAR; PG8_SCHED;
            PG8_LDA(At, 1, 1); PG8_STAGE(PG8_SB(1, 0), b3, voffB); PG8_STAGE(PG8_SB(1, 1), b3 + hstep, voffB); PG8_STAGE(PG8_SA(1, 0), a3, voffA);
            PG8_WAIT_V(8); PG8_WAIT_L(0); PG8_BAR; PG8_MMA(1, 0, At, B0); PG8_MMA(1, 1, At, B1); PG8_BAR; PG8_SCHED;
            } else {
            PG8_LDB(B0, 0, 0); PG8_SCHED; PG8_LDA(At, 0, 0); PG8_STAGE(PG8_SA(1, 1), a1 + hstep, voffA);
            PG8_WAIT_L(8); PG8_BAR; PG8_WAIT_L(0); PG8_MMA(0, 0, At, B0); PG8_BAR; PG8_SCHED;
            PG8_LDB(B1, 0, 1); PG8_STAGE(PG8_SB(0, 0), b2, voffB);
            PG8_BAR; PG8_WAIT_L(0); PG8_MMA(0, 1, At, B1); PG8_BAR;
            PG8_LDA(At, 0, 1); PG8_STAGE(PG8_SA(0, 0), a2, voffA);
            PG8_BAR; PG8_WAIT_L(0); PG8_MMA(1, 0, At, B0); PG8_BAR; PG8_SCHED;
            PG8_STAGE(PG8_SB(0, 1), b2 + hstep, voffB);
            PG8_WAIT_V(6); PG8_BAR; PG8_MMA(1, 1, At, B1); PG8_BAR;
            PG8_LDB(B0, 1, 0); PG8_SCHED; PG8_LDA(At, 1, 0); PG8_STAGE(PG8_SA(0, 1), a2 + hstep, voffA);
            PG8_WAIT_L(8); PG8_BAR; PG8_WAIT_L(0); PG8_MMA(0, 0, At, B0); PG8_BAR; PG8_SCHED;
            PG8_LDB(B1, 1, 1); PG8_STAGE(PG8_SB(1, 0), b3, voffB);
            PG8_BAR; PG8_WAIT_L(0); PG8_MMA(0, 1, At, B1); PG8_BAR;
            PG8_LDA(At, 1, 1); PG8_STAGE(PG8_SA(1, 0), a3, voffA);
            PG8_BAR; PG8_WAIT_L(0); PG8_MMA(1, 0, At, B0); PG8_BAR; PG8_SCHED;
            PG8_STAGE(PG8_SB(1, 1), b3 + hstep, voffB);
            PG8_WAIT_V(6); PG8_BAR; PG8_MMA(1, 1, At, B1); PG8_BAR;
            }
        }
        if constexpr (ALIGN_EPI) { if (wr == 0) PG8_BAR; }
        if constexpr (!Epi::AFTER_DRAIN) { E(acc, cur, wr, wc, fr, fq); S.done(cur); }
        if (!has_next) break;
#pragma unroll
        for (int a = 0; a < 2; ++a)
#pragma unroll
            for (int b = 0; b < 2; ++b)
#pragma unroll
                for (int m = 0; m < 4; ++m)
#pragma unroll
                    for (int n = 0; n < 2; ++n) acc[a][b][m][n] = (f32x4){0.f, 0.f, 0.f, 0.f};
        cur = nxt; cA = nA; cB = nB; ++ui;
        if constexpr (ALIGN_EPI) { if (wr == 1) PG8_BAR; }
    }
    PG8_WAIT_V(0);
    if constexpr (!ALIGN_EPI) { if (wr == 0) PG8_BAR; }
    PG8_BAR;
    if constexpr (Epi::AFTER_DRAIN) { E.fused(acc, cur, wr, wc, fr, fq, lds, wid, lane); S.done(cur); }
#undef PG8_SA
#undef PG8_SB
#undef PG8_STAGE
#undef PG8_LDA
#undef PG8_LDB
#undef PG8_MMA
#undef PG8_WAIT_V
#undef PG8_WAIT_L
#undef PG8_BAR
#undef PG8_SCHED
}
}

#define LAS __attribute__((address_space(3)))
using pg8::bf16_t; using pg8::bf16x8; using pg8::f32x4; using pg8::u32x4;
typedef float f32x16 __attribute__((ext_vector_type(16)));
typedef float f32x2_t __attribute__((ext_vector_type(2)));
typedef __bf16 bf16x2_t __attribute__((ext_vector_type(2)));
typedef unsigned u32x2 __attribute__((ext_vector_type(2)));

constexpr int DM = 1024, NTOK = 16384, NCTX = 8192, DFF = 2816, DATT = 512, DIN = 4096, NMOD = 9;
constexpr float EPS = 1e-6f, LOG2E = 1.4426950408889634f;
constexpr size_t MiB = 1u << 20;
constexpr size_t WS_FF1IN = 0, WS_FF1OUT = 11 * MiB, WS_FF2IN = 17 * MiB, WS_FF2OUT = 28 * MiB, WS_WIN = 34 * MiB, WS_WBP = 42 * MiB, WS_WBA = 43 * MiB, WS_WOUT = 44 * MiB,
                 WS_WPOOL = 46 * MiB, WS_MOD = 47 * MiB, WS_KC = 48 * MiB, WS_VTC = 50 * MiB;
constexpr size_t WS_H = 52 * MiB;
constexpr size_t WS_ACT = 84 * MiB;
constexpr size_t WS_P = 172 * MiB;
constexpr size_t WS_Q = 204 * MiB;
constexpr size_t WS_K = 220 * MiB;
constexpr size_t WS_VT = 236 * MiB;
constexpr size_t WS_CTL = 252 * MiB, CTL_BYTES = 16384;
constexpr size_t WS_SS = 253 * MiB;
constexpr size_t WS_BVIN = 47 * MiB + 512 * 1024, WS_BVFF2 = WS_BVIN + 128 * 1024;
constexpr size_t WS_END = 254 * MiB;
static_assert(WS_END <= 256 * MiB, "d_ws map");
constexpr size_t KV_LAT = (size_t)32 * 8 * 8 * 2048;
constexpr size_t OUT_Y = 0, OUT_K = (size_t)NTOK * DM, OUT_V = OUT_K + (size_t)NCTX * DATT;

__device__ __forceinline__ unsigned pkbf(float lo, float hi) { f32x2_t v = {lo, hi}; bf16x2_t b = __builtin_convertvector(v, bf16x2_t); return __builtin_bit_cast(unsigned, b); }
__device__ __forceinline__ float bflo(unsigned w) { return __uint_as_float(w << 16); }
__device__ __forceinline__ float bfhi(unsigned w) { return __uint_as_float(w & 0xffff0000u); }
__device__ __forceinline__ float fast_sigmoid(float x) { return __builtin_amdgcn_rcpf(1.0f + __builtin_amdgcn_exp2f(-x * LOG2E)); }
__device__ __forceinline__ float wave_sum(float v) {
#pragma unroll
    for (int o = 1; o < 64; o <<= 1) v += __shfl_xor(v, o);
    return v;
}
__device__ __forceinline__ int cond_of_pm(int pm) { return pm < 32 ? 0 : 1 + ((pm - 32) >> 3); }

__device__ __forceinline__ float row_sumsq(const float* SS, int row, int fq) {
    const f32x4 a = *(const f32x4*)(SS + (size_t)row * 16 + 4 * fq); float s = (a[0] + a[1]) + (a[2] + a[3]);
    s += __shfl_xor(s, 16); s += __shfl_xor(s, 32); return s;
}
__device__ __forceinline__ float rstd_of(float sumsq) { return 1.0f / sqrtf(sumsq * (1.0f / DM) + EPS); }

__device__ __forceinline__ void rstd_table(const float* SS, const pg8::StaticOrder& S, LAS float* tbl, int nmax, int tid) {
    pg8::Unit u;
    for (int i = 0; i < nmax && S.next(i, u); ++i)
        if (tid < 256) { const f32x4* p = (const f32x4*)(SS + (size_t)(u.pm * 256 + tid) * 16); const f32x4 a = (p[0] + p[1]) + (p[2] + p[3]); tbl[i * 256 + tid] = rstd_of(((a[0] + a[1]) + (a[2] + a[3]))); }
    __syncthreads();
}

#define EPI_ROWS(ai, m) (u.pm * 256 + (ai) * 128 + wr * 64 + (m) * 16 + fr)

template <bool NORMED> struct EpiSwiGLU {
    static constexpr bool PERM = true, AFTER_DRAIN = false;
    unsigned char* ws; const LAS float* tbl; int nmax;
    __device__ __forceinline__ void operator()(const f32x4 (&acc)[2][2][4][2], const pg8::Unit& u, int wr, int wc, int fr, int fq) const {
        bf16_t* O = (bf16_t*)(ws + WS_ACT); const float* bvec = (const float*)(ws + WS_BVFF2); const float* SS = (const float*)(ws + WS_SS);
        const int col = u.pn * 128 + wc * 32 + 8 * fq;
        f32x4 bv[2][2];
        if (NORMED) { const float* bp = bvec + (size_t)cond_of_pm(u.pm) * (2 * DFF) + u.pn * 256 + wc * 32 + 8 * fq;
#pragma unroll
            for (int bj = 0; bj < 2; ++bj)
#pragma unroll
                for (int n = 0; n < 2; ++n) bv[bj][n] = *(const f32x4*)(bp + bj * 128 + 4 * n); }
#pragma unroll
        for (int ai = 0; ai < 2; ++ai)
#pragma unroll
            for (int m = 0; m < 4; ++m) {
                const int row = EPI_ROWS(ai, m);
                const float rs = NORMED ? (u.ord < nmax ? tbl[u.ord * 256 + ai * 128 + wr * 64 + m * 16 + fr] : rstd_of(row_sumsq(SS, row, fq))) : 1.f;
                float v[8];
#pragma unroll
                for (int n = 0; n < 2; ++n)
#pragma unroll
                    for (int j = 0; j < 4; ++j) { float g = acc[ai][0][m][n][j], up = acc[ai][1][m][n][j]; if (NORMED) { g = g * rs + bv[0][n][j]; up = up * rs + bv[1][n][j]; } v[4 * n + j] = g * fast_sigmoid(g) * up; }
                u32x4 w; w.x = pkbf(v[0], v[1]); w.y = pkbf(v[2], v[3]); w.z = pkbf(v[4], v[5]); w.w = pkbf(v[6], v[7]);
                *(u32x4*)(O + (size_t)row * DFF + col) = w;
            }
    }
};
template <bool NEXT, int GI, int COEF2, int MNEXT> struct EpiResid {
    static constexpr bool PERM = true, AFTER_DRAIN = false;
    const float* base0; long d1;
    float* out; unsigned char* ws; const float* gnext;
    __device__ __forceinline__ void operator()(const f32x4 (&acc)[2][2][4][2], const pg8::Unit& u, int wr, int wc, int fr, int fq) const {
        constexpr int gi = GI, mnext = MNEXT; constexpr float coef = 0.5f * COEF2;
        bf16_t* XA = (bf16_t*)(ws + WS_H); float* SS = (float*)(ws + WS_SS);
        const float* mc = (const float*)(ws + WS_MOD) + (size_t)cond_of_pm(u.pm) * (NMOD * DM);
        const float* gv = mc + gi * DM;
        const float* base = base0 + (u.pm < 32 ? 0L : d1);
        const int col = u.pn * 256 + wc * 32 + 8 * fq;
        f32x4 g[2][2], an[2][2];
#pragma unroll
        for (int bj = 0; bj < 2; ++bj)
#pragma unroll
            for (int n = 0; n < 2; ++n) { g[bj][n] = *(const f32x4*)(gv + col + bj * 128 + 4 * n) * coef;
                if (NEXT) an[bj][n] = *(const f32x4*)(gnext + col + bj * 128 + 4 * n) * (*(const f32x4*)(mc + (mnext + 1) * DM + col + bj * 128 + 4 * n) + 1.0f); }
#pragma unroll
        for (int ai = 0; ai < 2; ++ai)
#pragma unroll
            for (int m = 0; m < 4; ++m) { const int row = EPI_ROWS(ai, m); const size_t off = (size_t)row * DM + col; float ss = 0.f;
#pragma unroll
                for (int bj = 0; bj < 2; ++bj) { f32x4 o[2];
#pragma unroll
                    for (int n = 0; n < 2; ++n) { const f32x4 b = *(const f32x4*)(base + off + bj * 128 + 4 * n); o[n] = b + g[bj][n] * acc[ai][bj][m][n]; if (NEXT) *(f32x4*)(out + off + bj * 128 + 4 * n) = o[n]; else __builtin_nontemporal_store(o[n], (f32x4*)(out + off + bj * 128 + 4 * n));
                        if (NEXT) ss += (o[n][0] * o[n][0] + o[n][1] * o[n][1]) + (o[n][2] * o[n][2] + o[n][3] * o[n][3]); }
                    if (NEXT) { const f32x4 xa = o[0] * an[bj][0], xb = o[1] * an[bj][1]; u32x4 w; w.x = pkbf(xa[0], xa[1]); w.y = pkbf(xa[2], xa[3]); w.z = pkbf(xb[0], xb[1]); w.w = pkbf(xb[2], xb[3]);
                        *(u32x4*)(XA + off + bj * 128) = w; }
                }
                if (NEXT) { ss += __shfl_xor(ss, 16); ss += __shfl_xor(ss, 32); if (fq == 0) SS[(size_t)row * 16 + u.pn * 4 + wc] = ss; }
            }
    }
};
struct EpiWin {
    static constexpr bool PERM = true, AFTER_DRAIN = false;
    unsigned char* ws; float* outk; const float* qgain; const float* kgain; LAS unsigned char* scr; const LAS float* tbl; int nmax;
    __device__ __forceinline__ void operator()(const f32x4 (&accr)[2][2][4][2], const pg8::Unit& u, int wr, int wc, int fr, int fq) const {
        const int pn = u.pn;
        float* P = (float*)(ws + WS_P); bf16_t* Q = (bf16_t*)(ws + WS_Q); bf16_t* Kb = (bf16_t*)(ws + WS_K); bf16_t* VT = (bf16_t*)(ws + WS_VT); bf16_t* Gt = (bf16_t*)(ws + WS_ACT);
        float* outv = outk + (size_t)NCTX * DATT; const float* bvec = (const float*)(ws + WS_BVIN);
        f32x4 (&acc)[2][2][4][2] = const_cast<f32x4 (&)[2][2][4][2]>(accr);
        { const float* bp = bvec + (size_t)cond_of_pm(u.pm) * DIN + pn * 256 + wc * 32 + 8 * fq; f32x4 bv[2][2];
#pragma unroll
            for (int bj = 0; bj < 2; ++bj)
#pragma unroll
                for (int n = 0; n < 2; ++n) bv[bj][n] = *(const f32x4*)(bp + bj * 128 + 4 * n);
#pragma unroll
            for (int ai = 0; ai < 2; ++ai)
#pragma unroll
                for (int m = 0; m < 4; ++m) { const float rs = u.ord < nmax ? tbl[u.ord * 256 + ai * 128 + wr * 64 + m * 16 + fr] : rstd_of(row_sumsq((const float*)(ws + WS_SS), EPI_ROWS(ai, m), fq));
#pragma unroll
                    for (int bj = 0; bj < 2; ++bj)
#pragma unroll
                        for (int n = 0; n < 2; ++n) acc[ai][bj][m][n] = accr[ai][bj][m][n] * rs + bv[bj][n]; } }

        if (pn < 2) {
            const int col = pn * 256 + wc * 32 + 8 * fq;
#pragma unroll
            for (int ai = 0; ai < 2; ++ai)
#pragma unroll
                for (int m = 0; m < 4; ++m) { float* rp = P + (size_t)EPI_ROWS(ai, m) * DATT + col;
#pragma unroll
                    for (int bj = 0; bj < 2; ++bj)
#pragma unroll
                        for (int n = 0; n < 2; ++n) *(f32x4*)(rp + bj * 128 + 4 * n) = acc[ai][bj][m][n]; }
        } else if (pn < 6) {
            const bool isk = pn >= 4;
            const float* gain = isk ? kgain : qgain;
            const int head = 4 * (pn & 1) + wc;
            f32x4 gn[2][2];
#pragma unroll
            for (int bj = 0; bj < 2; ++bj)
#pragma unroll
                for (int n = 0; n < 2; ++n) gn[bj][n] = *(const f32x4*)(gain + 32 * bj + 8 * fq + 4 * n);
#pragma unroll
            for (int ai = 0; ai < 2; ++ai)
#pragma unroll
                for (int m = 0; m < 4; ++m) {
                    float ss = 0.f;
#pragma unroll
                    for (int bj = 0; bj < 2; ++bj)
#pragma unroll
                        for (int n = 0; n < 2; ++n) { const f32x4 x = acc[ai][bj][m][n]; ss += (x[0] * x[0] + x[1] * x[1]) + (x[2] * x[2] + x[3] * x[3]); }
                    ss += __shfl_xor(ss, 16); ss += __shfl_xor(ss, 32);
                    const float rstd = 1.0f / sqrtf(ss * (1.0f / 64.0f) + EPS);
                    const int row = EPI_ROWS(ai, m);
#pragma unroll
                    for (int bj = 0; bj < 2; ++bj) {
                        const f32x4 a = acc[ai][bj][m][0] * rstd * gn[bj][0], b = acc[ai][bj][m][1] * rstd * gn[bj][1];
                        const int c = head * 64 + 32 * bj + 8 * fq;
                        u32x4 w; w.x = pkbf(a[0], a[1]); w.y = pkbf(a[2], a[3]); w.z = pkbf(b[0], b[1]); w.w = pkbf(b[2], b[3]);
                        if (!isk) *(u32x4*)(Q + (size_t)row * DATT + c) = w;
                        else {
                            const bool ctx = u.pm < 32; const int rl = row - u.pm * 256, tok = ctx ? rl : ((u.pm - 32) & 7) * 256 + rl;
                            const size_t tile = ctx ? (size_t)(u.pm * 8 + head) * 8 + (tok >> 5) : KV_LAT / 2048 + (size_t)(((u.pm - 32) >> 3) * 8 + head) * 64 + (tok >> 5);
                            *(u32x4*)(Kb + tile * 2048 + (2 * bj + (fq >> 1)) * 512 + (32 * (fq & 1) + (tok & 31)) * 8) = w; }
                        if (isk && u.pm < 32) { __builtin_nontemporal_store(a, (f32x4*)(outk + (size_t)row * DATT + c)); __builtin_nontemporal_store(b, (f32x4*)(outk + (size_t)row * DATT + c + 4)); }
                    }
                }
        } else if (pn < 8) {
            const bool ctx = u.pm < 32;
            LAS unsigned char* pad = scr + (wr * 4 + wc) * 1280;
            const int lane_ = fq * 16 + fr, d_ = lane_ & 31, hh_ = lane_ >> 5;
#pragma unroll
            for (int ai = 0; ai < 2; ++ai)
#pragma unroll
                for (int m = 0; m < 4; ++m) {
                    const int rl0 = ai * 128 + wr * 64 + m * 16, row = u.pm * 256 + rl0 + fr, tok0 = ctx ? rl0 : ((u.pm - 32) & 7) * 256 + rl0;
#pragma unroll
                    for (int bj = 0; bj < 2; ++bj) {
                        const int c = (pn - 6) * 256 + bj * 128 + wc * 32 + 8 * fq, head = c >> 6;
                        const f32x4 a = acc[ai][bj][m][0], b = acc[ai][bj][m][1];
                        u32x4 w; w.x = pkbf(a[0], a[1]); w.y = pkbf(a[2], a[3]); w.z = pkbf(b[0], b[1]); w.w = pkbf(b[2], b[3]);
                        *(LAS u32x4*)(pad + fr * 80 + fq * 16) = w;
                        if (ctx) { __builtin_nontemporal_store(a, (f32x4*)(outv + (size_t)row * DATT + c)); __builtin_nontemporal_store(b, (f32x4*)(outv + (size_t)row * DATT + c + 4)); }
                        unsigned short e[8];
#pragma unroll
                        for (int j = 0; j < 8; ++j) e[j] = *(const LAS unsigned short*)(pad + (8 * (j >> 2) + 4 * hh_ + (j & 3)) * 80 + d_ * 2);
                        u32x4 o; o.x = e[0] | ((unsigned)e[1] << 16); o.y = e[2] | ((unsigned)e[3] << 16); o.z = e[4] | ((unsigned)e[5] << 16); o.w = e[6] | ((unsigned)e[7] << 16);
                        const size_t tile = ctx ? (size_t)(u.pm * 8 + head) * 8 + (tok0 >> 5) : KV_LAT / 2048 + (size_t)(((u.pm - 32) >> 3) * 8 + head) * 64 + (tok0 >> 5);
                        *(u32x4*)(VT + tile * 2048 + ((wc & 1) * 2 + ((tok0 >> 4) & 1)) * 512 + lane_ * 8) = o;
                    }
                }
        } else {
            const int col = (pn - 8) * 256 + wc * 32 + 8 * fq;
#pragma unroll
            for (int ai = 0; ai < 2; ++ai)
#pragma unroll
                for (int m = 0; m < 4; ++m) { bf16_t* rp = Gt + (size_t)EPI_ROWS(ai, m) * 2048 + col;
#pragma unroll
                    for (int bj = 0; bj < 2; ++bj) { const f32x4 a = acc[ai][bj][m][0], b = acc[ai][bj][m][1];
                        u32x4 w; w.x = pkbf(fast_sigmoid(a[0]), fast_sigmoid(a[1])); w.y = pkbf(fast_sigmoid(a[2]), fast_sigmoid(a[3]));
                        w.z = pkbf(fast_sigmoid(b[0]), fast_sigmoid(b[1])); w.w = pkbf(fast_sigmoid(b[2]), fast_sigmoid(b[3]));
                        *(u32x4*)(rp + bj * 128) = w; }
                }
        }
    }
};
template <int MODE> struct EpiMix {
    static constexpr bool PERM = true, AFTER_DRAIN = false;
    unsigned char* ws; const float* vec;
    __device__ __forceinline__ void operator()(const f32x4 (&acc)[2][2][4][2], const pg8::Unit& u, int wr, int wc, int fr, int fq) const {
        bf16_t* O = (bf16_t*)(ws + (MODE == 0 ? WS_H + 16 * MiB : MODE == 1 ? WS_K : WS_P)); constexpr int ldo = MODE == 0 ? DATT : DM;
        const bf16_t* Gt = (const bf16_t*)(ws + WS_ACT); const bf16_t* T1 = (const bf16_t*)(ws + WS_K);
        const int col = u.pn * 256 + wc * 32 + 8 * fq;
        f32x4 sv[2][2];
        if (MODE == 0) {
#pragma unroll
            for (int bj = 0; bj < 2; ++bj)
#pragma unroll
                for (int n = 0; n < 2; ++n) sv[bj][n] = *(const f32x4*)(vec + col + bj * 128 + 4 * n);
        }
#pragma unroll
        for (int ai = 0; ai < 2; ++ai)
#pragma unroll
            for (int m = 0; m < 4; ++m) { const int row = EPI_ROWS(ai, m);
#pragma unroll
                for (int bj = 0; bj < 2; ++bj) {
                    f32x4 a = acc[ai][bj][m][0], b = acc[ai][bj][m][1];
                    const int c = col + bj * 128;
                    if (MODE == 0) { a = a * sv[bj][0]; b = b * sv[bj][1]; }
                    else {
                        const u32x4 gw = *(const u32x4*)(Gt + (size_t)row * 2048 + (MODE == 2 ? 1024 : 0) + c);
                        const f32x4 ga = {bflo(gw.x), bfhi(gw.x), bflo(gw.y), bfhi(gw.y)}, gb = {bflo(gw.z), bfhi(gw.z), bflo(gw.w), bfhi(gw.w)};
                        a = a * ga; b = b * gb;
                        if (MODE == 2) { const u32x4 tw = *(const u32x4*)(T1 + (size_t)row * DM + c);
                            a = a + (f32x4){bflo(tw.x), bfhi(tw.x), bflo(tw.y), bfhi(tw.y)}; b = b + (f32x4){bflo(tw.z), bfhi(tw.z), bflo(tw.w), bfhi(tw.w)}; }
                    }
                    u32x4 w; w.x = pkbf(a[0], a[1]); w.y = pkbf(a[2], a[3]); w.z = pkbf(b[0], b[1]); w.w = pkbf(b[2], b[3]);
                    *(u32x4*)(O + (size_t)row * ldo + c) = w;
                }
            }
    }
};

__device__ __forceinline__ unsigned f2bf(float f) { unsigned u = __builtin_bit_cast(unsigned, f); return (u + 0x7fffu + ((u >> 16) & 1u)) >> 16; }
__device__ __forceinline__ unsigned pk2(float lo, float hi) { return f2bf(lo) | (f2bf(hi) << 16); }
__device__ __forceinline__ int dest_row(int mode, int n) {
    if (mode == 1) { const int up = n >= DFF, j = up ? n - DFF : n; return 256 * (j >> 7) + (up ? 128 : 0) + (j & 127); }
    if (mode == 2) { if (n >= 512 && n < 1536) { const int tb = n & ~255, cc = n & 255, hh = cc >> 6, d = cc & 63; return tb + 128 * (d >> 5) + 32 * hh + (d & 31); } return n; }
    return n;
}
__device__ __forceinline__ void tr_item(const float* W, int N, bf16_t* WT, int ldt, int mode, LAS float* scr, int item, int lane, bool nts = false) {
    const int nblk = N / 32, kb = item / nblk, nb = item % nblk, k0 = 64 * kb, n0 = 32 * nb;
#pragma unroll
    for (int i = 0; i < 32; ++i) { const int kk = 2 * i + (lane >> 5); scr[kk * 33 + (lane & 31)] = __builtin_nontemporal_load(W + (size_t)(k0 + kk) * N + n0 + (lane & 31)); }
    asm volatile("s_waitcnt lgkmcnt(0)" ::: "memory");
    const int c = lane & 7;
#pragma unroll
    for (int j = 0; j < 4; ++j) { const int n = (lane >> 3) + 8 * j; const LAS float* s = scr + (8 * c) * 33 + n;
        u32x4 o; o.x = pk2(s[0 * 33], s[1 * 33]); o.y = pk2(s[2 * 33], s[3 * 33]); o.z = pk2(s[4 * 33], s[5 * 33]); o.w = pk2(s[6 * 33], s[7 * 33]);
        if (nts) __builtin_nontemporal_store(o, (u32x4*)(WT + (size_t)dest_row(mode, n0 + n) * ldt + k0 + 8 * c)); else *(u32x4*)(WT + (size_t)dest_row(mode, n0 + n) * ldt + k0 + 8 * c) = o; }
    asm volatile("s_waitcnt lgkmcnt(0)" ::: "memory");
}

struct Args { const float* in[24]; float* out; unsigned char* ws; int ph_lo, ph_hi; };
enum { I_XP = 0, I_XS, I_CK, I_CV, I_C, I_CCTX, I_WADA, I_BADA, I_GFF1, I_WFF1IN, I_WFF1OUT, I_GMIX, I_WIN, I_QG, I_KG, I_WPOOL, I_PSCALE, I_RPB, I_WBP, I_WBA, I_WOUT, I_GFF2, I_WFF2IN, I_WFF2OUT };

__device__ __forceinline__ void phase0(const Args& a, LAS unsigned char* lds, int tid, int lane, int wave, int G) {
    unsigned char* ws = a.ws;
    if ((int)blockIdx.x < 144) {
        LAS float* sc = (LAS float*)lds; LAS float* red = sc + 5 * 1024;
        for (int i = tid; i < 5 * 1024; i += 512) { const float v = i < 1024 ? a.in[I_CCTX][i] : a.in[I_C][i - 1024]; sc[i] = v * fast_sigmoid(v); }
        __syncthreads();
        float* mod = (float*)(ws + WS_MOD);
        for (int u = blockIdx.x; u < 144; u += G) {
            const int rsub = lane >> 4, c4 = (lane & 15) * 4;
            f32x4 acc[5];
#pragma unroll
            for (int c = 0; c < 5; ++c) acc[c] = (f32x4){0.f, 0.f, 0.f, 0.f};
            const float* wp = a.in[I_WADA] + (size_t)(wave * 128 + rsub) * (NMOD * DM) + u * 64 + c4;
            const LAS float* scw = sc + wave * 128 + rsub;
#pragma unroll 8
            for (int i = 0; i < 32; ++i) {
                const f32x4 wv = __builtin_nontemporal_load((const f32x4*)(wp + (size_t)(4 * i) * (NMOD * DM)));
#pragma unroll
                for (int c = 0; c < 5; ++c) acc[c] += wv * scw[c * 1024 + 4 * i];
            }
#pragma unroll
            for (int c = 0; c < 5; ++c)
#pragma unroll
                for (int j = 0; j < 4; ++j) { float v = acc[c][j]; v += __shfl_xor(v, 16); v += __shfl_xor(v, 32); acc[c][j] = v; }
            if (lane < 16) {
#pragma unroll
                for (int c = 0; c < 5; ++c) *(LAS f32x4*)(red + (wave * 5 + c) * 64 + c4) = acc[c]; }
            __syncthreads();
            if (tid < 320) { const int c = tid >> 6, l = tid & 63; float s = 0.f;
#pragma unroll
                for (int w = 0; w < 8; ++w) s += red[(w * 5 + c) * 64 + l];
                mod[c * (NMOD * DM) + u * 64 + l] = s + a.in[I_BADA][u * 64 + l]; }
            __syncthreads();
        }
    }
    LAS float* scr = (LAS float*)(lds + wave * 16384);
    constexpr int I_FIN = 16 * 176, I_IN = 16 * 128, I_FOUT = 44 * 32;
    constexpr int NITEMS = I_FIN + I_IN + I_FOUT;
    const bool bal = (G == 256); const int bx = blockIdx.x;
    if (bal && bx < 144) return;
    const int slot0 = bal ? (bx - 144) * 8 + wave : bx * 8 + wave, nslots = bal ? 112 * 8 : G * 8;
    for (int it = slot0; it < NITEMS; it += nslots) {
        int r = it;
        if (r < I_FIN) { tr_item(a.in[I_WFF1IN], 2 * DFF, (bf16_t*)(ws + WS_FF1IN), DM, 1, scr, r, lane); continue; } r -= I_FIN;
        if (r < I_IN) { tr_item(a.in[I_WIN], DIN, (bf16_t*)(ws + WS_WIN), DM, 2, scr, r, lane); continue; } r -= I_IN;
        tr_item(a.in[I_WFF1OUT], DM, (bf16_t*)(ws + WS_FF1OUT), DFF, 0, scr, r, lane);
    }
}

__device__ __forceinline__ void late_copies(const Args& a, LAS unsigned char* lds, int lane, int wave, int wi, int nw) {
    unsigned char* ws = a.ws;
    LAS float* scr = (LAS float*)(lds + wave * 16384);
    constexpr int I_FIN = 16 * 176, I_FOUT = 44 * 32, I_BR = 8 * 32, I_OUT = 16 * 32, I_FOLD = 4 * 8 * 16;
    constexpr int NITEMS = I_FIN + I_FOUT + I_BR + I_OUT + I_FOLD;
    for (int it = wi; it < NITEMS; it += nw) {
        int r = it;
        if (r < I_FIN) { tr_item(a.in[I_WFF2IN], 2 * DFF, (bf16_t*)(ws + WS_FF2IN), DM, 1, scr, r, lane, true); continue; } r -= I_FIN;
        if (r < I_FOUT) { tr_item(a.in[I_WFF2OUT], DM, (bf16_t*)(ws + WS_FF2OUT), DFF, 0, scr, r, lane, true); continue; } r -= I_FOUT;
        if (r < I_BR) { tr_item(a.in[I_WBA], DM, (bf16_t*)(ws + WS_WBA), DATT, 0, scr, r, lane); continue; } r -= I_BR;
        if (r < I_OUT) { tr_item(a.in[I_WOUT], DM, (bf16_t*)(ws + WS_WOUT), DM, 0, scr, r, lane); continue; } r -= I_OUT;
        {
            const int g = r >> 7, ib = (r >> 4) & 7, n = (r & 15) * 64 + lane;
            const float* wp = a.in[I_WPOOL] + (size_t)g * 128 * 128 + (size_t)(ib * 16) * 128; const float* ps = a.in[I_PSCALE] + g * 128; const float* wb = a.in[I_WBP] + (size_t)(g * 128) * DM + n;
#pragma unroll
            for (int q = 0; q < 8; ++q) { const int e4 = q * 64 + lane, i = e4 >> 5, j4 = (e4 & 31) * 4; const f32x4 w4 = *(const f32x4*)(wp + i * 128 + j4) * *(const f32x4*)(ps + j4); *(LAS f32x4*)(scr + i * 128 + j4) = w4; }
            asm volatile("s_waitcnt lgkmcnt(0)" ::: "memory");
            float acc[16];
#pragma unroll
            for (int i = 0; i < 16; ++i) acc[i] = 0.f;
#pragma unroll 2
            for (int j = 0; j < 128; j += 4) { const float w0 = __builtin_nontemporal_load(wb + (size_t)j * DM), w1 = __builtin_nontemporal_load(wb + (size_t)(j + 1) * DM), w2 = __builtin_nontemporal_load(wb + (size_t)(j + 2) * DM), w3 = __builtin_nontemporal_load(wb + (size_t)(j + 3) * DM);
#pragma unroll
                for (int i = 0; i < 16; ++i) { const f32x4 p4 = *(const LAS f32x4*)(scr + i * 128 + j); acc[i] += (p4[0] * w0 + p4[1] * w1) + (p4[2] * w2 + p4[3] * w3); } }
            asm volatile("s_waitcnt lgkmcnt(0)" ::: "memory");
            u32x4 o0, o1; o0.x = pk2(acc[0], acc[1]); o0.y = pk2(acc[2], acc[3]); o0.z = pk2(acc[4], acc[5]); o0.w = pk2(acc[6], acc[7]);
            o1.x = pk2(acc[8], acc[9]); o1.y = pk2(acc[10], acc[11]); o1.z = pk2(acc[12], acc[13]); o1.w = pk2(acc[14], acc[15]);
            bf16_t* dst = (bf16_t*)(ws + WS_WBP) + (size_t)n * DATT + g * 128 + ib * 16; *(u32x4*)dst = o0; *(u32x4*)(dst + 8) = o1;
        }
    }
    const int gt = wi * 64 + lane, NGT = nw * 64;
    for (int i = gt; i < 2 * 32 * 16 * 256; i += NGT) {
        const int isv = i >= 32 * 16 * 256, ch = isv ? i - 32 * 16 * 256 : i, ln = ch & 63, q4 = (ch >> 6) & 3, tile = (ch >> 8) & 15, bh = ch >> 12, b = bh >> 3, h = bh & 7, r32 = ln & 31, hh = ln >> 5;
        u32x4 o;
        if (!isv) { const float* src = a.in[I_CK] + ((size_t)(b * 512 + tile * 32 + r32) * 8 + h) * 64 + 16 * q4 + 8 * hh; const f32x4 v0 = __builtin_nontemporal_load((const f32x4*)src), v1 = __builtin_nontemporal_load((const f32x4*)(src + 4));
            o.x = pk2(v0[0], v0[1]); o.y = pk2(v0[2], v0[3]); o.z = pk2(v1[0], v1[1]); o.w = pk2(v1[2], v1[3]);
            *(u32x4*)((bf16_t*)(ws + WS_KC) + (size_t)ch * 8) = o; }
        else { const int t = q4 >> 1, sK = q4 & 1; float v[8];
#pragma unroll
            for (int j = 0; j < 8; ++j) { const int key = 16 * sK + 8 * (j >> 2) + 4 * hh + (j & 3); v[j] = __builtin_nontemporal_load(a.in[I_CV] + ((size_t)(b * 512 + tile * 32 + key) * 8 + h) * 64 + 32 * t + r32); }
            o.x = pk2(v[0], v[1]); o.y = pk2(v[2], v[3]); o.z = pk2(v[4], v[5]); o.w = pk2(v[6], v[7]);
            *(u32x4*)((bf16_t*)(ws + WS_VTC) + (size_t)ch * 8) = o; }
    }
}

__device__ __forceinline__ void norm_phase(const float* src0, const float* src1, const float* gvec, const float* mod, int mi, bf16_t* H, int G, int wave, int lane) {
    for (int rb = blockIdx.x; rb < NTOK / 64; rb += G) {
        const int rbase = rb * 64, cond = rbase < NCTX ? 0 : 1 + ((rbase - NCTX) >> 11);
        const float* sh = mod + (size_t)cond * (NMOD * DM) + mi * DM; const float* scl = sh + DM;
        f32x4 av[4], sv[4];
#pragma unroll
        for (int j = 0; j < 4; ++j) { const int c = 4 * lane + 256 * j; av[j] = *(const f32x4*)(gvec + c) * (*(const f32x4*)(scl + c) + 1.0f); sv[j] = *(const f32x4*)(sh + c); }
        for (int i0 = 0; i0 < 8; i0 += 4) {
            f32x4 v[4][4]; float s[4];
#pragma unroll
            for (int i = 0; i < 4; ++i) {
                const int row = rbase + wave * 8 + i0 + i;
                const float* xr = row < NCTX ? src0 + (size_t)row * DM : src1 + (size_t)(row - NCTX) * DM;
#pragma unroll
                for (int j = 0; j < 4; ++j) v[i][j] = __builtin_nontemporal_load((const f32x4*)(xr + 4 * lane + 256 * j));
            }
#pragma unroll
            for (int i = 0; i < 4; ++i) { s[i] = 0.f;
#pragma unroll
                for (int j = 0; j < 4; ++j) s[i] += (v[i][j][0] * v[i][j][0] + v[i][j][1] * v[i][j][1]) + (v[i][j][2] * v[i][j][2] + v[i][j][3] * v[i][j][3]); }
#pragma unroll
            for (int o = 1; o < 64; o <<= 1) {
#pragma unroll
                for (int i = 0; i < 4; ++i) s[i] += __shfl_xor(s[i], o); }
#pragma unroll
            for (int i = 0; i < 4; ++i) {
                const int row = rbase + wave * 8 + i0 + i;
                const float rstd = 1.0f / sqrtf(s[i] * (1.0f / DM) + EPS);
#pragma unroll
                for (int j = 0; j < 4; ++j) { const f32x4 o = v[i][j] * rstd * av[j] + sv[j]; u32x2 w; w.x = pkbf(o[0], o[1]); w.y = pkbf(o[2], o[3]); *(u32x2*)(H + (size_t)row * DM + 4 * lane + 256 * j) = w; }
            }
        }
    }
}

__device__ __forceinline__ void bvec_items(const bf16_t* Bt, int N, const float* mod, int mi, float* out, int gw, int NGW, int lane) {
    float sh[5][16];
#pragma unroll
    for (int c = 0; c < 5; ++c)
#pragma unroll
        for (int q = 0; q < 4; ++q) { const f32x4 v = *(const f32x4*)(mod + (size_t)c * (NMOD * DM) + mi * DM + 16 * lane + 4 * q); sh[c][4 * q] = v[0]; sh[c][4 * q + 1] = v[1]; sh[c][4 * q + 2] = v[2]; sh[c][4 * q + 3] = v[3]; }
    for (int n = gw; n < N; n += NGW) {
        const u32x4 w0 = *(const u32x4*)(Bt + (size_t)n * DM + 16 * lane), w1 = *(const u32x4*)(Bt + (size_t)n * DM + 16 * lane + 8);
        const float w[16] = {bflo(w0.x), bfhi(w0.x), bflo(w0.y), bfhi(w0.y), bflo(w0.z), bfhi(w0.z), bflo(w0.w), bfhi(w0.w), bflo(w1.x), bfhi(w1.x), bflo(w1.y), bfhi(w1.y), bflo(w1.z), bfhi(w1.z), bflo(w1.w), bfhi(w1.w)};
        float acc[5];
#pragma unroll
        for (int c = 0; c < 5; ++c) { float a = 0.f;
#pragma unroll
            for (int k = 0; k < 16; ++k) a += sh[c][k] * w[k];
            acc[c] = a; }
#pragma unroll
        for (int o = 1; o < 64; o <<= 1) {
#pragma unroll
            for (int c = 0; c < 5; ++c) acc[c] += __shfl_xor(acc[c], o); }
        if (lane == 0) {
#pragma unroll
            for (int c = 0; c < 5; ++c) out[(size_t)c * N + n] = acc[c]; }
    }
}

__device__ __forceinline__ int crow(int r, int hh) { return (r & 3) + 8 * (r >> 2) + 4 * hh; }
#define MFMA32(a, b, c) __builtin_amdgcn_mfma_f32_32x32x16_bf16((a), (b), (c), 0, 0, 0)
struct KVFrag { bf16x8 k[4]; bf16x8 v[4]; };
__device__ __forceinline__ void kv_load(KVFrag& f, const bf16_t* kt, const bf16_t* vt, int lane) {
#pragma unroll
    for (int i = 0; i < 4; ++i) { f.k[i] = *(const bf16x8*)(kt + i * 512 + lane * 8); f.v[i] = *(const bf16x8*)(vt + i * 512 + lane * 8); }
}
struct AttnState { f32x16 o0, o1; float mrun, lrun; };
template <bool LOCAL, int FAR = 0> __device__ __forceinline__ void attn_tile(AttnState& st, const KVFrag& f, const bf16x8 (&qf)[4], const LAS float* bq, int okb) {
    constexpr float C2 = 0.125f * LOG2E;
    constexpr int R0 = FAR == 2 ? 12 : 0, R1 = FAR == 1 ? 4 : 16;
    f32x16 s;
#pragma unroll
    for (int r = 0; r < 16; ++r) s[r] = 0.f;
#pragma unroll
    for (int d0 = 0; d0 < 4; ++d0) s = MFMA32(f.k[d0], qf[d0], s);
    if (LOCAL) {
#pragma unroll
        for (int r = R0; r < R1; ++r) { const int cr = (r & 3) + 8 * (r >> 2); const bool ok = (unsigned)(okb + cr) < 16u; s[r] = ok ? __builtin_fmaf(s[r], C2, bq[cr]) : -1e30f; }
    }
    float mx = s[R0];
#pragma unroll
    for (int r = R0 + 1; r < R1; ++r) mx = fmaxf(mx, s[r]);
    if (!LOCAL) mx *= C2;
    mx = fmaxf(mx, __shfl_xor(mx, 32));
    const float mnew = fmaxf(st.mrun, mx);
    if (__builtin_amdgcn_ballot_w64(mnew > st.mrun) != 0ull) {
        const float alpha = __builtin_amdgcn_exp2f(st.mrun - mnew);
        st.lrun *= alpha;
#pragma unroll
        for (int r = 0; r < 16; ++r) { st.o0[r] *= alpha; st.o1[r] *= alpha; }
        st.mrun = mnew;
    }
    float ps = 0.f;
#pragma unroll
    for (int r = 0; r < 16; ++r) { if (r >= R0 && r < R1) { s[r] = __builtin_amdgcn_exp2f(LOCAL ? s[r] - mnew : __builtin_fmaf(s[r], C2, -mnew)); ps += s[r]; } else s[r] = 0.f; }
    st.lrun += ps;
    u32x4 p0, p1;
    p0.x = pkbf(s[0], s[1]); p0.y = pkbf(s[2], s[3]); p0.z = pkbf(s[4], s[5]); p0.w = pkbf(s[6], s[7]);
    p1.x = pkbf(s[8], s[9]); p1.y = pkbf(s[10], s[11]); p1.z = pkbf(s[12], s[13]); p1.w = pkbf(s[14], s[15]);
    const bf16x8 pb0 = __builtin_bit_cast(bf16x8, p0), pb1 = __builtin_bit_cast(bf16x8, p1);
    if (FAR != 2) { st.o0 = MFMA32(f.v[0], pb0, st.o0); st.o1 = MFMA32(f.v[2], pb0, st.o1); }
    if (FAR != 1) { st.o0 = MFMA32(f.v[1], pb1, st.o0); st.o1 = MFMA32(f.v[3], pb1, st.o1); }
}
__device__ __forceinline__ void attn_wave(const bf16_t* Qp, bf16_t* Op, int nd, const bf16_t* KFd, const bf16_t* VFd,
                                          int nl, const bf16_t* KFl, const bf16_t* VFl, int rq, int r0, int g, const LAS float* rpbh, int lane) {
    const int r32 = lane & 31, hh = lane >> 5;
    bf16x8 qf[4];
#pragma unroll
    for (int d0 = 0; d0 < 4; ++d0) qf[d0] = *(const bf16x8*)(Qp + (size_t)r32 * DATT + d0 * 16 + 8 * hh);
    AttnState st;
#pragma unroll
    for (int r = 0; r < 16; ++r) { st.o0[r] = 0.f; st.o1[r] = 0.f; }
    st.mrun = -1e30f; st.lrun = 0.f;
    const int nt = nd + nl;
    const int qc = 32 * g + r32; int c0 = qc - 8; c0 = c0 < 0 ? 0 : (c0 > 48 ? 48 : c0);
    KVFrag f0, f1, f2;
#define ATT_LOAD(f, ti) do { const int ti_ = (ti); if (ti_ < nt) { if (ti_ < nd) kv_load(f, KFd + (size_t)ti_ * 2048, VFd + (size_t)ti_ * 2048, lane); \
        else { const int tx_ = 2 * r0 + (ti_ - nd); kv_load(f, KFl + (size_t)tx_ * 2048, VFl + (size_t)tx_ * 2048, lane); } } } while (0)
#define ATT_TILE(f, ti) do { const int ti_ = (ti); if (ti_ < nt) { if (ti_ < nd) attn_tile<false, 0>(st, f, qf, nullptr, 0); \
        else { const int tl_ = ti_ - nd, kb_ = 32 * (tl_ & 1) + 4 * hh; const LAS float* bq_ = rpbh + (r0 + (tl_ >> 1) - rq + 7) * 31 + (kb_ - qc + 15); \
            if ((tl_ & 1) == g) attn_tile<true, 0>(st, f, qf, bq_, kb_ - c0); else if (g == 0) attn_tile<true, 1>(st, f, qf, bq_, kb_ - c0); else attn_tile<true, 2>(st, f, qf, bq_, kb_ - c0); } } } while (0)
    ATT_LOAD(f0, 0); ATT_LOAD(f1, 1);
    for (int ti = 0; ti < nt; ti += 3) {
        ATT_LOAD(f2, ti + 2); ATT_TILE(f0, ti);
        ATT_LOAD(f0, ti + 3); ATT_TILE(f1, ti + 1);
        ATT_LOAD(f1, ti + 4); ATT_TILE(f2, ti + 2);
    }
#undef ATT_LOAD
#undef ATT_TILE
    float lrun = st.lrun; lrun += __shfl_xor(lrun, 32);
    const float inv = 1.0f / lrun;
    bf16_t* op = Op + (size_t)r32 * DATT + 4 * hh;
#pragma unroll
    for (int rg = 0; rg < 4; ++rg) {
        u32x2 w; w.x = pkbf(st.o0[4 * rg] * inv, st.o0[4 * rg + 1] * inv); w.y = pkbf(st.o0[4 * rg + 2] * inv, st.o0[4 * rg + 3] * inv); *(u32x2*)(op + 8 * rg) = w;
        u32x2 x; x.x = pkbf(st.o1[4 * rg] * inv, st.o1[4 * rg + 1] * inv); x.y = pkbf(st.o1[4 * rg + 2] * inv, st.o1[4 * rg + 3] * inv); *(u32x2*)(op + 32 + 8 * rg) = x;
    }
}

template <int HW> __device__ __forceinline__ void dpass_item(const float* ps, bf16_t* ds, int t0, int L) {
    f32x2_t x[32 + 2 * HW];
#pragma unroll
    for (int j = 0; j < 32 + 2 * HW; ++j) { const int t = t0 - HW + j; const bool ok = t >= 0 && t < L; const f32x2_t v = *(const f32x2_t*)(ps + (size_t)(ok ? t : t0) * DATT); x[j] = ok ? v : (f32x2_t){0.f, 0.f}; }
    f32x2_t s = {0.f, 0.f};
#pragma unroll
    for (int j = 0; j < 2 * HW; ++j) s += x[j];
#pragma unroll
    for (int i = 0; i < 32; ++i) {
        const int t = t0 + i; const int lo = t - HW < 0 ? 0 : t - HW, hi = t + HW > L ? L : t + HW;
        const f32x2_t d = s * (1.0f / (float)(hi - lo)) - x[i + HW];
        *(unsigned*)(ds + (size_t)t * DATT) = pkbf(d[0], d[1]);
        if (i < 31) s += x[i + 2 * HW] - x[i];
    }
}

__device__ __forceinline__ void mixer_phase(const Args& a, LAS unsigned char* lds, int tid, int lane, int wave, int G, int what, int vb) {
    unsigned char* ws = a.ws;
    if (what & 1) {
    const bf16_t* Q = (const bf16_t*)(ws + WS_Q); const bf16_t* Kb = (const bf16_t*)(ws + WS_K); const bf16_t* VT = (const bf16_t*)(ws + WS_VT);
    const bf16_t* KC = (const bf16_t*)(ws + WS_KC); const bf16_t* VTC = (const bf16_t*)(ws + WS_VTC);
    bf16_t* ATT = (bf16_t*)(ws + WS_H);
    LAS float* rpbl = (LAS float*)(lds + 1024);
    for (int i = tid; i < 8 * 15 * 31; i += 512) rpbl[i] = a.in[I_RPB][i] * LOG2E;
    __syncthreads();
    for (int u = vb; u < 256; u += G) {
        {
            const int ul = (u & 7) * 32 + (u >> 3), bh = ul >> 3, b = bh >> 3, h = bh & 7, rq = 4 * (ul & 7) + (wave >> 1), g = wave & 1;
            int r0 = rq - 4; r0 = r0 < 0 ? 0 : (r0 > 24 ? 24 : r0);
            const size_t row0 = (size_t)NCTX + (size_t)b * 2048 + rq * 64 + 32 * g;
            attn_wave(Q + row0 * DATT + h * 64, ATT + row0 * DATT + h * 64, 16, KC + (size_t)bh * 16 * 2048, VTC + (size_t)bh * 16 * 2048,
                      16, Kb + KV_LAT + (size_t)bh * 64 * 2048, VT + KV_LAT + (size_t)bh * 64 * 2048, rq, r0, g, rpbl + h * 15 * 31, lane);
        }
        {
            const int b = u >> 3, h = u & 7;
            const size_t row0 = (size_t)b * 256 + 32 * wave;
            attn_wave(Q + row0 * DATT + h * 64, ATT + row0 * DATT + h * 64, 8, Kb + (size_t)u * 8 * 2048, VT + (size_t)u * 8 * 2048,
                      0, Kb, VT, 0, 0, 0, rpbl, lane);
        }
    }
    }
    if (!(what & 2)) return;
    const float* P = (const float*)(ws + WS_P); bf16_t* D = (bf16_t*)(ws + WS_ACT + 64 * MiB);
    const int gw = blockIdx.x * 8 + wave, NGW = G * 8;
    for (int it = gw; it < (NTOK / 32) * 4; it += NGW) {
        const int g = it & 3, row0 = (it >> 2) * 32;
        int t0, L; if (row0 < NCTX) { t0 = row0 & 255; L = 256; } else { t0 = (row0 - NCTX) & 2047; L = 2048; }
        const float* ps = P + (size_t)(row0 - t0) * DATT + g * 128 + 2 * lane; bf16_t* ds = D + (size_t)(row0 - t0) * DATT + g * 128 + 2 * lane;
        if (g == 0) dpass_item<1>(ps, ds, t0, L); else if (g == 1) dpass_item<2>(ps, ds, t0, L); else if (g == 2) dpass_item<4>(ps, ds, t0, L); else dpass_item<8>(ps, ds, t0, L);
    }
}


typedef unsigned v4u __attribute__((ext_vector_type(4)));
#define XB_TMO      128
#define XB_XCNT(j)  (256  + 64 * (j))
#define XB_XSUB(j)  (1280 + 64 * (j))
#define XB_XGEN(j)  (2304 + 64 * (j))
#define XB_TOP      3328
#define XB_TOPGEN   3392
#define XCD_BAR_WORDS 3456
#define XB_SPIN_CAP (1u << 18)

__device__ __forceinline__ unsigned xb_ld(unsigned* p)              { return __hip_atomic_load(p, __ATOMIC_RELAXED, __HIP_MEMORY_SCOPE_AGENT); }
__device__ __forceinline__ unsigned xb_add(unsigned* p, unsigned v) { return __hip_atomic_fetch_add(p, v, __ATOMIC_RELAXED, __HIP_MEMORY_SCOPE_AGENT); }
__device__ __forceinline__ unsigned xb_xcc_id() { return (unsigned)__builtin_amdgcn_s_getreg((3 << 11) | 20) & 0xFu; }
#define XB_SPIN(cond, bar) do { unsigned _sp = 0; while (cond) { __builtin_amdgcn_s_sleep(1); \
    if ((++_sp & 255u) == 0u) { if (xb_ld(&(bar)[XB_TMO])) break; if (_sp > XB_SPIN_CAP) { atomicAdd(&(bar)[XB_TMO], 1u); break; } } } } while (0)

struct XcdBarrier {
    unsigned* bar; unsigned x;
    volatile LAS unsigned* st;
};

__device__ __forceinline__ XcdBarrier xcd_barrier_post(unsigned* bar, volatile LAS unsigned* st) {
    XcdBarrier b; b.bar = bar; b.x = xb_xcc_id(); b.st = st;
    if (threadIdx.x == 0) st[2] = xb_add(&bar[XB_XCNT(b.x)], 1u);
    return b;
}
__device__ __forceinline__ void xcd_barrier_complete(unsigned* bar, unsigned x, unsigned& nloc, unsigned& nx) {
    const unsigned G = gridDim.x * gridDim.y * gridDim.z;
    unsigned sum, cnt, mine, sp = 0u;
    for (;;) {
        sum = 0u; cnt = 0u; mine = 0u;
#pragma unroll
        for (unsigned j = 0; j < 16; ++j) { const unsigned c = xb_ld(&bar[XB_XCNT(j)]); sum += c; cnt += (c > 0u) ? 1u : 0u; mine = (j == x) ? c : mine; }
        if (sum == G) break;
        __builtin_amdgcn_s_sleep(1);
        if ((++sp & 255u) == 0u) { if (xb_ld(&bar[XB_TMO])) break; if (sp > XB_SPIN_CAP) { atomicAdd(&bar[XB_TMO], 1u); break; } }
    }
    nloc = mine > 0u ? mine : 1u; nx = cnt > 0u ? cnt : 1u;
}

__device__ __forceinline__ void xcd_barrier(const XcdBarrier& b, const char* pre_b = nullptr, int preK = 0, LAS unsigned char* lds = nullptr) {
    asm volatile("s_waitcnt vmcnt(0)" ::: "memory");
    __syncthreads();
    if (pre_b != nullptr) {
        const int tid_ = threadIdx.x, wid_ = __builtin_amdgcn_readfirstlane(tid_ >> 6);
        if (wid_ != 0) {
            unsigned voff_[2];
#pragma unroll
            for (int i = 0; i < 2; ++i) { int R, C; pg8::stage_rc(tid_ * 16 + i * 8192, R, C); const int Rb = (R & ~31) + pg8::perm32(R & 31); voff_[i] = (unsigned)(Rb * preK + C) * 2u; }
#pragma unroll
            for (int h = 0; h < 2; ++h)
#pragma unroll
                for (int i = 0; i < 2; ++i)
                    __builtin_amdgcn_global_load_lds((const unsigned*)(pre_b + (size_t)h * pg8::HALF * preK * 2 + voff_[i]), (LAS unsigned*)(lds + (4 + h) * pg8::HTB + wid_ * 1024 + i * 8192), 16, 0, 0);
        }
    }
    if (threadIdx.x == 0) {
        unsigned* bar = b.bar;
        __builtin_amdgcn_s_waitcnt(0);
        unsigned nloc = b.st[0], nx = b.st[1];
        if (nloc == 0u) { xcd_barrier_complete(bar, b.x, nloc, nx); b.st[0] = nloc; b.st[1] = nx; }
        const unsigned old = xb_add(&bar[XB_XSUB(b.x)], 1u);
        const unsigned gen = old / nloc;
        if (old + 1u == (gen + 1u) * nloc) {
            __builtin_amdgcn_fence(__ATOMIC_RELEASE, "agent");
            asm volatile("s_waitcnt vmcnt(0)" ::: "memory");
            const unsigned og = xb_add(&bar[XB_TOP], 1u);
            const unsigned tg = og / nx;
            if (og + 1u == (tg + 1u) * nx) xb_add(&bar[XB_TOPGEN], 1u);
            else XB_SPIN(xb_ld(&bar[XB_TOPGEN]) == tg, bar);
            __builtin_amdgcn_fence(__ATOMIC_ACQUIRE, "agent");
            xb_add(&bar[XB_XGEN(b.x)], 1u);
            asm volatile("s_waitcnt vmcnt(0)" ::: "memory");
        } else {
            XB_SPIN(xb_ld(&bar[XB_XGEN(b.x)]) == gen, bar);
            __builtin_amdgcn_fence(__ATOMIC_ACQUIRE, "agent");
            asm volatile("s_waitcnt vmcnt(0)" ::: "memory");
        }
    }
    __syncthreads();
}

#ifndef PROBE_DUP
#define PROBE_DUP -1
#endif
#ifndef MK_PER_PHASE
#define MK_PER_PHASE 0
#endif
constexpr int LDS_BYTES = 147456;
__global__ void __launch_bounds__(512, 2) mk_fwd(Args args) {
    extern __shared__ __attribute__((aligned(16))) unsigned char lds_raw[];
    LAS unsigned char* lds = (LAS unsigned char*)lds_raw;
    cg::grid_group grid = cg::this_grid();
    const int tid = threadIdx.x, lane = tid & 63, wave = __builtin_amdgcn_readfirstlane(tid >> 6), G = gridDim.x;
    unsigned char* ws = args.ws;
    const int lo = args.ph_lo, hi = args.ph_hi;
    if (tid < 64) ((LAS unsigned*)(lds + 131072))[tid] = 0u;
    __syncthreads();
    XcdBarrier bar = xcd_barrier_post((unsigned*)(ws + WS_CTL), (volatile LAS unsigned*)(lds + 131072 + 64));
    if (hi > 1000) grid.sync();
    const float* mod = (const float*)(ws + WS_MOD);
    float* Y = args.out + OUT_Y;
    bf16_t* H = (bf16_t*)(ws + WS_H); bf16_t* ACT = (bf16_t*)(ws + WS_ACT);
#define IN(k) (lo <= (k) && (k) < hi)
#define SEAM(k) do { if (IN(k) && IN((k) + 1)) xcd_barrier(bar); } while (0)
#define SEAM_PRE(k, Bptr, N_, K_) do { if (IN(k) && IN((k) + 1)) { pg8::StaticOrder So_; So_.init(NTOK, (N_), G, vb); pg8::Unit uo_; const bool h_ = So_.next(0, uo_); \
        xcd_barrier(bar, h_ ? (const char*)(Bptr) + (size_t)uo_.pn * 256 * (K_) * 2 : nullptr, (K_), lds); } } while (0)
#define PRE_OF(k) (MK_PER_PHASE ? false : true)
#define GEMM_PHASE(EPI, e, Aptr, Bptr, N_, K_) GEMM_PHASE_P(EPI, e, Aptr, Bptr, N_, K_, 0)
#define GEMM_PHASE_P(EPI, e, Aptr, Bptr, N_, K_, PRE_) do { pg8::Gemm g_{(const bf16_t*)(Aptr), (const bf16_t*)(Bptr), NTOK, (N_), (K_)}; pg8::StaticOrder S_; S_.init(NTOK, (N_), G, vb); \
        pg8::gemm_phase<EPI, pg8::StaticOrder, true, true, (PRE_)>(lds, g_, S_, e); } while (0)
    float* SSb = (float*)(ws + WS_SS); float* BVIN = (float*)(ws + WS_BVIN); float* BVFF2 = (float*)(ws + WS_BVFF2);
    const int gwv = blockIdx.x * 8 + wave, NGWv = G * 8;
#define PHASE(k, ...) if (IN(k)) { __VA_ARGS__ if (PROBE_DUP == (k)) { xcd_barrier(bar); __VA_ARGS__ } }
    PHASE(0, { phase0(args, lds, tid, lane, wave, G); }) SEAM(0);
    int vb = blockIdx.x;
    if (IN(0) && IN(1)) {
        volatile LAS unsigned* stw = (volatile LAS unsigned*)(lds + 131072 + 64);
        if (tid == 0) { const unsigned* bw = (const unsigned*)(ws + WS_CTL); bool ok = (G % 8 == 0) && bar.x < 8u;
            for (int j = 0; j < 8; ++j) ok = ok && (xb_ld((unsigned*)&bw[XB_XCNT(j)]) == (unsigned)(G / 8));
            stw[3] = ok ? (stw[2] * 8u + bar.x) : (unsigned)blockIdx.x; }
        __syncthreads();
        vb = (int)stw[3];
    }
    vb = __builtin_amdgcn_readfirstlane(vb);
    PHASE(1, { norm_phase(args.in[I_XP], args.in[I_XS], args.in[I_GFF1], mod, 0, H, G, wave, lane);
               bvec_items((const bf16_t*)(ws + WS_WIN), DIN, mod, 3, BVIN, gwv, NGWv, lane); }) SEAM_PRE(1, ws + WS_FF1IN, 2 * DFF, DM);
    PHASE(2, { EpiSwiGLU<false> e{ws, nullptr, 0}; GEMM_PHASE_P(EpiSwiGLU<false>, e, H, ws + WS_FF1IN, 2 * DFF, DM, PRE_OF(2));
               if (G == 256) { if (vb >= 128) late_copies(args, lds, lane, wave, (vb - 128) * 8 + wave, 1024); } else late_copies(args, lds, lane, wave, vb * 8 + wave, G * 8); }) SEAM_PRE(2, ws + WS_FF1OUT, DM, DFF);
    PHASE(3, { typedef EpiResid<true, 2, 1, 3> E3; E3 e{args.in[I_XP], (long)(args.in[I_XS] - args.in[I_XP]) - (long)NCTX * DM, Y, ws, args.in[I_GMIX]}; GEMM_PHASE_P(E3, e, ACT, ws + WS_FF1OUT, DM, DFF, PRE_OF(3)); }) SEAM_PRE(3, ws + WS_WIN, DIN, DM);
    PHASE(4, { LAS float* tbl = (LAS float*)(lds + 141824); { pg8::StaticOrder S_; S_.init(NTOK, DIN, G, vb); rstd_table(SSb, S_, tbl, 5, tid); }
               EpiWin e{ws, args.out + OUT_K, args.in[I_QG], args.in[I_KG], lds + 131072 + 512, tbl, 5};
               GEMM_PHASE_P(EpiWin, e, H, ws + WS_WIN, DIN, DM, PRE_OF(4)); }) SEAM(4);
    PHASE(5, { mixer_phase(args, lds, tid, lane, wave, G, 3, vb); bvec_items((const bf16_t*)(ws + WS_FF2IN), 2 * DFF, mod, 6, BVFF2, gwv, NGWv, lane); }) SEAM_PRE(5, ws + WS_WBP, DM, DATT);
    PHASE(6, { { EpiMix<1> e{ws, nullptr}; GEMM_PHASE_P(EpiMix<1>, e, ws + WS_ACT + 64 * MiB, ws + WS_WBP, DM, DATT, PRE_OF(6)); }
               { EpiMix<2> e{ws, nullptr}; GEMM_PHASE(EpiMix<2>, e, H, ws + WS_WBA, DM, DATT); } }) SEAM_PRE(6, ws + WS_WOUT, DM, DM);
    if (IN(7)) { typedef EpiResid<true, 5, 2, 6> E8; E8 e{Y, 0L, Y, ws, args.in[I_GFF2]}; GEMM_PHASE_P(E8, e, ws + WS_P, ws + WS_WOUT, DM, DM, PRE_OF(7)); } SEAM_PRE(7, ws + WS_FF2IN, 2 * DFF, DM);
    PHASE(8, { LAS float* tbl = (LAS float*)(lds + 131072 + 512); { pg8::StaticOrder S_; S_.init(NTOK, 2 * DFF, G, vb); rstd_table(SSb, S_, tbl, 15, tid); }
               EpiSwiGLU<true> e{ws, tbl, 15}; GEMM_PHASE_P(EpiSwiGLU<true>, e, H, ws + WS_FF2IN, 2 * DFF, DM, PRE_OF(8)); }) SEAM_PRE(8, ws + WS_FF2OUT, DM, DFF);
    if (IN(9)) { typedef EpiResid<false, 8, 1, 0> E10; E10 e{Y, 0L, Y, ws, nullptr}; GEMM_PHASE_P(E10, e, ACT, ws + WS_FF2OUT, DM, DFF, PRE_OF(9)); }
}

extern "C" void kernel_launch(void* const* d_in, const int* in_sizes, int n_in, void* d_out, int out_size, void* d_ws, size_t ws_size, hipStream_t stream) {
    static int grid = 0;
    if (grid == 0) {
        if (n_in != 24 || ws_size < WS_END) { fprintf(stderr, "kernel_launch: unexpected n_in %d / ws_size %zu (need %zu)\n", n_in, ws_size, (size_t)WS_END); grid = -1; return; }
        int dev = 0, cus = 0, per_cu = 0;
        hipGetDevice(&dev); hipDeviceGetAttribute(&cus, hipDeviceAttributeMultiprocessorCount, dev);
        if (hipFuncSetAttribute((const void*)mk_fwd, hipFuncAttributeMaxDynamicSharedMemorySize, LDS_BYTES) != hipSuccess) { fprintf(stderr, "kernel_launch: hipFuncSetAttribute failed\n"); grid = -1; return; }
        if (hipOccupancyMaxActiveBlocksPerMultiprocessor(&per_cu, (const void*)mk_fwd, 512, LDS_BYTES) != hipSuccess || per_cu < 1) { fprintf(stderr, "kernel_launch: occupancy query says %d\n", per_cu); per_cu = 1; }
        (void)hipGetLastError();
        grid = cus * per_cu;
        fprintf(stderr, "kernel_launch: grid %d (cus %d x %d), ws %zu\n", grid, cus, per_cu, ws_size);
    }
    if (grid < 0) return;
    if (hipMemsetAsync((char*)d_ws + WS_CTL, 0, CTL_BYTES, stream) != hipSuccess) { fprintf(stderr, "kernel_launch: memset failed\n"); return; }
    Args a{};
    for (int i = 0; i < 24; ++i) a.in[i] = (const float*)d_in[i];
    a.out = (float*)d_out; a.ws = (unsigned char*)d_ws;
#if MK_PER_PHASE
    for (int p = 0; p < 10; ++p) { a.ph_lo = p; a.ph_hi = p + 1; hipLaunchKernelGGL(mk_fwd, dim3(grid), dim3(512), LDS_BYTES, stream, a); }
#else
    a.ph_lo = 0; a.ph_hi = 10;
    void* kargs[] = {&a};
    hipError_t e = hipLaunchCooperativeKernel((const void*)mk_fwd, dim3(grid), dim3(512), kargs, LDS_BYTES, stream);
    if (e != hipSuccess) fprintf(stderr, "kernel_launch: cooperative launch failed: %s (grid %d)\n", hipGetErrorString(e), grid);
#endif
}
```
